# Optimizing an MI355X kernel written in HIP

```python
import math
import jax, jax.numpy as jnp
from jax import lax
import numpy as np

D_MODEL = 1024
BATCH = 16
SEQ = 2048
DEPTH = 4

GRID_W = 64
CTX_LEN = 256
N_MIXERS = 3
N_MOD = 9
D_FF = 2816
MACARON_W = 0.5
NORM_EPS = 1e-6
NEG_INF = -1e9

DA_HEADS = 8
DA_HEAD_DIM = 64
DA_Q_BLOCK = 128
ROPE_BASE = 10000.0
ROPE_PAIRS = DA_HEAD_DIM // 4

NA_HEADS = 16
NA_HEAD_DIM = D_MODEL // NA_HEADS
NA_ROWS = 8
NA_COLS = 16

RW_HEAD = 64
RW_HEADS = D_MODEL // RW_HEAD
RW_DECAY_LORA = 64
RW_AAA_LORA = 64
RW_GATE_LORA = 160
RW_LN_EPS = 64e-5

kernel_name = 'hybrid_diffattn_natten_rwkv7_dit'


def _rmsnorm(h, g):
    hf = h.astype(jnp.float32)
    hf = hf * lax.rsqrt(jnp.mean(hf * hf, axis=-1, keepdims=True) + NORM_EPS)
    return hf.astype(h.dtype) * g


def _modulate(h, shift, scale):
    return h * (1 + scale) + shift


def _ffn_sublayer(h, mod, g_pre, g_post, w_in, w_out):
    shift, scale, gate = mod
    u = _modulate(_rmsnorm(h, g_pre), shift, scale)
    a, b = jnp.split(u @ w_in, 2, axis=-1)
    y = (jax.nn.silu(a) * b) @ w_out
    return h + MACARON_W * gate * _rmsnorm(y, g_post)


def _axial_rope_tables(seq_len):
    t = jnp.arange(seq_len)
    pos = jnp.stack([t // GRID_W, t % GRID_W], axis=-1).astype(jnp.float32)
    freq = ROPE_BASE ** (-jnp.arange(ROPE_PAIRS, dtype=jnp.float32) / ROPE_PAIRS)
    ang = pos[:, :, None] * freq
    return jnp.cos(ang), jnp.sin(ang)


def _axial_rope(x, cos, sin):
    d = x.shape[-1]
    xr = x.reshape(x.shape[:-1] + (2, 2, d // 4))
    x1, x2 = xr[..., 0, :], xr[..., 1, :]
    bshape = (cos.shape[0],) + (1,) * (x.ndim - 3) + (2, d // 4)
    c = cos.reshape(bshape).astype(x.dtype)
    s = sin.reshape(bshape).astype(x.dtype)
    return jnp.stack([x1 * c - x2 * s, x2 * c + x1 * s], axis=-2).reshape(x.shape)


def _attend(q, k, v):
    s = jnp.einsum('bthd,bkhd->bhtk', q, k).astype(jnp.float32)
    p = jax.nn.softmax(s, axis=-1).astype(v.dtype)
    return jnp.einsum('bhtk,bkhd->bthd', p, v)


def _diff_attend(q, k, v, lam):
    s = jnp.einsum('bthjd,bkhjd->bhjtk', q, k).astype(jnp.float32)
    p = jax.nn.softmax(s, axis=-1)
    p = p[:, :, 0] - lam.astype(jnp.float32) * p[:, :, 1]
    return jnp.einsum('bhtk,bkhe->bthe', p.astype(v.dtype), v)


def _diff_attention(uc, ux, w_in, w_out, lam_vec, subln_g, lam_init, cos, sin, need_ctx):
    B, S, D = ux.shape
    H, d = DA_HEADS, DA_HEAD_DIM

    def proj(u):
        L = u.shape[1]
        q, k, v = jnp.split(u @ w_in, 3, axis=-1)
        return (q.reshape(B, L, H, 2, d) * d ** -0.5, k.reshape(B, L, H, 2, d), v.reshape(B, L, H, 2 * d))

    qc, kc, vc = proj(uc)
    qx, kx, vx = proj(ux)
    qx = _axial_rope(qx, cos, sin)
    kx = _axial_rope(kx, cos, sin)
    lam = (jnp.exp(jnp.sum(lam_vec[0] * lam_vec[1])) - jnp.exp(jnp.sum(lam_vec[2] * lam_vec[3]))
           + lam_init)
    k_all = jnp.concatenate([kc, kx], axis=1)
    v_all = jnp.concatenate([vc, vx], axis=1)
    nb = S // DA_Q_BLOCK
    qb = jnp.moveaxis(qx.reshape(B, nb, DA_Q_BLOCK, H, 2, d), 1, 0)
    ox = lax.map(lambda q: _diff_attend(q, k_all, v_all, lam), qb)
    ox = jnp.moveaxis(ox, 0, 1).reshape(B, S, H, 2 * d)

    def out(o):
        o = _rmsnorm(o, subln_g) * (1 - lam_init)
        return o.reshape(o.shape[0], o.shape[1], H * 2 * d) @ w_out

    yx = out(ox)
    yc = out(_diff_attend(qc, kc, vc, lam)) if need_ctx else None
    return yc, yx


def _neighbourhood_attention(uc, ux, w_in, w_out, rpb, need_ctx):
    B, S, D = ux.shape
    C = uc.shape[1]
    H, d = NA_HEADS, NA_HEAD_DIM
    rows = S // GRID_W
    kr = min(NA_ROWS, rows)

    def proj(u):
        L = u.shape[1]
        q, k, v = jnp.split(u @ w_in, 3, axis=-1)
        return q.reshape(B, L, H, d) * d ** -0.5, k.reshape(B, L, H, d), v.reshape(B, L, H, d)

    qc, kc, vc = proj(uc)
    qx, kx, vx = proj(ux)
    q_grid = qx.reshape(B, rows, GRID_W, H, d)
    k_grid = kx.reshape(B, rows, GRID_W, H, d)
    v_grid = vx.reshape(B, rows, GRID_W, H, d)
    col = jnp.arange(GRID_W)
    col_start = jnp.clip(col - NA_COLS // 2, 0, GRID_W - NA_COLS)
    col_in = (col[None, :] >= col_start[:, None]) & (col[None, :] < col_start[:, None] + NA_COLS)
    col_off = jnp.clip(col[None, :] - col[:, None] + NA_COLS - 1, 0, 2 * NA_COLS - 2)
    col_bias = jnp.where(col_in, rpb[:, :, col_off].astype(jnp.float32), NEG_INF)

    def row_block(r):
        rs = jnp.clip(r - kr // 2, 0, rows - kr)
        q = lax.dynamic_index_in_dim(q_grid, r, axis=1, keepdims=False)
        kb = lax.dynamic_slice_in_dim(k_grid, rs, kr, axis=1)
        vb = lax.dynamic_slice_in_dim(v_grid, rs, kr, axis=1)
        bias = jnp.swapaxes(col_bias[:, rs + jnp.arange(kr) - r + NA_ROWS - 1], 1, 2)
        s_lat = jnp.einsum('bqhd,brkhd->bhqrk', q, kb).astype(jnp.float32) + bias
        s_ctx = jnp.einsum('bqhd,bchd->bhqc', q, kc).astype(jnp.float32)
        s = jnp.concatenate([s_ctx, s_lat.reshape(B, H, GRID_W, kr * GRID_W)], axis=-1)
        p = jax.nn.softmax(s, axis=-1).astype(vx.dtype)
        p_ctx = p[..., :C]
        p_lat = p[..., C:].reshape(B, H, GRID_W, kr, GRID_W)
        return (jnp.einsum('bhqc,bchd->bqhd', p_ctx, vc)
                + jnp.einsum('bhqrk,brkhd->bqhd', p_lat, vb))

    ox = lax.map(row_block, jnp.arange(rows))
    yx = jnp.moveaxis(ox, 0, 1).reshape(B, S, D) @ w_out
    yc = _attend(qc, kc, vc).reshape(B, C, D) @ w_out if need_ctx else None
    return yc, yx


def _rwkv7_prep(u, mu, w_in, w0, w1, w2, a0, a1, a2, g1, g2, k_k, k_a):
    B, L, D = u.shape
    H, N = RW_HEADS, RW_HEAD
    f32 = jnp.float32
    zero = jnp.zeros_like(u[:, :1])
    xx = 0.5 * (jnp.concatenate([zero, u[:, :-1]], axis=1) + jnp.concatenate([u[:, 1:], zero], axis=1)) - u
    xr, xw, xk, xv, xa, xg = [u + xx * mu[j] for j in range(6)]
    w_r, w_k, w_v = jnp.split(w_in, 3, axis=1)
    r = xr @ w_r
    k = xk @ w_k
    v = xv @ w_v
    lora_w = jnp.einsum('zblr,zrd->zbld', jnp.tanh(jnp.einsum('bld,zdr->zblr', xw, w1)), w2)
    w_log = -jax.nn.softplus(-(w0[:, None, None, :] + lora_w).astype(f32)) - 0.5
    decay = jnp.exp(-jnp.exp(w_log))
    a = jax.nn.sigmoid(a0[:, None, None, :]
                       + jnp.einsum('zblr,zrd->zbld', jnp.einsum('bld,zdr->zblr', xa, a1), a2))
    g = jax.nn.sigmoid(xg @ g1) @ g2
    kk = (k * k_k).reshape(B, L, H, N).astype(f32)
    kk = kk / jnp.maximum(jnp.linalg.norm(kk, axis=-1, keepdims=True), 1e-12)
    kd = k[None] * (1 + (a - 1) * k_a)

    def heads(t):
        return t.reshape(t.shape[:-1] + (H, N)).astype(f32)

    def two(t):
        return jnp.broadcast_to(t, (2,) + t.shape)

    def orient(t):
        t = jnp.stack([t[0], jnp.flip(t[1], axis=1)])
        return jnp.moveaxis(t, 2, 0)

    scan_in = (orient(two(heads(r))), orient(heads(decay)), orient(heads(kd)),
               orient(two(heads(v))), orient(two(-kk)), orient(kk[None] * heads(a)))
    return scan_in, (r, kd, v, g)


def _wkv7_scan(state0, r, w, k, v, a, b):
    def step(S, inp):
        rt, wt, kt, vt, at, bt = inp
        sa = jnp.einsum('zbhvk,zbhk->zbhv', S, at)
        S = S * wt[..., None, :] + sa[..., :, None] * bt[..., None, :] + vt[..., :, None] * kt[..., None, :]
        return S, jnp.einsum('zbhvk,zbhk->zbhv', S, rt)
    return lax.scan(step, state0, (r, w, k, v, a, b))


def _rwkv7_readout(y, r, kd, v, g, r_k, ln_g, ln_b, w_out):
    B, L, D = r.shape
    H, N = RW_HEADS, RW_HEAD
    y = jnp.moveaxis(y, 0, 2)
    y = y[0] + jnp.flip(y[1], axis=1)
    mean = jnp.mean(y, axis=-1, keepdims=True)
    var = jnp.mean(jnp.square(y - mean), axis=-1, keepdims=True)
    y = ((y - mean) * lax.rsqrt(var + RW_LN_EPS)).reshape(B, L, D).astype(r.dtype) * ln_g + ln_b
    rh = r.reshape(B, L, H, N)
    kh = (kd[0] + kd[1]).reshape(B, L, H, N)
    bonus = jnp.sum(rh * kh * r_k, axis=-1, keepdims=True) * v.reshape(B, L, H, N)
    return ((y + bonus.reshape(B, L, D)) * g) @ w_out


def _rwkv7_mixer(uc, ux, mu, w_in, w_out, w0, w1, w2, a0, a1, a2, g1, g2, k_k, k_a, r_k,
                 ln_g, ln_b, need_ctx):
    B = ux.shape[0]
    in_c, aux_c = _rwkv7_prep(uc, mu, w_in, w0, w1, w2, a0, a1, a2, g1, g2, k_k, k_a)
    in_x, aux_x = _rwkv7_prep(ux, mu, w_in, w0, w1, w2, a0, a1, a2, g1, g2, k_k, k_a)
    s0 = jnp.zeros((2, B, RW_HEADS, RW_HEAD, RW_HEAD), jnp.float32)
    s_ctx, y_c = _wkv7_scan(s0, *in_c)
    _, y_x = _wkv7_scan(s_ctx, *in_x)
    yx = _rwkv7_readout(y_x, *aux_x, r_k, ln_g, ln_b, w_out)
    yc = _rwkv7_readout(y_c, *aux_c, r_k, ln_g, ln_b, w_out) if need_ctx else None
    return yc, yx


def setup_inputs(seed: int = 0) -> dict:
    key = jax.random.key(seed)
    ks = iter(jax.random.split(key, 48))
    f32 = jnp.float32
    D, F = D_MODEL, D_FF
    n_a, n_b, n_c = [len(range(m, DEPTH, N_MIXERS)) for m in range(N_MIXERS)]

    def nrm(shape, scale):
        return jax.random.normal(next(ks), shape, f32) * scale

    def gain(shape):
        return 1.0 + nrm(shape, 0.05)

    return {
        'x': nrm((BATCH, SEQ, D), 1.0),
        'c': nrm((BATCH, D), 1.0),
        'ctx': nrm((BATCH, CTX_LEN, D), 1.0),
        'c_ctx': nrm((D,), 1.0),
        'ada_w': nrm((DEPTH, D, N_MOD * D), 0.5 * D ** -0.5),
        'ada_b': nrm((DEPTH, N_MOD * D), 0.02),
        'norm_g': gain((DEPTH, 6, D)),
        'ffn_w_in': nrm((DEPTH, 2, D, 2 * F), D ** -0.5),
        'ffn_w_out': nrm((DEPTH, 2, F, D), F ** -0.5),
        'da_w_in': nrm((n_a, D, 3 * D), D ** -0.5),
        'da_w_out': nrm((n_a, D, D), D ** -0.5),
        'da_lambda': nrm((n_a, 4, DA_HEAD_DIM), 0.1),
        'da_subln_g': gain((n_a, 2 * DA_HEAD_DIM)),
        'na_w_in': nrm((n_b, D, 3 * D), D ** -0.5),
        'na_w_out': nrm((n_b, D, D), D ** -0.5),
        'na_rpb': nrm((n_b, NA_HEADS, 2 * NA_ROWS - 1, 2 * NA_COLS - 1), 0.2),
        'rw_mu': jax.random.uniform(next(ks), (n_c, 6, D), f32),
        'rw_w_in': nrm((n_c, D, 3 * D), D ** -0.5),
        'rw_w_out': nrm((n_c, D, D), D ** -0.5),
        'rw_w0': jax.random.uniform(next(ks), (n_c, 2, D), f32, -6.0, -1.0),
        'rw_w1': nrm((n_c, 2, D, RW_DECAY_LORA), D ** -0.5),
        'rw_w2': nrm((n_c, 2, RW_DECAY_LORA, D), 0.1 * RW_DECAY_LORA ** -0.5),
        'rw_a0': nrm((n_c, 2, D), 0.1),
        'rw_a1': nrm((n_c, 2, D, RW_AAA_LORA), D ** -0.5),
        'rw_a2': nrm((n_c, 2, RW_AAA_LORA, D), RW_AAA_LORA ** -0.5),
        'rw_g1': nrm((n_c, D, RW_GATE_LORA), D ** -0.5),
        'rw_g2': nrm((n_c, RW_GATE_LORA, D), RW_GATE_LORA ** -0.5),
        'rw_k_k': 0.85 + nrm((n_c, D), 0.05),
        'rw_k_a': gain((n_c, D)),
        'rw_r_k': nrm((n_c, RW_HEADS, RW_HEAD), 0.1),
        'rw_ln_g': gain((n_c, D)),
        'rw_ln_b': nrm((n_c, D), 0.02),
    }


def reference(x, c, ctx, c_ctx, ada_w, ada_b, norm_g, ffn_w_in, ffn_w_out,
              da_w_in, da_w_out, da_lambda, da_subln_g,
              na_w_in, na_w_out, na_rpb,
              rw_mu, rw_w_in, rw_w_out, rw_w0, rw_w1, rw_w2, rw_a0, rw_a1, rw_a2,
              rw_g1, rw_g2, rw_k_k, rw_k_a, rw_r_k, rw_ln_g, rw_ln_b):
    B, S, D = x.shape
    cos, sin = _axial_rope_tables(S)
    hx, hc = x, ctx
    silu_c, silu_cc = jax.nn.silu(c), jax.nn.silu(c_ctx)
    for i in range(DEPTH):
        last = i == DEPTH - 1
        kind, slot = i % N_MIXERS, i // N_MIXERS
        g = norm_g[i]
        mx = (silu_c @ ada_w[i] + ada_b[i]).reshape(B, N_MOD, 1, D)
        mc = (silu_cc @ ada_w[i] + ada_b[i]).reshape(N_MOD, D)

        hx = _ffn_sublayer(hx, (mx[:, 0], mx[:, 1], mx[:, 2]), g[0], g[1], ffn_w_in[i, 0], ffn_w_out[i, 0])
        hc = _ffn_sublayer(hc, (mc[0], mc[1], mc[2]), g[0], g[1], ffn_w_in[i, 0], ffn_w_out[i, 0])

        ux = _modulate(_rmsnorm(hx, g[2]), mx[:, 3], mx[:, 4])
        uc = _modulate(_rmsnorm(hc, g[2]), mc[3], mc[4])
        if kind == 0:
            lam_init = 0.8 - 0.6 * math.exp(-0.3 * i)
            yc, yx = _diff_attention(uc, ux, da_w_in[slot], da_w_out[slot], da_lambda[slot],
                                     da_subln_g[slot], lam_init, cos, sin, not last)
        elif kind == 1:
            yc, yx = _neighbourhood_attention(uc, ux, na_w_in[slot], na_w_out[slot], na_rpb[slot], not last)
        else:
            yc, yx = _rwkv7_mixer(uc, ux, rw_mu[slot], rw_w_in[slot], rw_w_out[slot],
                                  rw_w0[slot], rw_w1[slot], rw_w2[slot],
                                  rw_a0[slot], rw_a1[slot], rw_a2[slot],
                                  rw_g1[slot], rw_g2[slot], rw_k_k[slot], rw_k_a[slot],
                                  rw_r_k[slot], rw_ln_g[slot], rw_ln_b[slot], not last)
        hx = hx + mx[:, 5] * _rmsnorm(yx, g[3])

        hx = _ffn_sublayer(hx, (mx[:, 6], mx[:, 7], mx[:, 8]), g[4], g[5], ffn_w_in[i, 1], ffn_w_out[i, 1])
        if not last:
            hc = hc + mc[5] * _rmsnorm(yc, g[3])
            hc = _ffn_sublayer(hc, (mc[6], mc[7], mc[8]), g[4], g[5], ffn_w_in[i, 1], ffn_w_out[i, 1])
    return hx
```

```cpp
#include <hip/hip_runtime.h>
#include <hip/hip_cooperative_groups.h>
#include <cstdio>
#include <cstdint>
namespace cg = cooperative_groups;
#ifndef REP_MASK
#define REP_MASK 0
#endif

#define LAS __attribute__((address_space(3)))
#define DI __device__ __forceinline__
typedef unsigned short bf16_t;
typedef short bf16x8 __attribute__((ext_vector_type(8)));
typedef short s16x4 __attribute__((ext_vector_type(4)));
typedef float f32x2 __attribute__((ext_vector_type(2)));
typedef float f32x4 __attribute__((ext_vector_type(4)));
typedef float f32x16 __attribute__((ext_vector_type(16)));
typedef unsigned u32x4 __attribute__((ext_vector_type(4)));
typedef unsigned u32x2 __attribute__((ext_vector_type(2)));
typedef __bf16 bf2_t __attribute__((ext_vector_type(2)));

constexpr int DM = 1024, NB = 16, SEQ = 2048, CTX = 256, LROW = 2304, MROWS = NB * LROW, FF = 2816, NMOD = 9216;
constexpr float NORM_EPS = 1e-6f;
constexpr float LOG2E = 1.4426950408889634f;
constexpr float QSCALE = 0.125f * LOG2E;

constexpr size_t MiB = 1u << 20;
constexpr size_t WS_MOD = 0, WS_ROPE = 3 * MiB, WS_LAM = 3 * MiB + 16384, WS_BAR = 3 * MiB + 32768, WS_CD = 4 * MiB, WS_HC = 9 * MiB, WS_WB = 25 * MiB,
                 WS_U = 75 * MiB, WS_ACT = 219 * MiB, WS_Y = 471 * MiB, WS_END = 543 * MiB;
constexpr size_t WB_IN0 = 0, WB_OUT0 = 5767168, WB_IN1 = 8650752, WB_OUT1 = 14417920, WB_MIXIN = 17301504, WB_MIXOUT = 24641536, WB_G2T = 25690112;
constexpr int LDS_BYTES = 147456;

DI unsigned pk2(float lo, float hi) { f32x2 v = {lo, hi}; bf2_t b = __builtin_convertvector(v, bf2_t); return __builtin_bit_cast(unsigned, b); }
DI float bf2f(bf16_t h) { return __uint_as_float(((unsigned)h) << 16); }
DI float bflo(unsigned w) { return __uint_as_float(w << 16); }
DI float bfhi(unsigned w) { return __uint_as_float(w & 0xffff0000u); }
DI float wave_sum(float v) {
#pragma unroll
    for (int o = 1; o < 64; o <<= 1) v += __shfl_xor(v, o);
    return v;
}
#define LDS_BARRIER() asm volatile("s_waitcnt lgkmcnt(0)\n\ts_barrier" ::: "memory")
DI float fast_exp(float x) { return __builtin_amdgcn_exp2f(x * LOG2E); }
DI float sigmoidf_(float x) { return __builtin_amdgcn_rcpf(1.f + fast_exp(-x)); }
DI float siluf_(float x) { return x * sigmoidf_(x); }
DI float tanhf_(float x) { return 1.f - 2.f * __builtin_amdgcn_rcpf(1.f + fast_exp(2.f * x)); }

namespace pg8 {
constexpr int BM = 256, BK = 64, HALF = 128, HTB = HALF * BK * 2, NXCD = 8, WGM = 4;
__host__ __device__ __forceinline__ int lds_byte(int r, int c) { const int st = (r >> 4) * 2 + (c >> 5), rr = r & 15, cc = c & 31, ob = rr * 64 + cc * 2; return st * 1024 + (ob ^ (((ob >> 9) & 1) << 5)); }
__host__ __device__ __forceinline__ void stage_rc(int b, int& R, int& C) { const int st = b / 1024, sb = b % 1024, swz = sb ^ (((sb >> 9) & 1) << 5); R = (st >> 1) * 16 + swz / 64; C = (st & 1) * 32 + (swz % 64) / 2; }
__host__ __device__ __forceinline__ int perm32(int rho) { const int n = rho >> 4, i = rho & 15; return 8 * (i >> 2) + 4 * n + (i & 3); }

struct Unit { int pm, pn; };
struct Gemm { const bf16_t* A; const bf16_t* Bt; int lda, ldb, N, K, nM, skip; };

struct StaticOrder {
    int nM, nN, nwg, G, c, skip;
    int pmode, r0, nr;
    DI void init(int nM_, int N, int G_, int c_, int skip_) { nM = nM_; nN = N / BM; nwg = nM * nN; G = G_; c = c_; skip = skip_; pmode = 0; r0 = 0; nr = 0; }
    DI bool next(int i, Unit& u) const {
        if (pmode) {
            if (i >= nr) return false;
            const int round = r0 + i, xcd = c & 7, j = c >> 3, full = nM >> 6; int panel;
            if (round < full) { panel = round * 64 + xcd * 8 + (j & 7); u.pn = j >> 3; }
            else { if (j >= 8) return false; panel = full * 64 + 2 * xcd + (j & 1); u.pn = j >> 1; if (panel >= nM) return false; }
            u.pm = skip ? (panel + panel / 8 + 1) : panel;
            return true;
        }
        const long L = (long)i * G + c; if (L >= nwg) return false;
        int wgid = (int)L; { const int q = nwg / NXCD, r = nwg % NXCD, xcd = wgid % NXCD, off = wgid / NXCD; wgid = (xcd < r ? xcd * (q + 1) : r * (q + 1) + (xcd - r) * q) + off; }
        const int nig = WGM * nN, gid = wgid / nig, fm = gid * WGM, gsz = (nM - fm) < WGM ? (nM - fm) : WGM;
        int pm = fm + ((wgid % nig) % gsz); u.pn = (wgid % nig) / gsz;
        u.pm = skip ? (pm + pm / 8 + 1) : pm;
        return true;
    }
};

enum { EPI_PLAIN = 0, EPI_SWIGLU = 1, EPI_QKV_DA = 2, EPI_QKV_NA = 3, EPI_RWKV = 4 };
struct Epi {
    static constexpr bool PERM = true;
    int mode; bf16_t* O; int ldc; const float* cosT; const float* sinT;
    DI void operator()(const f32x4 (&acc)[2][2][4][2], const Unit& u, int wr, int wc, int fr, int fq) const {
        const int row0 = u.pm * BM + wr * 64 + fr;
        if (mode == EPI_SWIGLU) {
            const int col0 = u.pn * 128 + wc * 32 + 8 * fq;
#pragma unroll
            for (int ai = 0; ai < 2; ++ai)
#pragma unroll
                for (int m = 0; m < 4; ++m) {
                    bf16_t* rowp = O + (size_t)(row0 + ai * HALF + m * 16) * ldc + col0;
                    const f32x4 a0 = acc[ai][0][m][0], a1 = acc[ai][0][m][1], b0 = acc[ai][1][m][0], b1 = acc[ai][1][m][1];
                    u32x4 w;
                    w.x = pk2(siluf_(a0[0]) * b0[0], siluf_(a0[1]) * b0[1]); w.y = pk2(siluf_(a0[2]) * b0[2], siluf_(a0[3]) * b0[3]);
                    w.z = pk2(siluf_(a1[0]) * b1[0], siluf_(a1[1]) * b1[1]); w.w = pk2(siluf_(a1[2]) * b1[2], siluf_(a1[3]) * b1[3]);
                    *(u32x4*)rowp = w;
                }
        } else {
            const int col0 = u.pn * BM + wc * 32 + 8 * fq;
            const int jt = u.pm % 9;
            float sc = 1.f; bool rope = false; int act0 = 0, act1 = 0;
            if (mode == EPI_QKV_DA) { if (u.pn < 4) sc = QSCALE; if (u.pn < 8 && jt != 0) rope = true; }
            else if (mode == EPI_QKV_NA) { if (u.pn < 4) sc = QSCALE; }
            else if (mode == EPI_RWKV) { if (u.pn == 12) act0 = 1; if (u.pn == 13) { act0 = 2; act1 = 2; } }
#pragma unroll
            for (int ai = 0; ai < 2; ++ai)
#pragma unroll
                for (int m = 0; m < 4; ++m) {
                    bf16_t* rowp = O + (size_t)(row0 + ai * HALF + m * 16) * ldc + col0;
                    f32x4 c0 = {1.f, 1.f, 1.f, 1.f}, c1 = c0, s0 = {0.f, 0.f, 0.f, 0.f}, s1 = s0;
                    if (rope) {
                        const int t = (jt - 1) * 256 + ai * HALF + wr * 64 + m * 16 + fr;
                        const int pos = (wc & 1) ? (t & 63) : (t >> 6);
                        const float* cp = cosT + pos * 16 + 8 * (fq & 1); const float* sp = sinT + pos * 16 + 8 * (fq & 1);
                        c0 = *(const f32x4*)cp; c1 = *(const f32x4*)(cp + 4); s0 = *(const f32x4*)sp; s1 = *(const f32x4*)(sp + 4);
                        if (!(fq & 2)) { s0 = -s0; s1 = -s1; }
                    }
#pragma unroll
                    for (int bj = 0; bj < 2; ++bj) {
                        f32x4 v0 = acc[ai][bj][m][0], v1 = acc[ai][bj][m][1];
                        if (rope) {
                            f32x4 p0, p1;
#pragma unroll
                            for (int e = 0; e < 4; ++e) { p0[e] = __shfl_xor(v0[e], 32); p1[e] = __shfl_xor(v1[e], 32); }
                            v0 = v0 * c0 + p0 * s0; v1 = v1 * c1 + p1 * s1;
                        }
                        v0 = v0 * sc; v1 = v1 * sc;
                        const int act = bj ? act1 : act0;
                        if (act == 1) {
#pragma unroll
                            for (int e = 0; e < 4; ++e) { v0[e] = tanhf_(v0[e]); v1[e] = tanhf_(v1[e]); }
                        } else if (act == 2) {
#pragma unroll
                            for (int e = 0; e < 4; ++e) { v0[e] = sigmoidf_(v0[e]); v1[e] = sigmoidf_(v1[e]); }
                        }
                        u32x4 w; w.x = pk2(v0[0], v0[1]); w.y = pk2(v0[2], v0[3]); w.z = pk2(v1[0], v1[1]); w.w = pk2(v1[2], v1[3]);
                        *(u32x4*)(rowp + bj * HALF) = w;
                    }
                }
        }
    }
};

DI void gemm_phase(LAS unsigned char* lds, const int tid, const Gemm g, const StaticOrder& S, const Epi& E) {
    const int wid = __builtin_amdgcn_readfirstlane(tid >> 6), lane = tid & 63, wr = wid >> 2, wc = wid & 3, fr = lane & 15, fq = lane >> 4;
    const int K = g.K, nt = K / BK;
    unsigned voffA[2], voffB[2];
#pragma unroll
    for (int i = 0; i < 2; ++i) { int R, C; stage_rc(tid * 16 + i * 8192, R, C); const int Rb = (R & ~31) + perm32(R & 31);
        voffA[i] = (unsigned)(R * g.lda + C) * 2u; voffB[i] = (unsigned)(Rb * g.ldb + C) * 2u; }
    const size_t kstep = (size_t)(BK * 2);
    const size_t hstepA = (size_t)HALF * g.lda * 2, hstepB = (size_t)HALF * g.ldb * 2;
    const size_t tstepA = 2 * hstepA, tstepB = 2 * hstepB;
    const unsigned ldsw = (unsigned)wid * 1024u;
    const int aoff = lds_byte(wr * 64 + fr, fq * 8), boff = lds_byte(wc * 32 + fr, fq * 8);
#define PG8_SA(b, h) (((b) * 2 + (h)) * HTB)
#define PG8_SB(b, h) ((4 + (b) * 2 + (h)) * HTB)
#define PG8_STAGE(bufoff, gbase, voff) do { _Pragma("unroll") for (int _i = 0; _i < 2; ++_i) \
        __builtin_amdgcn_global_load_lds((const unsigned*)((const char*)(gbase) + (voff)[_i]), (LAS unsigned*)(lds + (bufoff) + ldsw + _i * 8192), 16, 0, 0); } while (0)
#define PG8_LDA(dst, b, h) do { _Pragma("unroll") for (int m = 0; m < 4; ++m) _Pragma("unroll") for (int k = 0; k < 2; ++k) dst[m][k] = *(const LAS bf16x8*)(lds + PG8_SA(b, h) + aoff + m * 2048 + k * 1024); } while (0)
#define PG8_LDB(dst, b, h) do { _Pragma("unroll") for (int n = 0; n < 2; ++n) _Pragma("unroll") for (int k = 0; k < 2; ++k) dst[n][k] = *(const LAS bf16x8*)(lds + PG8_SB(b, h) + boff + n * 2048 + k * 1024); } while (0)
#define PG8_MMA(ai, bj, At, Bt) do { __builtin_amdgcn_s_setprio(1); _Pragma("unroll") for (int m = 0; m < 4; ++m) _Pragma("unroll") for (int n = 0; n < 2; ++n) _Pragma("unroll") for (int k = 0; k < 2; ++k) \
        acc[ai][bj][m][n] = __builtin_amdgcn_mfma_f32_16x16x32_bf16(Bt[n][k], At[m][k], acc[ai][bj][m][n], 0, 0, 0); __builtin_amdgcn_s_setprio(0); } while (0)
#define PG8_WAIT_V(n) asm volatile("s_waitcnt vmcnt(" #n ")" ::: "memory")
#define PG8_WAIT_L(n) asm volatile("s_waitcnt lgkmcnt(" #n ")" ::: "memory")
#define PG8_BAR __builtin_amdgcn_s_barrier()
#define PG8_SCHED __builtin_amdgcn_sched_barrier(0)
    Unit cur, nxt; int ui = 0;
    if (!S.next(0, cur)) return;
    f32x4 acc[2][2][4][2];
#pragma unroll
    for (int a = 0; a < 2; ++a)
#pragma unroll
        for (int b = 0; b < 2; ++b)
#pragma unroll
            for (int m = 0; m < 4; ++m)
#pragma unroll
                for (int n = 0; n < 2; ++n) acc[a][b][m][n] = (f32x4){0.f, 0.f, 0.f, 0.f};
    bf16x8 At[4][2], B0[2][2], B1[2][2];
    const char* cA = (const char*)g.A + (size_t)cur.pm * tstepA; const char* cB = (const char*)g.Bt + (size_t)cur.pn * tstepB;
    PG8_STAGE(PG8_SB(0, 0), cB, voffB); PG8_STAGE(PG8_SB(0, 1), cB + hstepB, voffB); PG8_STAGE(PG8_SA(0, 0), cA, voffA); PG8_STAGE(PG8_SA(0, 1), cA + hstepA, voffA);
    if (wr == 1) PG8_BAR;
    PG8_WAIT_V(2); PG8_BAR;
    PG8_STAGE(PG8_SB(1, 0), cB + kstep, voffB); PG8_STAGE(PG8_SA(1, 0), cA + kstep, voffA); PG8_STAGE(PG8_SB(1, 1), cB + hstepB + kstep, voffB);
    PG8_WAIT_V(6); PG8_BAR;
    for (;;) {
        const bool has_next = S.next(ui + 1, nxt);
        const char* nA = has_next ? (const char*)g.A + (size_t)nxt.pm * tstepA : cA; const char* nB = has_next ? (const char*)g.Bt + (size_t)nxt.pn * tstepB : cB;
        for (int t = 0; t < nt; t += 2) {
            const bool last = (t == nt - 2);
            const char* a1 = cA + (size_t)(t + 1) * kstep;
            const char* a2 = last ? nA : cA + (size_t)(t + 2) * kstep; const char* b2 = last ? nB : cB + (size_t)(t + 2) * kstep;
            const char* a3 = a2 + kstep; const char* b3 = b2 + kstep;
            PG8_LDB(B0, 0, 0); PG8_LDB(B1, 0, 1); PG8_SCHED; PG8_LDA(At, 0, 0); PG8_STAGE(PG8_SA(1, 1), a1 + hstepA, voffA);
            PG8_WAIT_V(8); PG8_WAIT_L(0); PG8_BAR; PG8_MMA(0, 0, At, B0); PG8_MMA(0, 1, At, B1); PG8_BAR; PG8_SCHED;
            PG8_LDA(At, 0, 1); PG8_STAGE(PG8_SB(0, 0), b2, voffB); PG8_STAGE(PG8_SB(0, 1), b2 + hstepB, voffB); PG8_STAGE(PG8_SA(0, 0), a2, voffA);
            PG8_WAIT_V(8); PG8_WAIT_L(0); PG8_BAR; PG8_MMA(1, 0, At, B0); PG8_MMA(1, 1, At, B1); PG8_BAR; PG8_SCHED;
            PG8_LDB(B0, 1, 0); PG8_LDB(B1, 1, 1); PG8_SCHED; PG8_LDA(At, 1, 0); PG8_STAGE(PG8_SA(0, 1), a2 + hstepA, voffA);
            PG8_WAIT_V(8); PG8_WAIT_L(0); PG8_BAR; PG8_MMA(0, 0, At, B0); PG8_MMA(0, 1, At, B1); PG8_BAR; PG8_SCHED;
            PG8_LDA(At, 1, 1); PG8_STAGE(PG8_SB(1, 0), b3, voffB); PG8_STAGE(PG8_SB(1, 1), b3 + hstepB, voffB); PG8_STAGE(PG8_SA(1, 0), a3, voffA);
            PG8_WAIT_V(8); PG8_WAIT_L(0); PG8_BAR; PG8_MMA(1, 0, At, B0); PG8_MMA(1, 1, At, B1); PG8_BAR; PG8_SCHED;
        }
        if (wr == 0) PG8_BAR;
        E(acc, cur, wr, wc, fr, fq);
        if (!has_next) break;
#pragma unroll
        for (int a = 0; a < 2; ++a)
#pragma unroll
            for (int b = 0; b < 2; ++b)
#pragma unroll
                for (int m = 0; m < 4; ++m)
#pragma unroll
                    for (int n = 0; n < 2; ++n) acc[a][b][m][n] = (f32x4){0.f, 0.f, 0.f, 0.f};
        cur = nxt; cA = nA; cB = nB; ++ui;
        if (wr == 1) PG8_BAR;
    }
    PG8_WAIT_V(0);
    PG8_BAR;
#undef PG8_SA
#undef PG8_SB
#undef PG8_STAGE
#undef PG8_LDA
#undef PG8_LDB
#undef PG8_MMA
#undef PG8_WAIT_V
#undef PG8_WAIT_L
#undef PG8_BAR
#undef PG8_SCHED
}
}

struct Args { const float* in[32]; float* out; unsigned char* ws; };

struct Frame {
    LAS unsigned char* lds;
    int tid, lane, wave, vcu, G, gw, NGW, bx;
    const float* const* in;
};
enum { I_X = 0, I_C, I_CTX, I_CCTX, I_ADAW, I_ADAB, I_NORMG, I_FWIN, I_FWOUT, I_DAWIN, I_DAWOUT, I_DALAM, I_DASUB, I_NAWIN, I_NAWOUT, I_NARPB,
       I_RWMU, I_RWWIN, I_RWWOUT, I_RWW0, I_RWW1, I_RWW2, I_RWA0, I_RWA1, I_RWA2, I_RWG1, I_RWG2, I_RWKK, I_RWKA, I_RWRK, I_RWLNG, I_RWLNB };

DI void conv_item(const float* W, int ldw, int k0, int n0, int kmax, const float* mu, bf16_t* dst, int ldd, int dst_row0, int dst_k0, LAS float* scr, int lane) {
#pragma unroll 8
    for (int i = 0; i < 32; ++i) { const int kk = 2 * i + (lane >> 5); const int k = k0 + kk;
        float v = 0.f; if (k < kmax) { v = W[(size_t)k * ldw + n0 + (lane & 31)]; if (mu) v *= mu[k]; }
        scr[kk * 33 + (lane & 31)] = v; }
    asm volatile("s_waitcnt lgkmcnt(0)" ::: "memory");
    const int c = lane & 7;
#pragma unroll
    for (int j = 0; j < 4; ++j) { const int n = (lane >> 3) + 8 * j; const LAS float* s = scr + (8 * c) * 33 + n;
        u32x4 o; o.x = pk2(s[0 * 33], s[1 * 33]); o.y = pk2(s[2 * 33], s[3 * 33]); o.z = pk2(s[4 * 33], s[5 * 33]); o.w = pk2(s[6 * 33], s[7 * 33]);
        *(u32x4*)(dst + (size_t)(dst_row0 + n) * ldd + dst_k0 + k0 + 8 * c) = o; }
    asm volatile("s_waitcnt lgkmcnt(0)" ::: "memory");
}

DI void convert_layer(Frame& F, unsigned char* ws, int l) {
    bf16_t* WB = (bf16_t*)(ws + WS_WB);
    LAS float* scr = (LAS float*)(F.lds + F.wave * 16384);
    const int kind = l % 3, slot = l / 3;
    constexpr int I_FIN = 16 * 176, I_FOUT = 44 * 32, I_MIN = 16 * 96, I_MOUT = 16 * 32;
    const float* fwin = F.in[I_FWIN] + (size_t)l * 2 * 1024 * 5632;
    const float* fwout = F.in[I_FWOUT] + (size_t)l * 2 * 2816 * 1024;
    int nitems = 2 * I_FIN + 2 * I_FOUT + I_MOUT;
    if (kind == 2) nitems += 2 * I_MIN + 4 * 16 * 2 * 2 + 16 * 5 * 2 + 4 * 32 + 96;
    else nitems += I_MIN;
    for (int it = F.gw; it < nitems; it += F.NGW) {
        int r = it;
        if (r < 2 * I_FIN) { const int s = r / I_FIN; r -= s * I_FIN; const int kb = r / 176, nb = r % 176, n0 = nb * 32;
            const int hf = n0 / 2816, rem = n0 % 2816, p = rem / 128, i = rem % 128;
            conv_item(fwin + (size_t)s * 1024 * 5632, 5632, kb * 64, n0, 1024, nullptr, WB + (s ? WB_IN1 : WB_IN0), 1024, p * 256 + hf * 128 + i, 0, scr, F.lane); continue; }
        r -= 2 * I_FIN;
        if (r < 2 * I_FOUT) { const int s = r / I_FOUT; r -= s * I_FOUT; const int kb = r / 32, nb = r % 32;
            conv_item(fwout + (size_t)s * 2816 * 1024, 1024, kb * 64, nb * 32, 2816, nullptr, WB + (s ? WB_OUT1 : WB_OUT0), 2816, nb * 32, 0, scr, F.lane); continue; }
        r -= 2 * I_FOUT;
        if (r < I_MOUT) { const float* w = kind == 0 ? F.in[I_DAWOUT] + (size_t)slot * 1024 * 1024 : kind == 1 ? F.in[I_NAWOUT] : F.in[I_RWWOUT];
            const int kb = r / 32, nb = r % 32;
            conv_item(w, 1024, kb * 64, nb * 32, 1024, nullptr, WB + WB_MIXOUT, 1024, nb * 32, 0, scr, F.lane); continue; }
        r -= I_MOUT;
        if (kind != 2) { const float* w = kind == 0 ? F.in[I_DAWIN] + (size_t)slot * 1024 * 3072 : F.in[I_NAWIN];
            const int kb = r / 96, nb = r % 96;
            conv_item(w, 3072, kb * 64, nb * 32, 1024, nullptr, WB + WB_MIXIN, 1024, nb * 32, 0, scr, F.lane); continue; }
        const float* mu = F.in[I_RWMU];
        if (r < 2 * I_MIN) { const int var = r / I_MIN; r -= var * I_MIN; const int kb = r / 96, nb = r % 96, n0 = nb * 32;
            const int mj = n0 < 1024 ? 0 : (n0 < 2048 ? 2 : 3);
            conv_item(F.in[I_RWWIN], 3072, kb * 64, n0, 1024, var ? mu + mj * 1024 : nullptr, WB + WB_MIXIN, 2048, n0, var * 1024, scr, F.lane); continue; }
        r -= 2 * I_MIN;
        if (r < 4 * 16 * 2 * 2) { const int var = r & 1; r >>= 1; const int nb = r & 1; r >>= 1; const int kb = r & 15; r >>= 4; const int dir = r & 1, isa = r >> 1;
            const float* w = (isa ? F.in[I_RWA1] : F.in[I_RWW1]) + (size_t)dir * 1024 * 64;
            conv_item(w, 64, kb * 64, nb * 32, 1024, var ? mu + (isa ? 4 : 1) * 1024 : nullptr, WB + WB_MIXIN, 2048, (isa ? 3200 : 3072) + dir * 64 + nb * 32, var * 1024, scr, F.lane); continue; }
        r -= 4 * 16 * 2 * 2;
        if (r < 16 * 5 * 2) { const int var = r & 1; r >>= 1; const int nb = r % 5, kb = r / 5;
            conv_item(F.in[I_RWG1], 160, kb * 64, nb * 32, 1024, var ? mu + 5 * 1024 : nullptr, WB + WB_MIXIN, 2048, 3328 + nb * 32, var * 1024, scr, F.lane); continue; }
        r -= 16 * 5 * 2;
        if (r < 4 * 32) { const int kb = r / 32, nb = r % 32;
            conv_item(F.in[I_RWG2], 1024, kb * 64, nb * 32, 160, nullptr, WB + WB_G2T, 256, nb * 32, 0, scr, F.lane); continue; }
        r -= 4 * 32;
        { bf16_t* z = WB + WB_MIXIN + (size_t)(3488 + r) * 2048;
#pragma unroll
          for (int j = 0; j < 4; ++j) *(u32x4*)(z + (j * 64 + F.lane) * 8) = (u32x4){0u, 0u, 0u, 0u}; }
    }
}

DI void phase0(Frame& F, unsigned char* ws) {
    LAS float* sl = (LAS float*)F.lds;
    LAS float* part = (LAS float*)(F.lds + 69632);
    float* MOD = (float*)(ws + WS_MOD);
    for (int i = F.tid; i < 17 * 1024; i += 512) { const float v = i < 16384 ? F.in[I_C][i] : F.in[I_CCTX][i - 16384]; sl[i] = v / (1.f + expf(-v)); }
    __syncthreads();
    for (int item = F.vcu; item < 4 * 72; item += F.G) {
        const int l = item / 72, n0 = (item % 72) * 128;
        const float* W = F.in[I_ADAW] + (size_t)l * 1024 * NMOD + n0 + 2 * F.lane;
        float acc[17][2];
#pragma unroll
        for (int r = 0; r < 17; ++r) { acc[r][0] = 0.f; acc[r][1] = 0.f; }
        const int kbase = F.wave * 128;
        for (int k4 = 0; k4 < 128; k4 += 4) {
            f32x2 w[4];
#pragma unroll
            for (int e = 0; e < 4; ++e) w[e] = *(const f32x2*)(W + (size_t)(kbase + k4 + e) * NMOD);
#pragma unroll
            for (int r = 0; r < 17; ++r) { const f32x4 s = *(const LAS f32x4*)(sl + r * 1024 + kbase + k4);
#pragma unroll
                for (int e = 0; e < 4; ++e) { acc[r][0] += s[e] * w[e].x; acc[r][1] += s[e] * w[e].y; } }
        }
#pragma unroll
        for (int r = 0; r < 17; ++r) *(LAS f32x2*)(part + (F.wave * 17 + r) * 128 + 2 * F.lane) = (f32x2){acc[r][0], acc[r][1]};
        __syncthreads();
        for (int idx = F.tid; idx < 17 * 128; idx += 512) { const int r = idx >> 7, cI = idx & 127; float s = 0.f;
#pragma unroll
            for (int w = 0; w < 8; ++w) s += part[(w * 17 + r) * 128 + cI];
            MOD[((size_t)l * 17 + r) * NMOD + n0 + cI] = s + F.in[I_ADAB][(size_t)l * NMOD + n0 + cI]; }
        __syncthreads();
    }
    if (F.bx == 0) {
        for (int i = F.tid; i < 3456; i += 512) ((unsigned*)(ws + WS_BAR))[i] = 0u;
        float* cosT = (float*)(ws + WS_ROPE); float* sinT = cosT + 1024;
        for (int i = F.tid; i < 1024; i += 512) { const int pos = i >> 4, p = i & 15; const float fr = powf(10000.f, -(float)p / 16.f); const float ang = (float)pos * fr; cosT[i] = cosf(ang); sinT[i] = sinf(ang); }
        if (F.tid < 2) { const float* lv = F.in[I_DALAM] + F.tid * 256; float d0 = 0.f, d1 = 0.f;
            for (int i = 0; i < 64; ++i) { d0 += lv[i] * lv[64 + i]; d1 += lv[128 + i] * lv[192 + i]; }
            const float li = 0.8f - 0.6f * expf(-0.3f * (float)(F.tid * 3));
            float* lam = (float*)(ws + WS_LAM); lam[2 * F.tid] = expf(d0) - expf(d1) + li; lam[2 * F.tid + 1] = li; }
    }
    __syncthreads();
    convert_layer(F, ws, 0);
}

struct RowPass {
    const float* hsrc_lat; const float* hsrc_ctx; float* hdst_lat; float* hdst_ctx;
    const bf16_t* Y;
    const float* gpost; int gate_idx; float coef; int lpost;
    const float* gpre; int shift_idx; int lpre;
    bf16_t* U; int ldu; int skip_ctx;
};
DI void row_pass(Frame& F, unsigned char* ws, const RowPass& P, int row_lo, int row_hi, int widx, int nw) {
    const float* MOD = (const float*)(ws + WS_MOD);
    const int rpw = (row_hi - row_lo + nw - 1) / nw;
    const int rbeg = row_lo + widx * rpw, rend = min(rbeg + rpw, row_hi);
    if (rbeg >= rend) return;
    const int l4 = 4 * F.lane;
    f32x4 gpo[4], gpr[4], gat[4], shf[4], scl[4];
#pragma unroll
    for (int j = 0; j < 4; ++j) { gpo[j] = *(const f32x4*)(P.gpost + l4 + 256 * j); gpr[j] = P.gpre ? *(const f32x4*)(P.gpre + l4 + 256 * j) : (f32x4){0.f, 0.f, 0.f, 0.f}; }
    int cur_mrow = -1;
    f32x4 hn[4]; u32x2 yn[4];
#define RP_ADDR(row, isctx, hoff) const int _b = (row) / LROW, _t = (row) % LROW; const bool isctx = _t < CTX; \
        const size_t hoff = isctx ? ((size_t)_b * CTX + _t) * DM : ((size_t)_b * SEQ + (_t - CTX)) * DM;
#define RP_LOAD(row) do { RP_ADDR(row, ic_, ho_) if (!(ic_ && P.skip_ctx)) { const float* hs_ = (ic_ ? P.hsrc_ctx : P.hsrc_lat) + ho_ + l4; \
        _Pragma("unroll") for (int j = 0; j < 4; ++j) hn[j] = *(const f32x4*)(hs_ + 256 * j); \
        if (P.Y) { const bf16_t* yr_ = P.Y + (size_t)(row) * DM + l4; _Pragma("unroll") for (int j = 0; j < 4; ++j) yn[j] = *(const u32x2*)(yr_ + 256 * j); } } } while (0)
    RP_LOAD(rbeg);
    for (int row = rbeg; row < rend; ++row) {
        f32x4 h[4]; u32x2 yv[4];
#pragma unroll
        for (int j = 0; j < 4; ++j) { h[j] = hn[j]; yv[j] = yn[j]; }
        if (row + 1 < rend) RP_LOAD(row + 1);
        RP_ADDR(row, isctx, hoff)
        if (isctx && P.skip_ctx) continue;
        float* hd = (isctx ? P.hdst_ctx : P.hdst_lat) + hoff + l4;
        const bool copy_h = ((isctx ? P.hsrc_ctx : P.hsrc_lat) != (isctx ? P.hdst_ctx : P.hdst_lat));
        const int mrow = isctx ? 16 : _b;
        if (mrow != cur_mrow) { cur_mrow = mrow;
            const float* gate = MOD + ((size_t)P.lpost * 17 + mrow) * NMOD + P.gate_idx * DM + l4;
            const float* sh = MOD + ((size_t)P.lpre * 17 + mrow) * NMOD + P.shift_idx * DM + l4;
#pragma unroll
            for (int j = 0; j < 4; ++j) { gat[j] = *(const f32x4*)(gate + 256 * j) * P.coef; shf[j] = *(const f32x4*)(sh + 256 * j); scl[j] = *(const f32x4*)(sh + DM + 256 * j) + 1.f; } }
        if (P.Y) {
            f32x4 y[4]; float ss = 0.f;
#pragma unroll
            for (int j = 0; j < 4; ++j) { y[j] = (f32x4){bflo(yv[j].x), bfhi(yv[j].x), bflo(yv[j].y), bfhi(yv[j].y)};
                ss += (y[j].x * y[j].x + y[j].y * y[j].y) + (y[j].z * y[j].z + y[j].w * y[j].w); }
            const float rstd = 1.f / sqrtf(wave_sum(ss) * (1.f / DM) + NORM_EPS);
#pragma unroll
            for (int j = 0; j < 4; ++j) h[j] = h[j] + gat[j] * ((y[j] * rstd) * gpo[j]);
        }
        if (P.Y || copy_h) {
#pragma unroll
            for (int j = 0; j < 4; ++j) *(f32x4*)(hd + 256 * j) = h[j];
        }
        if (P.gpre) {
            float ss = 0.f;
#pragma unroll
            for (int j = 0; j < 4; ++j) ss += (h[j].x * h[j].x + h[j].y * h[j].y) + (h[j].z * h[j].z + h[j].w * h[j].w);
            const float rstd = 1.f / sqrtf(wave_sum(ss) * (1.f / DM) + NORM_EPS);
            bf16_t* ur = P.U + (size_t)row * P.ldu + l4;
#pragma unroll
            for (int j = 0; j < 4; ++j) { const f32x4 u = ((h[j] * rstd) * gpr[j]) * scl[j] + shf[j];
                *(u32x2*)(ur + 256 * j) = (u32x2){pk2(u.x, u.y), pk2(u.z, u.w)}; }
        }
    }
#undef RP_ADDR
#undef RP_LOAD
}

DI void xx_pass(Frame& F, unsigned char* ws) {
    bf16_t* U = (bf16_t*)(ws + WS_U);
    for (int row = F.gw; row < MROWS; row += F.NGW) {
        const int t = row % LROW;
        const bool first = (t == 0) || (t == CTX), lastr = (t == CTX - 1) || (t == LROW - 1);
        const bf16_t* ur = U + (size_t)row * 2048 + 8 * F.lane;
#pragma unroll
        for (int j = 0; j < 2; ++j) {
            const u32x4 c = *(const u32x4*)(ur + 512 * j);
            u32x4 p = {0u, 0u, 0u, 0u}, n = {0u, 0u, 0u, 0u};
            if (!first) p = *(const u32x4*)(ur - 2048 + 512 * j);
            if (!lastr) n = *(const u32x4*)(ur + 2048 + 512 * j);
            u32x4 o;
#pragma unroll
            for (int e = 0; e < 4; ++e) { const float lo = 0.5f * (bflo(p[e]) + bflo(n[e])) - bflo(c[e]); const float hi = 0.5f * (bfhi(p[e]) + bfhi(n[e])) - bfhi(c[e]); o[e] = pk2(lo, hi); }
            *(u32x4*)((bf16_t*)ur + 1024 + 512 * j) = o;
        }
    }
}

DI f32x16 mfma32(bf16x8 a, bf16x8 b, f32x16 c) { return __builtin_amdgcn_mfma_f32_32x32x16_bf16(a, b, c, 0, 0, 0); }
DI bf16x8 pack8(const f32x16& x, int s) { u32x4 p; p.x = pk2(x[8 * s], x[8 * s + 1]); p.y = pk2(x[8 * s + 2], x[8 * s + 3]); p.z = pk2(x[8 * s + 4], x[8 * s + 5]); p.w = pk2(x[8 * s + 6], x[8 * s + 7]); return __builtin_bit_cast(bf16x8, p); }
typedef short v4i16_t __attribute__((ext_vector_type(4)));
DI s16x4 vtr(LAS const unsigned char* p) { return __builtin_bit_cast(s16x4, __builtin_amdgcn_ds_read_tr16_b64_v4i16((LAS v4i16_t*)p)); }
DI float max3f(float a, float b, float c) { return __builtin_fmaxf(__builtin_fmaxf(a, b), c); }
DI float max16(const f32x16& p) { float a = max3f(p[0], p[1], p[2]), b = max3f(p[3], p[4], p[5]);
    a = max3f(a, p[6], p[7]); b = max3f(b, p[8], p[9]); a = max3f(a, p[10], p[11]); b = max3f(b, p[12], p[13]); a = max3f(a, p[14], p[15]); return __builtin_fmaxf(a, b); }

template <int NDB>
DI void softmax_pv(f32x16& p0, f32x16& p1, f32x16 (&o)[NDB], f32x16& negm, float& m_run, float& l_run, const bool first, LAS float* wsf, LAS const unsigned char* Vb, int KP, int r, int hh, int lane) {
    float mx = __builtin_fmaxf(max16(p0), max16(p1)); mx = __builtin_fmaxf(mx, __shfl_xor(mx, 32));
    if (first || __any(mx > 8.f)) {
        const float delta = first ? mx : __builtin_fmaxf(mx, 0.f);
        m_run += delta;
#pragma unroll
        for (int i = 0; i < 16; ++i) { p0[i] -= delta; p1[i] -= delta; negm[i] = -m_run; }
        if (!first) {
            const float alpha = __builtin_amdgcn_exp2f(-delta);
            l_run *= alpha;
            if (hh == 0) wsf[r] = alpha;
#pragma unroll
            for (int g4 = 0; g4 < 4; ++g4) { const f32x4 a4 = *(const LAS f32x4*)(wsf + 8 * g4 + 4 * hh);
#pragma unroll
                for (int d = 0; d < NDB; ++d)
#pragma unroll
                    for (int e = 0; e < 4; ++e) o[d][4 * g4 + e] *= a4[e]; }
        }
    }
    f32x2 ls2 = {0.f, 0.f};
#pragma unroll
    for (int i = 0; i < 16; i += 2) {
        p0[i] = __builtin_amdgcn_exp2f(p0[i]); p0[i + 1] = __builtin_amdgcn_exp2f(p0[i + 1]); p1[i] = __builtin_amdgcn_exp2f(p1[i]); p1[i + 1] = __builtin_amdgcn_exp2f(p1[i + 1]);
        ls2 += (f32x2){p0[i], p0[i + 1]}; ls2 += (f32x2){p1[i], p1[i + 1]};
    }
    l_run += ls2.x + ls2.y;
    const int i16 = lane & 15, q4 = i16 >> 2, p4 = i16 & 3, g1 = (lane >> 4) & 1;
    LAS const unsigned char* vl = Vb + (4 * hh + q4) * 64 + 32 * g1 + 8 * p4;
    const bf16x8 pa[4] = {pack8(p0, 0), pack8(p0, 1), pack8(p1, 0), pack8(p1, 1)};
    s16x4 flo[2][NDB], fhi[2][NDB];
#pragma unroll
    for (int d = 0; d < NDB; ++d) { flo[0][d] = vtr(vl + d * 4096); fhi[0][d] = vtr(vl + 8 * 64 + d * 4096); }
#pragma unroll
    for (int k = 0; k < 4; ++k) {
        if (k + 1 < 4) {
            LAS const unsigned char* vk = vl + 16 * (k + 1) * 64;
#pragma unroll
            for (int d = 0; d < NDB; ++d) { flo[(k + 1) & 1][d] = vtr(vk + d * 4096); fhi[(k + 1) & 1][d] = vtr(vk + 8 * 64 + d * 4096); }
        }
        __builtin_amdgcn_sched_barrier(0);
        __builtin_amdgcn_s_setprio(1);
#pragma unroll
        for (int d = 0; d < NDB; ++d) { const bf16x8 vb = __builtin_shufflevector(flo[k & 1][d], fhi[k & 1][d], 0, 1, 2, 3, 4, 5, 6, 7); o[d] = mfma32(pa[k], vb, o[d]); }
        __builtin_amdgcn_s_setprio(0);
        __builtin_amdgcn_sched_barrier(0);
    }
}

DI void da_unit(LAS unsigned char* lds, const int tid, const bf16_t* QKV, bf16_t* O, int q_row0, int kv_row0, int NT, int h, float lam, float one_m_li, const float* subg) {
    const int lane = tid & 63, wid = __builtin_amdgcn_readfirstlane(tid >> 6), r = lane & 31, hh = lane >> 5;
    const int qg = wid >> 1, j = wid & 1;
    constexpr int KP = 272, STG = 2 * 64 * KP;
    LAS float* wsf = (LAS float*)(lds + 2 * STG) + wid * 64;
    const bf16_t* gbase = QKV + (size_t)(kv_row0 + (tid >> 4)) * 3072 + 1024 + h * 128 + (tid & 15) * 8;
    const int lbase = (tid >> 4) * KP + (tid & 15) * 16;
    const int vbase = ((tid & 15) >> 2) * 4096 + (tid >> 4) * 64 + (tid & 3) * 16;
    u32x4 st[4];
#define DA_LOAD(t) do { _Pragma("unroll") for (int i = 0; i < 4; ++i) st[i] = *(const u32x4*)(gbase + (size_t)(t) * 64 * 3072 + (size_t)(i & 1) * 32 * 3072 + (i >> 1) * 1024); } while (0)
#define DA_STORE(buf) do { _Pragma("unroll") for (int i = 0; i < 2; ++i) { *(LAS u32x4*)(lds + (buf) * STG + lbase + i * 32 * KP) = st[i]; *(LAS u32x4*)(lds + (buf) * STG + 64 * KP + vbase + i * 32 * 64) = st[2 + i]; } } while (0)
    const bf16_t* qp = QKV + (size_t)(q_row0 + 32 * qg + r) * 3072 + h * 128 + j * 64 + 8 * hh;
    bf16x8 qr[4];
#pragma unroll
    for (int d0 = 0; d0 < 4; ++d0) qr[d0] = *(const bf16x8*)(qp + 16 * d0);
    f32x16 o[4];
#pragma unroll
    for (int d = 0; d < 4; ++d)
#pragma unroll
        for (int i = 0; i < 16; ++i) o[d][i] = 0.f;
    float m_run = 0.f, l_run = 0.f;
    f32x16 negm;
#pragma unroll
    for (int i = 0; i < 16; ++i) negm[i] = 0.f;
    DA_LOAD(0); DA_STORE(0); __syncthreads();
    for (int t = 0; t < NT; ++t) {
        const int cur = t & 1;
        if (t + 1 < NT) DA_LOAD(t + 1);
        LAS const unsigned char* Kb = lds + cur * STG + j * 128 + r * KP + hh * 16;
        LAS const unsigned char* Vb = lds + cur * STG + 64 * KP;
        f32x16 p0 = negm, p1 = negm;
        __builtin_amdgcn_s_setprio(1);
#pragma unroll
        for (int d0 = 0; d0 < 4; ++d0) { const bf16x8 k0 = *(const LAS bf16x8*)(Kb + d0 * 32), k1 = *(const LAS bf16x8*)(Kb + 32 * KP + d0 * 32);
            p0 = mfma32(k0, qr[d0], p0); p1 = mfma32(k1, qr[d0], p1); }
        __builtin_amdgcn_s_setprio(0);
        softmax_pv<4>(p0, p1, o, negm, m_run, l_run, t == 0, wsf, Vb, KP, r, hh, lane);
        if (t + 1 < NT) DA_STORE(cur ^ 1);
        LDS_BARRIER();
    }
#undef DA_LOAD
#undef DA_STORE
    const float lt = l_run + __shfl_xor(l_run, 32);
    if (hh == 0) wsf[r] = 1.f / lt;
    float rl[16];
#pragma unroll
    for (int g4 = 0; g4 < 4; ++g4) { const f32x4 a4 = *(const LAS f32x4*)(wsf + 8 * g4 + 4 * hh);
#pragma unroll
        for (int e = 0; e < 4; ++e) rl[4 * g4 + e] = a4[e]; }
    LAS float* R = (LAS float*)lds + qg * 32 * 132;
    if (j == 1) {
#pragma unroll
        for (int d = 0; d < 4; ++d)
#pragma unroll
            for (int i = 0; i < 16; ++i) R[((i & 3) + 8 * (i >> 2) + 4 * hh) * 132 + d * 32 + r] = o[d][i] * rl[i] * lam;
    }
    __syncthreads();
    if (j == 0) {
#pragma unroll
        for (int d = 0; d < 4; ++d)
#pragma unroll
            for (int i = 0; i < 16; ++i) { const int idx = ((i & 3) + 8 * (i >> 2) + 4 * hh) * 132 + d * 32 + r; R[idx] = o[d][i] * rl[i] - R[idx]; }
    }
    __syncthreads();
    {
        const int row = tid >> 2, qtr = tid & 3;
        LAS const float* rp = (LAS const float*)lds + (row >> 5) * 32 * 132 + (row & 31) * 132 + qtr * 32;
        f32x4 v[8]; float ss = 0.f;
#pragma unroll
        for (int c = 0; c < 8; ++c) { v[c] = *(const LAS f32x4*)(rp + 4 * c); ss += (v[c].x * v[c].x + v[c].y * v[c].y) + (v[c].z * v[c].z + v[c].w * v[c].w); }
        ss += __shfl_xor(ss, 1); ss += __shfl_xor(ss, 2);
        const float rs = one_m_li / sqrtf(ss * (1.f / 128.f) + NORM_EPS);
        bf16_t* op = O + (size_t)(q_row0 + row) * DM + h * 128 + qtr * 32;
        const float* gp = subg + qtr * 32;
#pragma unroll
        for (int c = 0; c < 4; ++c) { const f32x4 g0 = *(const f32x4*)(gp + 8 * c), g1 = *(const f32x4*)(gp + 8 * c + 4); const f32x4 a = v[2 * c] * rs * g0, b = v[2 * c + 1] * rs * g1;
            *(u32x4*)(op + 8 * c) = (u32x4){pk2(a.x, a.y), pk2(a.z, a.w), pk2(b.x, b.y), pk2(b.z, b.w)}; }
    }
    __syncthreads();
}

DI void da_phase(Frame& F, unsigned char* ws, int l) {
    const bf16_t* QKV = (const bf16_t*)(ws + WS_ACT); bf16_t* O = (bf16_t*)(ws + WS_U);
    const int slot = l / 3; const bool last = (l == 3);
    const float* lamv = (const float*)(ws + WS_LAM); const float lam = lamv[2 * slot], li = lamv[2 * slot + 1];
    const float* subg = F.in[I_DASUB] + slot * 128;
    const int nunits = 2048 + (last ? 0 : 256);
    for (int u = F.vcu; u < nunits; u += F.G) {
        if (u < 2048) { const int bh = u >> 4, qt = u & 15, b = bh >> 3, h = bh & 7;
            da_unit(F.lds, F.tid, QKV, O, b * LROW + CTX + qt * 128, b * LROW, 36, h, lam, 1.f - li, subg); }
        else { const int v = u - 2048, bh = v >> 1, qt = v & 1, b = bh >> 3, h = bh & 7;
            da_unit(F.lds, F.tid, QKV, O, b * LROW + qt * 128, b * LROW, 4, h, lam, 1.f - li, subg); }
    }
}

DI void na_unit(LAS unsigned char* lds, const int tid, const bf16_t* QKV, bf16_t* O, const float* rpb, int b, int h, int R, int ctxq) {
    const int lane = tid & 63, wid = __builtin_amdgcn_readfirstlane(tid >> 6), r = lane & 31, hh = lane >> 5;
    constexpr int KP = 144, STG = 2 * 64 * KP;
    LAS float* wsf = (LAS float*)(lds + 2 * STG) + wid * 64;
    LAS float* rpbL = (LAS float*)(lds + 2 * STG + 2048);
    const int rw = 4 * R + (wid >> 1), cq = 32 * (wid & 1) + r;
    const int rs_w = min(max(rw - 4, 0), 24);
    const int rlo = min(max(4 * R - 4, 0), 24), rhi = min(max(4 * R - 1, 0), 24) + 7;
    const int NT = ctxq ? 4 : 4 + (rhi - rlo + 1);
    const int q_row = ctxq ? b * LROW + 32 * wid + r : b * LROW + CTX + R * 256 + 32 * wid + r;
    if (!ctxq) for (int i = tid; i < 465; i += 512) rpbL[i] = rpb[h * 465 + i] * LOG2E;
    const int srow = tid >> 3, sch = tid & 7;
    const bf16_t* gb = QKV + (size_t)(b * LROW) * 3072 + 1024 + h * 64 + sch * 8;
    const int lbase = srow * KP + sch * 16;
    u32x4 st[2];
#define NA_ROW(t) ((t) < 4 ? 64 * (t) : CTX + (rlo + (t) - 4) * 64)
#define NA_LOAD(t) do { const bf16_t* _g = gb + (size_t)(NA_ROW(t) + srow) * 3072; st[0] = *(const u32x4*)_g; st[1] = *(const u32x4*)(_g + 1024); } while (0)
#define NA_STORE(buf) do { *(LAS u32x4*)(lds + (buf) * STG + lbase) = st[0]; *(LAS u32x4*)(lds + (buf) * STG + 64 * KP + (sch >> 2) * 4096 + srow * 64 + (sch & 3) * 16) = st[1]; } while (0)
    const bf16_t* qp = QKV + (size_t)q_row * 3072 + h * 64 + 8 * hh;
    bf16x8 qr[4];
#pragma unroll
    for (int d0 = 0; d0 < 4; ++d0) qr[d0] = *(const bf16x8*)(qp + 16 * d0);
    f32x16 o[2];
#pragma unroll
    for (int d = 0; d < 2; ++d)
#pragma unroll
        for (int i = 0; i < 16; ++i) o[d][i] = 0.f;
    float m_run = 0.f, l_run = 0.f;
    f32x16 negm;
#pragma unroll
    for (int i = 0; i < 16; ++i) negm[i] = 0.f;
    const int cs = min(max(cq - 8, 0), 48);
    NA_LOAD(0); NA_STORE(0); __syncthreads();
    for (int t = 0; t < NT; ++t) {
        const int cur = t & 1;
        if (t + 1 < NT) NA_LOAD(t + 1);
        const int ri = rlo + t - 4;
        const bool active = (t < 4) || (ri >= rs_w && ri <= rs_w + 7);
        if (active) {
            LAS const unsigned char* Kb = lds + cur * STG + r * KP + hh * 16;
            LAS const unsigned char* Vb = lds + cur * STG + 64 * KP;
            f32x16 p0 = negm, p1 = negm;
#pragma unroll
            for (int d0 = 0; d0 < 4; ++d0) { const bf16x8 k0 = *(const LAS bf16x8*)(Kb + d0 * 32), k1 = *(const LAS bf16x8*)(Kb + 32 * KP + d0 * 32);
                p0 = mfma32(k0, qr[d0], p0); p1 = mfma32(k1, qr[d0], p1); }
            if (t >= 4) {
                LAS const float* bt = rpbL + (ri - rw + 7) * 31 + 15 - cq;
#pragma unroll
                for (int i = 0; i < 16; ++i) { const int ck = (i & 3) + 8 * (i >> 2) + 4 * hh;
                    { const bool in = (ck >= cs) && (ck < cs + 16); const float bv = bt[in ? ck : cq]; p0[i] = in ? p0[i] + bv : -1e30f; }
                    { const int ck2 = ck + 32; const bool in = (ck2 >= cs) && (ck2 < cs + 16); const float bv = bt[in ? ck2 : cq]; p1[i] = in ? p1[i] + bv : -1e30f; } }
            }
            softmax_pv<2>(p0, p1, o, negm, m_run, l_run, t == 0, wsf, Vb, KP, r, hh, lane);
        }
        if (t + 1 < NT) NA_STORE(cur ^ 1);
        LDS_BARRIER();
    }
#undef NA_ROW
#undef NA_LOAD
#undef NA_STORE
    const float lt = l_run + __shfl_xor(l_run, 32);
    if (hh == 0) wsf[r] = 1.f / lt;
    const int orow0 = (ctxq ? b * LROW : b * LROW + CTX + R * 256) + 32 * wid;
#pragma unroll
    for (int g4 = 0; g4 < 4; ++g4) { const f32x4 a4 = *(const LAS f32x4*)(wsf + 8 * g4 + 4 * hh);
#pragma unroll
        for (int e = 0; e < 4; ++e) { const int i = 4 * g4 + e; const int q = 8 * g4 + 4 * hh + e;
            bf16_t* op = O + (size_t)(orow0 + q) * DM + h * 64 + r;
            op[0] = (bf16_t)(pk2(o[0][i] * a4[e], 0.f) & 0xffffu); op[32] = (bf16_t)(pk2(o[1][i] * a4[e], 0.f) & 0xffffu); } }
    __syncthreads();
}

DI void na_phase(Frame& F, unsigned char* ws) {
    const bf16_t* QKV = (const bf16_t*)(ws + WS_ACT); bf16_t* O = (bf16_t*)(ws + WS_U);
    for (int u = F.vcu; u < 2048 + 256; u += F.G) {
        if (u < 2048) { const int bh = u >> 3, R = u & 7; na_unit(F.lds, F.tid, QKV, O, F.in[I_NARPB], bh >> 4, bh & 15, R, 0); }
        else { const int bh = u - 2048; na_unit(F.lds, F.tid, QKV, O, F.in[I_NARPB], bh >> 4, bh & 15, 0, 1); }
    }
}

template <int CTRL> DI float dppf(float x) { return __int_as_float(__builtin_amdgcn_update_dpp(0, __float_as_int(x), CTRL, 0xf, 0xf, false)); }
DI float allred8(float x) {
    float a, b, c;
    asm volatile("s_nop 1\n\tv_add_f32_dpp %0, %1, %1 row_half_mirror row_mask:0xf bank_mask:0xf bound_ctrl:1" : "=v"(a) : "v"(x));
    asm volatile("s_nop 1\n\tv_add_f32_dpp %0, %1, %1 quad_perm:[1,0,3,2] row_mask:0xf bank_mask:0xf bound_ctrl:1" : "=v"(b) : "v"(a));
    asm volatile("s_nop 1\n\tv_add_f32_dpp %0, %1, %1 quad_perm:[2,3,0,1] row_mask:0xf bank_mask:0xf bound_ctrl:1" : "=v"(c) : "v"(b));
    return c;
}
DI float allred8_ref(float x) { x += dppf<0x141>(x); x += dppf<0xB1>(x); x += dppf<0x4E>(x); return x; }
DI float allred16(float x) { x += dppf<0x128>(x); x += dppf<0x124>(x); x += dppf<0x122>(x); x += dppf<0x121>(x); return x; }
DI void rwkv_scan(Frame& F, unsigned char* ws) {
    const bf16_t* X = (const bf16_t*)(ws + WS_ACT);
    bf16_t* Y0 = (bf16_t*)(ws + WS_U) + (size_t)MROWS * DM;
    bf16_t* Y1 = (bf16_t*)(ws + WS_Y);
    float* CD = (float*)(ws + WS_CD);
    const int tid = F.tid, lane = F.lane, g = tid >> 8, gt = tid & 255, gwv = (tid >> 6) & 3;
    LAS float* buf = (LAS float*)(F.lds) + g * 6144;
    LAS float* ybuf = (LAS float*)(F.lds + 49152) + g * 8192;
    LAS float* red = (LAS float*)(F.lds + 114688) + g * 128;
    for (int s0 = F.vcu * 2; s0 < 512; s0 += F.G * 2) {
        const int s = s0 + g, dir = s >> 8, b = (s >> 4) & 15, h = s & 15;
        const int ch = 16 * gwv + (lane & 15), chn = h * 64 + ch, rq = lane >> 4;
        bf16x8 bw[2], ba[2];
#pragma unroll
        for (int ks = 0; ks < 2; ++ks) { u32x4 pw, pa;
#pragma unroll
            for (int e = 0; e < 4; ++e) { const int k = 32 * ks + 8 * rq + 2 * e;
                pw[e] = pk2(F.in[I_RWW2][(size_t)(dir * 64 + k) * 1024 + chn], F.in[I_RWW2][(size_t)(dir * 64 + k + 1) * 1024 + chn]);
                pa[e] = pk2(F.in[I_RWA2][(size_t)(dir * 64 + k) * 1024 + chn], F.in[I_RWA2][(size_t)(dir * 64 + k + 1) * 1024 + chn]); }
            bw[ks] = __builtin_bit_cast(bf16x8, pw); ba[ks] = __builtin_bit_cast(bf16x8, pa); }
        const float w0c = F.in[I_RWW0][dir * 1024 + chn], a0c = F.in[I_RWA0][dir * 1024 + chn], kkc = F.in[I_RWKK][chn], kac = F.in[I_RWKA][chn], rkc = F.in[I_RWRK][chn];
        const bf16_t* Xb = X + (size_t)(b * LROW) * 3584;
        bf16_t* Yd = (dir ? Y1 : Y0) + (size_t)(b * LROW) * DM + h * 64;
        float* CDd = CD + ((size_t)dir * MROWS + (size_t)b * LROW) * 16 + h;
        f32x2 S2[8];
#pragma unroll
        for (int i = 0; i < 8; ++i) S2[i] = (f32x2){0.f, 0.f};
        const int kgrp = lane & 7, vpair = lane >> 3;
        bf16x8 ahw[2], aha[2]; bf16_t rr_[4], kr_[4], vr_[4];
#define SC_RLO(c) (dir ? (((c) < 16 ? 255 - 16 * (c) : 2559 - 16 * (c)) - 15) : 16 * (c))
#define SC_LOAD(c) do { const int _rlo = SC_RLO(c); const bf16_t* _p = Xb + (size_t)(_rlo + (lane & 15)) * 3584 + 3072 + dir * 64 + 8 * rq; \
        ahw[0] = *(const bf16x8*)_p; ahw[1] = *(const bf16x8*)(_p + 32); aha[0] = *(const bf16x8*)(_p + 128); aha[1] = *(const bf16x8*)(_p + 160); \
        _Pragma("unroll") for (int j = 0; j < 4; ++j) { const bf16_t* _q = Xb + (size_t)(_rlo + 4 * rq + j) * 3584 + chn; rr_[j] = _q[0]; kr_[j] = _q[1024]; vr_[j] = _q[2048]; } } while (0)
        SC_LOAD(0);
        for (int c = 0; c < 144; ++c) {
            const int rlo = SC_RLO(c);
            LAS float* cb = buf;
            f32x4 accw = {0.f, 0.f, 0.f, 0.f}, acca = {0.f, 0.f, 0.f, 0.f};
#pragma unroll
            for (int ks = 0; ks < 2; ++ks) { accw = __builtin_amdgcn_mfma_f32_16x16x32_bf16(ahw[ks], bw[ks], accw, 0, 0, 0); acca = __builtin_amdgcn_mfma_f32_16x16x32_bf16(aha[ks], ba[ks], acca, 0, 0, 0); }
            float dec[4], av[4], kkv[4], kd[4], rv[4], vv[4];
#pragma unroll
            for (int j = 0; j < 4; ++j) {
                const float z = w0c + accw[j]; dec[j] = fast_exp(-0.6065306597126334f * sigmoidf_(z));
                av[j] = sigmoidf_(a0c + acca[j]);
                const float kx = bf2f(kr_[j]); rv[j] = bf2f(rr_[j]); vv[j] = bf2f(vr_[j]);
                kkv[j] = kx * kkc; kd[j] = kx * (1.f + (av[j] - 1.f) * kac);
                const float nsq = allred16(kkv[j] * kkv[j]), cp = allred16(rv[j] * kd[j] * rkc);
                if ((lane & 15) == 0) { red[(4 * rq + j) * 4 + gwv] = nsq; red[64 + (4 * rq + j) * 4 + gwv] = cp; }
            }
            LDS_BARRIER();
#pragma unroll
            for (int j = 0; j < 4; ++j) {
                const int rr = 4 * rq + j, js = dir ? 15 - rr : rr;
                const f32x4 n4 = *(const LAS f32x4*)(red + rr * 4);
                const float inv = __builtin_amdgcn_rsqf(fmaxf((n4.x + n4.y) + (n4.z + n4.w), 1e-24f));
                const float kkn = kkv[j] * inv;
                LAS float* d = cb + js * 384 + ch;
                d[0] = rv[j]; d[64] = dec[j]; d[128] = kd[j]; d[192] = -kkn; d[256] = kkn * av[j]; d[320] = vv[j];
            }
            if (gt < 16) { const f32x4 c4 = *(const LAS f32x4*)(red + 64 + gt * 4); CDd[(size_t)(rlo + gt) * 16] = (c4.x + c4.y) + (c4.z + c4.w); }
            if (c + 1 < 144) SC_LOAD(c + 1);
            LDS_BARRIER();
#pragma unroll 2
            for (int js = 0; js < 16; ++js) {
                LAS const float* sb = cb + js * 384 + 8 * kgrp;
                const f32x4 r0 = *(const LAS f32x4*)(sb), r1 = *(const LAS f32x4*)(sb + 4);
                const f32x4 w0 = *(const LAS f32x4*)(sb + 64), w1 = *(const LAS f32x4*)(sb + 68);
                const f32x4 d0 = *(const LAS f32x4*)(sb + 128), d1 = *(const LAS f32x4*)(sb + 132);
                const f32x4 a0 = *(const LAS f32x4*)(sb + 192), a1 = *(const LAS f32x4*)(sb + 196);
                const f32x4 b0 = *(const LAS f32x4*)(sb + 256), b1 = *(const LAS f32x4*)(sb + 260);
                const f32x2 vt = *(const LAS f32x2*)(cb + js * 384 + 320 + 16 * gwv + 2 * vpair);
                const float rr8[8] = {r0.x, r0.y, r0.z, r0.w, r1.x, r1.y, r1.z, r1.w};
                const float ww8[8] = {w0.x, w0.y, w0.z, w0.w, w1.x, w1.y, w1.z, w1.w};
                const float dd8[8] = {d0.x, d0.y, d0.z, d0.w, d1.x, d1.y, d1.z, d1.w};
                const float aa8[8] = {a0.x, a0.y, a0.z, a0.w, a1.x, a1.y, a1.z, a1.w};
                const float bb8[8] = {b0.x, b0.y, b0.z, b0.w, b1.x, b1.y, b1.z, b1.w};
                f32x2 sA = S2[0] * aa8[0], sB = S2[1] * aa8[1];
#pragma unroll
                for (int q = 2; q < 8; q += 2) { sA += S2[q] * aa8[q]; sB += S2[q + 1] * aa8[q + 1]; }
                f32x2 sa = sA + sB; sa.x = allred8(sa.x); sa.y = allred8(sa.y);
                f32x2 yA = {0.f, 0.f}, yB = {0.f, 0.f};
#pragma unroll
                for (int q = 0; q < 8; q += 2) {
                    S2[q]     = S2[q]     * ww8[q]     + (sa * bb8[q]     + vt * dd8[q]);
                    S2[q + 1] = S2[q + 1] * ww8[q + 1] + (sa * bb8[q + 1] + vt * dd8[q + 1]);
                    yA += S2[q] * rr8[q]; yB += S2[q + 1] * rr8[q + 1];
                }
                const f32x2 y = yA + yB;
                LAS float* yp = ybuf + js * 512 + (16 * gwv + 2 * vpair) * 8 + kgrp;
                yp[0] = y.x; yp[8] = y.y;
            }
            LDS_BARRIER();
            { const int rr = gt >> 4, c4 = (gt & 15) * 4, js = dir ? 15 - rr : rr;
              f32x4 yv;
#pragma unroll
              for (int e = 0; e < 4; ++e) { const f32x4 q0 = *(const LAS f32x4*)(ybuf + js * 512 + (c4 + e) * 8), q1 = *(const LAS f32x4*)(ybuf + js * 512 + (c4 + e) * 8 + 4);
                  yv[e] = ((q0.x + q0.y) + (q0.z + q0.w)) + ((q1.x + q1.y) + (q1.z + q1.w)); }
              *(u32x2*)(Yd + (size_t)(rlo + rr) * DM + c4) = (u32x2){pk2(yv.x, yv.y), pk2(yv.z, yv.w)}; }
        }
#undef SC_RLO
#undef SC_LOAD
        __syncthreads();
    }
}

DI void rwkv_readout(Frame& F, unsigned char* ws) {
    const bf16_t* X = (const bf16_t*)(ws + WS_ACT);
    bf16_t* G = (bf16_t*)(ws + WS_U);
    const bf16_t* Y0 = G + (size_t)MROWS * DM; const bf16_t* Y1 = (const bf16_t*)(ws + WS_Y);
    const float* CD = (const float*)(ws + WS_CD);
    const int c0 = 16 * F.lane, hd = F.lane >> 2;
    for (int row = F.gw; row < MROWS; row += F.NGW) {
        float y[16], vv[16], gg[16];
#pragma unroll
        for (int j = 0; j < 2; ++j) {
            const u32x4 a = *(const u32x4*)(Y0 + (size_t)row * DM + c0 + 8 * j), bq = *(const u32x4*)(Y1 + (size_t)row * DM + c0 + 8 * j);
            const u32x4 v4 = *(const u32x4*)(X + (size_t)row * 3584 + 2048 + c0 + 8 * j), g4 = *(const u32x4*)(G + (size_t)row * DM + c0 + 8 * j);
#pragma unroll
            for (int e = 0; e < 4; ++e) { y[8 * j + 2 * e] = bflo(a[e]) + bflo(bq[e]); y[8 * j + 2 * e + 1] = bfhi(a[e]) + bfhi(bq[e]);
                vv[8 * j + 2 * e] = bflo(v4[e]); vv[8 * j + 2 * e + 1] = bfhi(v4[e]); gg[8 * j + 2 * e] = bflo(g4[e]); gg[8 * j + 2 * e + 1] = bfhi(g4[e]); }
        }
        float s = 0.f;
#pragma unroll
        for (int i = 0; i < 16; ++i) s += y[i];
        s += __shfl_xor(s, 1); s += __shfl_xor(s, 2);
        const float mean = s * (1.f / 64.f); float q = 0.f;
#pragma unroll
        for (int i = 0; i < 16; ++i) { y[i] -= mean; q += y[i] * y[i]; }
        q += __shfl_xor(q, 1); q += __shfl_xor(q, 2);
        const float rstd = 1.f / sqrtf(q * (1.f / 64.f) + 64e-5f);
        const float cc = CD[(size_t)row * 16 + hd] + CD[((size_t)MROWS + row) * 16 + hd];
        u32x4 o[2];
#pragma unroll
        for (int j = 0; j < 2; ++j)
#pragma unroll
            for (int e = 0; e < 4; ++e) { const int i = 8 * j + 2 * e;
                const float z0 = ((y[i] * rstd) * F.in[I_RWLNG][c0 + i] + F.in[I_RWLNB][c0 + i] + cc * vv[i]) * gg[i];
                const float z1 = ((y[i + 1] * rstd) * F.in[I_RWLNG][c0 + i + 1] + F.in[I_RWLNB][c0 + i + 1] + cc * vv[i + 1]) * gg[i + 1];
                o[j][e] = pk2(z0, z1); }
        *(u32x4*)(G + (size_t)row * DM + c0) = o[0]; *(u32x4*)(G + (size_t)row * DM + c0 + 8) = o[1];
    }
}


#define XB_TMO      128
#define XB_XCNT(j)  (256  + 64 * (j))
#define XB_XSUB(j)  (1280 + 64 * (j))
#define XB_XGEN(j)  (2304 + 64 * (j))
#define XB_TOP      3328
#define XB_TOPGEN   3392
#define XCD_BAR_WORDS 3456
#define XB_SPIN_CAP (1u << 18)
DI unsigned xb_ld(unsigned* p)              { return __hip_atomic_load(p, __ATOMIC_RELAXED, __HIP_MEMORY_SCOPE_AGENT); }
DI unsigned xb_add(unsigned* p, unsigned v) { return __hip_atomic_fetch_add(p, v, __ATOMIC_RELAXED, __HIP_MEMORY_SCOPE_AGENT); }
DI unsigned xb_xcc_id() { return (unsigned)__builtin_amdgcn_s_getreg((3 << 11) | 20) & 0xFu; }
#define XB_SPIN(cond, bar) do { unsigned _sp = 0; while (cond) { __builtin_amdgcn_s_sleep(1); \
    if ((++_sp & 255u) == 0u) { if (xb_ld(&(bar)[XB_TMO])) break; if (_sp > XB_SPIN_CAP) { atomicAdd(&(bar)[XB_TMO], 1u); break; } } } } while (0)
struct XcdBarrier { unsigned* bar; unsigned x; volatile LAS unsigned* st; };
DI XcdBarrier xcd_barrier_post(unsigned* bar, volatile LAS unsigned* st) {
    XcdBarrier b; b.bar = bar; b.x = xb_xcc_id(); b.st = st;
    if (threadIdx.x == 0) (void)xb_add(&bar[XB_XCNT(b.x)], 1u);
    return b;
}
DI void xcd_barrier_complete(unsigned* bar, unsigned x, unsigned& nloc, unsigned& nx) {
    const unsigned G = gridDim.x * gridDim.y * gridDim.z;
    unsigned sum, cnt, mine, sp = 0u;
    for (;;) {
        sum = 0u; cnt = 0u; mine = 0u;
#pragma unroll
        for (unsigned j = 0; j < 16; ++j) { const unsigned c = xb_ld(&bar[XB_XCNT(j)]); sum += c; cnt += (c > 0u) ? 1u : 0u; mine = (j == x) ? c : mine; }
        if (sum == G) break;
        __builtin_amdgcn_s_sleep(1);
        if ((++sp & 255u) == 0u) { if (xb_ld(&bar[XB_TMO])) break; if (sp > XB_SPIN_CAP) { atomicAdd(&bar[XB_TMO], 1u); break; } }
    }
    nloc = mine > 0u ? mine : 1u; nx = cnt > 0u ? cnt : 1u;
}
DI void xcd_barrier(const XcdBarrier& b) {
    asm volatile("s_waitcnt vmcnt(0)" ::: "memory");
    __syncthreads();
    if (threadIdx.x == 0) {
        unsigned* bar = b.bar;
        __builtin_amdgcn_s_waitcnt(0);
        unsigned nloc = b.st[0], nx = b.st[1];
        if (nloc == 0u) { xcd_barrier_complete(bar, b.x, nloc, nx); b.st[0] = nloc; b.st[1] = nx; }
        const unsigned old = xb_add(&bar[XB_XSUB(b.x)], 1u);
        const unsigned gen = old / nloc;
        if (old + 1u == (gen + 1u) * nloc) {
            __builtin_amdgcn_fence(__ATOMIC_RELEASE, "agent");
            asm volatile("s_waitcnt vmcnt(0)" ::: "memory");
            const unsigned og = xb_add(&bar[XB_TOP], 1u);
            const unsigned tg = og / nx;
            if (og + 1u == (tg + 1u) * nx) xb_add(&bar[XB_TOPGEN], 1u);
            else XB_SPIN(xb_ld(&bar[XB_TOPGEN]) == tg, bar);
            __builtin_amdgcn_fence(__ATOMIC_ACQUIRE, "agent");
            xb_add(&bar[XB_XGEN(b.x)], 1u);
            asm volatile("s_waitcnt vmcnt(0)" ::: "memory");
        } else {
            XB_SPIN(xb_ld(&bar[XB_XGEN(b.x)]) == gen, bar);
            __builtin_amdgcn_fence(__ATOMIC_ACQUIRE, "agent");
            asm volatile("s_waitcnt vmcnt(0)" ::: "memory");
        }
    }
    __syncthreads();
}

enum { OP_RP0 = 0, OP_G1, OP_G2, OP_RP1, OP_XX, OP_RKVH, OP_GG, OP_SCAN, OP_RDOUT, OP_QKV, OP_ATT, OP_OPROJ, OP_RP2, OP_G5, OP_G6, OP_RP3, OP_END };
DI int next_op(int kind, int op) {
    switch (op) {
        case OP_RP0: return OP_G1; case OP_G1: return OP_G2; case OP_G2: return OP_RP1;
        case OP_RP1: return kind == 2 ? OP_XX : OP_QKV;
        case OP_XX: return OP_RKVH; case OP_RKVH: return OP_GG; case OP_GG: return OP_SCAN; case OP_SCAN: return OP_RDOUT; case OP_RDOUT: return OP_OPROJ;
        case OP_QKV: return OP_ATT; case OP_ATT: return OP_OPROJ; case OP_OPROJ: return OP_RP2;
        case OP_RP2: return OP_G5; case OP_G5: return OP_G6; case OP_G6: return OP_RP3; default: return OP_END;
    }
}

__global__ void __launch_bounds__(512, 2) mega(const float* i0, const float* i1, const float* i2, const float* i3, const float* i4, const float* i5, const float* i6, const float* i7, const float* i8, const float* i9, const float* i10, const float* i11, const float* i12, const float* i13, const float* i14, const float* i15, const float* i16, const float* i17, const float* i18, const float* i19, const float* i20, const float* i21, const float* i22, const float* i23, const float* i24, const float* i25, const float* i26, const float* i27, const float* i28, const float* i29, const float* i30, const float* i31, float* out, unsigned char* ws0) {
    const float* in_[32] = {i0, i1, i2, i3, i4, i5, i6, i7, i8, i9, i10, i11, i12, i13, i14, i15, i16, i17, i18, i19, i20, i21, i22, i23, i24, i25, i26, i27, i28, i29, i30, i31};
    extern __shared__ __attribute__((aligned(16))) unsigned char lds_raw[];
    cg::grid_group grid = cg::this_grid();
    Frame F;
#define BUILD_FRAME() do { int tid_ = threadIdx.x; asm volatile("" : "+v"(tid_)); int bx_ = blockIdx.x; asm volatile("" : "+s"(bx_)); \
    F.lds = (LAS unsigned char*)lds_raw; F.tid = tid_; F.lane = tid_ & 63; F.wave = __builtin_amdgcn_readfirstlane(tid_ >> 6); \
    F.G = gridDim.x; F.bx = bx_; F.vcu = (F.G % 8 == 0) ? (bx_ % 8) * (F.G / 8) + bx_ / 8 : bx_; \
    F.gw = F.vcu * 8 + F.wave; F.NGW = F.G * 8; F.in = in_; } while (0)
    BUILD_FRAME();
    unsigned char* ws = ws0;

#ifndef NO_P0
    phase0(F, ws);
#endif
    grid.sync();
    volatile LAS unsigned* bst = (volatile LAS unsigned*)(F.lds + LDS_BYTES - 64);
    if (F.tid < 2) bst[F.tid] = 0u;
    __syncthreads();
    const XcdBarrier xbar = xcd_barrier_post((unsigned*)(ws0 + WS_BAR), bst);

    for (int l = 0; l < 4; ++l) {
        const int kind = l % 3; const bool last = (l == 3);
        const float* ng = F.in[I_NORMG] + l * 6 * DM;
        int op = (l == 0) ? OP_RP0 : OP_G1;
        int sub = 0, rp_lo = 0;
        while (op != OP_END) {
            { size_t zoff = 0; asm volatile("" : "+s"(zoff)); ws = ws0 + zoff; }
            BUILD_FRAME();
            float* HC = (float*)(ws + WS_HC); bf16_t* WB = (bf16_t*)(ws + WS_WB); bf16_t* U = (bf16_t*)(ws + WS_U); bf16_t* ACT = (bf16_t*)(ws + WS_ACT); bf16_t* YB = (bf16_t*)(ws + WS_Y);
            const float* cosT = (const float*)(ws + WS_ROPE); const float* sinT = cosT + 1024;
            int rpop = -1, rlo = 0, rhi = MROWS, rwidx = F.gw, rnw = F.NGW; bool fill = false;
            if (op == OP_G1 || op == OP_G2 || op == OP_G5 || op == OP_G6 || op == OP_QKV || op == OP_RKVH || op == OP_GG || op == OP_OPROJ) {
                pg8::Gemm g; pg8::Epi E; E.cosT = cosT; E.sinT = sinT; int skip = 0;
                if (op == OP_G1 || op == OP_G5) { g.A = U; g.lda = 1024; g.Bt = WB + (op == OP_G1 ? WB_IN0 : WB_IN1); g.ldb = 1024; g.N = 5632; g.K = 1024; E.mode = pg8::EPI_SWIGLU; E.O = ACT; E.ldc = FF; skip = (last && op == OP_G5); }
                else if (op == OP_G2 || op == OP_G6) { g.A = ACT; g.lda = FF; g.Bt = WB + (op == OP_G2 ? WB_OUT0 : WB_OUT1); g.ldb = FF; g.N = 1024; g.K = FF; E.mode = pg8::EPI_PLAIN; E.O = YB; E.ldc = 1024; skip = (last && op == OP_G6); }
                else if (op == OP_QKV) { g.A = U; g.lda = 1024; g.Bt = WB + WB_MIXIN; g.ldb = 1024; g.N = 3072; g.K = 1024; E.mode = kind == 0 ? pg8::EPI_QKV_DA : pg8::EPI_QKV_NA; E.O = ACT; E.ldc = 3072; }
                else if (op == OP_RKVH) { g.A = U; g.lda = 2048; g.Bt = WB + WB_MIXIN; g.ldb = 2048; g.N = 3584; g.K = 2048; E.mode = pg8::EPI_RWKV; E.O = ACT; E.ldc = 3584; }
                else if (op == OP_GG) { g.A = ACT + 3328; g.lda = 3584; g.Bt = WB + WB_G2T; g.ldb = 256; g.N = 1024; g.K = 256; E.mode = pg8::EPI_PLAIN; E.O = U; E.ldc = 1024; }
                else { g.A = U; g.lda = 1024; g.Bt = WB + WB_MIXOUT; g.ldb = 1024; g.N = 1024; g.K = 1024; E.mode = pg8::EPI_PLAIN; E.O = YB; E.ldc = 1024; skip = last; }
                g.nM = skip ? 128 : 144; g.skip = skip;
                pg8::StaticOrder S; S.init(g.nM, g.N, F.G, F.bx, skip);
                fill = (op == OP_G2 || op == OP_G6 || op == OP_OPROJ) && !skip && F.G == 256;
                if (fill) { S.pmode = 1; S.r0 = sub ? 2 : 0; S.nr = sub ? 1 : 2;
                    if (sub == 1 && F.bx >= 64) { rpop = (op == OP_G2) ? OP_RP1 : (op == OP_G6 ? OP_RP3 : OP_RP2); rlo = 0; rhi = 128 * 256; rwidx = (F.bx - 64) * 8 + F.wave; rnw = 192 * 8; } }
#ifndef NO_GEMM
                pg8::gemm_phase(F.lds, F.tid, g, S, E);
#endif
            } else if (op == OP_RP0 || op == OP_RP1 || op == OP_RP2 || op == OP_RP3) { rpop = op; rlo = rp_lo; }
            if (rpop >= 0) {
                RowPass P;
                P.hsrc_lat = out; P.hsrc_ctx = HC; P.hdst_lat = out; P.hdst_ctx = HC; P.U = U; P.ldu = 1024; P.skip_ctx = 0; P.lpost = l; P.lpre = l;
                if (rpop == OP_RP0) { P.hsrc_lat = F.in[I_X]; P.hsrc_ctx = F.in[I_CTX]; P.hdst_lat = (float*)F.in[I_X]; P.hdst_ctx = (float*)F.in[I_CTX];   P.Y = nullptr; P.gpost = ng; P.gate_idx = 0; P.coef = 0.f; P.gpre = ng; P.shift_idx = 0; }
                else if (rpop == OP_RP1) { if (l == 0) { P.hsrc_lat = F.in[I_X]; P.hsrc_ctx = F.in[I_CTX]; } P.Y = YB; P.gpost = ng + DM; P.gate_idx = 2; P.coef = 0.5f; P.gpre = ng + 2 * DM; P.shift_idx = 3; P.ldu = (kind == 2) ? 2048 : 1024; }
                else if (rpop == OP_RP2) { P.Y = YB; P.gpost = ng + 3 * DM; P.gate_idx = 5; P.coef = 1.f; P.gpre = ng + 4 * DM; P.shift_idx = 6; P.skip_ctx = last; }
                else { P.Y = YB; P.gpost = ng + 5 * DM; P.gate_idx = 8; P.coef = 0.5f; P.gpre = last ? nullptr : ng + 6 * DM; P.shift_idx = 0; P.lpre = l + 1; P.skip_ctx = last; }
#ifndef NO_RP
                row_pass(F, ws, P, rlo, rhi, rwidx, rnw);
#endif
#ifndef NO_CONV
                if (op == OP_RP3 && !last) { __syncthreads(); convert_layer(F, ws, l + 1); }
#endif
            }
#ifndef NO_XX
            if (op == OP_XX) { xx_pass(F, ws); }
#endif

#ifndef NO_SCAN
            if (op == OP_SCAN) { rwkv_scan(F, ws); }
#endif

#ifndef NO_RDOUT
            if (op == OP_RDOUT) { rwkv_readout(F, ws); }
#endif

#ifndef NO_ATT
            if (op == OP_ATT) {
#ifndef NO_DA
 if (kind == 0) da_phase(F, ws, l);
#endif
#ifndef NO_NA
 if (kind == 1) na_phase(F, ws);
#endif
 }
#endif
            xcd_barrier(xbar);
            if (fill) { if (sub == 0) { sub = 1; continue; } sub = 0; rp_lo = 128 * 256; }
            else if (rpop >= 0) rp_lo = 0;
            op = next_op(kind, op);
        }
    }
}

extern "C" void kernel_launch(void* const* d_in, const int* in_sizes, int n_in, void* d_out, int out_size,
                              void* d_ws, size_t ws_size, hipStream_t stream) {
    static int grid = 0;
    if (grid == 0) {
        if (n_in != 32 || ws_size < WS_END) { fprintf(stderr, "kernel_launch: need 32 inputs and %zu B of workspace; got %d, %zu\n", (size_t)WS_END, n_in, ws_size); grid = -1; return; }
        int dev = 0, cus = 0, per_cu = 0;
        (void)hipGetDevice(&dev);
        (void)hipDeviceGetAttribute(&cus, hipDeviceAttributeMultiprocessorCount, dev);
        (void)hipFuncSetAttribute((const void*)mega, hipFuncAttributeMaxDynamicSharedMemorySize, LDS_BYTES);
        (void)hipOccupancyMaxActiveBlocksPerMultiprocessor(&per_cu, (const void*)mega, 512, LDS_BYTES);
        if (per_cu < 1) per_cu = 1;
        grid = cus * per_cu;
    }
    if (grid < 0) return;
    const float* inp[32]; for (int i = 0; i < 32; ++i) inp[i] = (const float*)d_in[i];
    float* outp = (float*)d_out; unsigned char* wsp = (unsigned char*)d_ws;
    void* kargs[34]; for (int i = 0; i < 32; ++i) kargs[i] = (void*)&inp[i];
    kargs[32] = (void*)&outp; kargs[33] = (void*)&wsp;
    hipError_t e = hipLaunchCooperativeKernel((const void*)mega, dim3(grid), dim3(512), kargs, LDS_BYTES, stream);
    if (e != hipSuccess) fprintf(stderr, "cooperative launch failed: %s (grid %d)\n", hipGetErrorString(e), grid);
}
```

```cpp
#include <hip/hip_runtime.h>
#include <hip/hip_cooperative_groups.h>
#include <cstdio>
#include <cstdint>
namespace cg = cooperative_groups;
#ifndef REP_MASK
#define REP_MASK 0
#endif

#define LAS __attribute__((address_space(3)))
#define DI __device__ __forceinline__
typedef unsigned short bf16_t;
typedef short bf16x8 __attribute__((ext_vector_type(8)));
typedef short s16x4 __attribute__((ext_vector_type(4)));
typedef float f32x2 __attribute__((ext_vector_type(2)));
typedef float f32x4 __attribute__((ext_vector_type(4)));
typedef float f32x16 __attribute__((ext_vector_type(16)));
typedef unsigned u32x4 __attribute__((ext_vector_type(4)));
typedef unsigned u32x2 __attribute__((ext_vector_type(2)));
typedef __bf16 bf2_t __attribute__((ext_vector_type(2)));

constexpr int DM = 1024, NB = 16, SEQ = 2048, CTX = 256, LROW = 2304, MROWS = NB * LROW, FF = 2816, NMOD = 9216;
constexpr float NORM_EPS = 1e-6f;
constexpr float LOG2E = 1.4426950408889634f;
constexpr float QSCALE = 0.125f * LOG2E;

constexpr size_t MiB = 1u << 20;
constexpr size_t WS_MOD = 0, WS_ROPE = 3 * MiB, WS_LAM = 3 * MiB + 16384, WS_BAR = 3 * MiB + 32768, WS_CD = 4 * MiB, WS_HC = 9 * MiB, WS_WB = 25 * MiB,
                 WS_U = 75 * MiB, WS_ACT = 219 * MiB, WS_Y = 471 * MiB, WS_END = 543 * MiB;
constexpr size_t WB_IN0 = 0, WB_OUT0 = 5767168, WB_IN1 = 8650752, WB_OUT1 = 14417920, WB_MIXIN = 17301504, WB_MIXOUT = 24641536, WB_G2T = 25690112;
constexpr int LDS_BYTES = 147456;

DI unsigned pk2(float lo, float hi) { f32x2 v = {lo, hi}; bf2_t b = __builtin_convertvector(v, bf2_t); return __builtin_bit_cast(unsigned, b); }
DI float bf2f(bf16_t h) { return __uint_as_float(((unsigned)h) << 16); }
DI float bflo(unsigned w) { return __uint_as_float(w << 16); }
DI float bfhi(unsigned w) { return __uint_as_float(w & 0xffff0000u); }
DI float wave_sum(float v) {
#pragma unroll
    for (int o = 1; o < 64; o <<= 1) v += __shfl_xor(v, o);
    return v;
}
#define LDS_BARRIER() asm volatile("s_waitcnt lgkmcnt(0)\n\ts_barrier" ::: "memory")
DI float fast_exp(float x) { return __builtin_amdgcn_exp2f(x * LOG2E); }
DI float sigmoidf_(float x) { return __builtin_amdgcn_rcpf(1.f + fast_exp(-x)); }
DI float siluf_(float x) { return x * sigmoidf_(x); }
DI float tanhf_(float x) { return 1.f - 2.f * __builtin_amdgcn_rcpf(1.f + fast_exp(2.f * x)); }

namespace pg8 {
constexpr int BM = 256, BK = 64, HALF = 128, HTB = HALF * BK * 2, NXCD = 8, WGM = 4;
__host__ __device__ __forceinline__ int lds_byte(int r, int c) { const int st = (r >> 4) * 2 + (c >> 5), rr = r & 15, cc = c & 31, ob = rr * 64 + cc * 2; return st * 1024 + (ob ^ (((ob >> 9) & 1) << 5)); }
__host__ __device__ __forceinline__ void stage_rc(int b, int& R, int& C) { const int st = b / 1024, sb = b % 1024, swz = sb ^ (((sb >> 9) & 1) << 5); R = (st >> 1) * 16 + swz / 64; C = (st & 1) * 32 + (swz % 64) / 2; }
__host__ __device__ __forceinline__ int perm32(int rho) { const int n = rho >> 4, i = rho & 15; return 8 * (i >> 2) + 4 * n + (i & 3); }

struct Unit { int pm, pn; };
struct Gemm { const bf16_t* A; const bf16_t* Bt; int lda, ldb, N, K, nM, skip; };

struct StaticOrder {
    int nM, nN, nwg, G, c, skip;
    int pmode, r0, nr;
    DI void init(int nM_, int N, int G_, int c_, int skip_) { nM = nM_; nN = N / BM; nwg = nM * nN; G = G_; c = c_; skip = skip_; pmode = 0; r0 = 0; nr = 0; }
    DI bool next(int i, Unit& u) const {
        if (pmode) {
            if (i >= nr) return false;
            const int round = r0 + i, xcd = c & 7, j = c >> 3, full = nM >> 6; int panel;
            if (round < full) { panel = round * 64 + xcd * 8 + (j & 7); u.pn = j >> 3; }
            else { if (j >= 8) return false; panel = full * 64 + 2 * xcd + (j & 1); u.pn = j >> 1; if (panel >= nM) return false; }
            u.pm = skip ? (panel + panel / 8 + 1) : panel;
            return true;
        }
        const long L = (long)i * G + c; if (L >= nwg) return false;
        int wgid = (int)L; { const int q = nwg / NXCD, r = nwg % NXCD, xcd = wgid % NXCD, off = wgid / NXCD; wgid = (xcd < r ? xcd * (q + 1) : r * (q + 1) + (xcd - r) * q) + off; }
        const int nig = WGM * nN, gid = wgid / nig, fm = gid * WGM, gsz = (nM - fm) < WGM ? (nM - fm) : WGM;
        int pm = fm + ((wgid % nig) % gsz); u.pn = (wgid % nig) / gsz;
        u.pm = skip ? (pm + pm / 8 + 1) : pm;
        return true;
    }
};

enum { EPI_PLAIN = 0, EPI_SWIGLU = 1, EPI_QKV_DA = 2, EPI_QKV_NA = 3, EPI_RWKV = 4 };
struct Epi {
    static constexpr bool PERM = true;
    int mode; bf16_t* O; int ldc; const float* cosT; const float* sinT;
    DI void operator()(const f32x4 (&acc)[2][2][4][2], const Unit& u, int wr, int wc, int fr, int fq) const {
        const int row0 = u.pm * BM + wr * 64 + fr;
        if (mode == EPI_SWIGLU) {
            const int col0 = u.pn * 128 + wc * 32 + 8 * fq;
#pragma unroll
            for (int ai = 0; ai < 2; ++ai)
#pragma unroll
                for (int m = 0; m < 4; ++m) {
                    bf16_t* rowp = O + (size_t)(row0 + ai * HALF + m * 16) * ldc + col0;
                    const f32x4 a0 = acc[ai][0][m][0], a1 = acc[ai][0][m][1], b0 = acc[ai][1][m][0], b1 = acc[ai][1][m][1];
                    u32x4 w;
                    w.x = pk2(siluf_(a0[0]) * b0[0], siluf_(a0[1]) * b0[1]); w.y = pk2(siluf_(a0[2]) * b0[2], siluf_(a0[3]) * b0[3]);
                    w.z = pk2(siluf_(a1[0]) * b1[0], siluf_(a1[1]) * b1[1]); w.w = pk2(siluf_(a1[2]) * b1[2], siluf_(a1[3]) * b1[3]);
                    *(u32x4*)rowp = w;
                }
        } else {
            const int col0 = u.pn * BM + wc * 32 + 8 * fq;
            const int jt = u.pm % 9;
            float sc = 1.f; bool rope = false; int act0 = 0, act1 = 0;
            if (mode == EPI_QKV_DA) { if (u.pn < 4) sc = QSCALE; if (u.pn < 8 && jt != 0) rope = true; }
            else if (mode == EPI_QKV_NA) { if (u.pn < 4) sc = QSCALE; }
            else if (mode == EPI_RWKV) { if (u.pn == 12) act0 = 1; if (u.pn == 13) { act0 = 2; act1 = 2; } }
#pragma unroll
            for (int ai = 0; ai < 2; ++ai)
#pragma unroll
                for (int m = 0; m < 4; ++m) {
                    bf16_t* rowp = O + (size_t)(row0 + ai * HALF + m * 16) * ldc + col0;
                    f32x4 c0 = {1.f, 1.f, 1.f, 1.f}, c1 = c0, s0 = {0.f, 0.f, 0.f, 0.f}, s1 = s0;
                    if (rope) {
                        const int t = (jt - 1) * 256 + ai * HALF + wr * 64 + m * 16 + fr;
                        const int pos = (wc & 1) ? (t & 63) : (t >> 6);
                        const float* cp = cosT + pos * 16 + 8 * (fq & 1); const float* sp = sinT + pos * 16 + 8 * (fq & 1);
                        c0 = *(const f32x4*)cp; c1 = *(const f32x4*)(cp + 4); s0 = *(const f32x4*)sp; s1 = *(const f32x4*)(sp + 4);
                        if (!(fq & 2)) { s0 = -s0; s1 = -s1; }
                    }
#pragma unroll
                    for (int bj = 0; bj < 2; ++bj) {
                        f32x4 v0 = acc[ai][bj][m][0], v1 = acc[ai][bj][m][1];
                        if (rope) {
                            f32x4 p0, p1;
#pragma unroll
                            for (int e = 0; e < 4; ++e) { p0[e] = __shfl_xor(v0[e], 32); p1[e] = __shfl_xor(v1[e], 32); }
                            v0 = v0 * c0 + p0 * s0; v1 = v1 * c1 + p1 * s1;
                        }
                        v0 = v0 * sc; v1 = v1 * sc;
                        const int act = bj ? act1 : act0;
                        if (act == 1) {
#pragma unroll
                            for (int e = 0; e < 4; ++e) { v0[e] = tanhf_(v0[e]); v1[e] = tanhf_(v1[e]); }
                        } else if (act == 2) {
#pragma unroll
                            for (int e = 0; e < 4; ++e) { v0[e] = sigmoidf_(v0[e]); v1[e] = sigmoidf_(v1[e]); }
                        }
                        u32x4 w; w.x = pk2(v0[0], v0[1]); w.y = pk2(v0[2], v0[3]); w.z = pk2(v1[0], v1[1]); w.w = pk2(v1[2], v1[3]);
                        *(u32x4*)(rowp + bj * HALF) = w;
                    }
                }
        }
    }
};

DI void gemm_phase(LAS unsigned char* lds, const int tid, const Gemm g, const StaticOrder& S, const Epi& E) {
    const int wid = __builtin_amdgcn_readfirstlane(tid >> 6), lane = tid & 63, wr = wid >> 2, wc = wid & 3, fr = lane & 15, fq = lane >> 4;
    const int K = g.K, nt = K / BK;
    unsigned voffA[2], voffB[2];
#pragma unroll
    for (int i = 0; i < 2; ++i) { int R, C; stage_rc(tid * 16 + i * 8192, R, C); const int Rb = (R & ~31) + perm32(R & 31);
        voffA[i] = (unsigned)(R * g.lda + C) * 2u; voffB[i] = (unsigned)(Rb * g.ldb + C) * 2u; }
    const size_t kstep = (size_t)(BK * 2);
    const size_t hstepA = (size_t)HALF * g.lda * 2, hstepB = (size_t)HALF * g.ldb * 2;
    const size_t tstepA = 2 * hstepA, tstepB = 2 * hstepB;
    const unsigned ldsw = (unsigned)wid * 1024u;
    const int aoff = lds_byte(wr * 64 + fr, fq * 8), boff = lds_byte(wc * 32 + fr, fq * 8);
#define PG8_SA(b, h) (((b) * 2 + (h)) * HTB)
#define PG8_SB(b, h) ((4 + (b) * 2 + (h)) * HTB)
#define PG8_STAGE(bufoff, gbase, voff) do { _Pragma("unroll") for (int _i = 0; _i < 2; ++_i) \
        __builtin_amdgcn_global_load_lds((const unsigned*)((const char*)(gbase) + (voff)[_i]), (LAS unsigned*)(lds + (bufoff) + ldsw + _i * 8192), 16, 0, 0); } while (0)
#define PG8_LDA(dst, b, h) do { _Pragma("unroll") for (int m = 0; m < 4; ++m) _Pragma("unroll") for (int k = 0; k < 2; ++k) dst[m][k] = *(const LAS bf16x8*)(lds + PG8_SA(b, h) + aoff + m * 2048 + k * 1024); } while (0)
#define PG8_LDB(dst, b, h) do { _Pragma("unroll") for (int n = 0; n < 2; ++n) _Pragma("unroll") for (int k = 0; k < 2; ++k) dst[n][k] = *(const LAS bf16x8*)(lds + PG8_SB(b, h) + boff + n * 2048 + k * 1024); } while (0)
#define PG8_MMA(ai, bj, At, Bt) do { __builtin_amdgcn_s_setprio(1); _Pragma("unroll") for (int m = 0; m < 4; ++m) _Pragma("unroll") for (int n = 0; n < 2; ++n) _Pragma("unroll") for (int k = 0; k < 2; ++k) \
        acc[ai][bj][m][n] = __builtin_amdgcn_mfma_f32_16x16x32_bf16(Bt[n][k], At[m][k], acc[ai][bj][m][n], 0, 0, 0); __builtin_amdgcn_s_setprio(0); } while (0)
#define PG8_WAIT_V(n) asm volatile("s_waitcnt vmcnt(" #n ")" ::: "memory")
#define PG8_WAIT_L(n) asm volatile("s_waitcnt lgkmcnt(" #n ")" ::: "memory")
#define PG8_BAR __builtin_amdgcn_s_barrier()
#define PG8_SCHED __builtin_amdgcn_sched_barrier(0)
    Unit cur, nxt; int ui = 0;
    if (!S.next(0, cur)) return;
    f32x4 acc[2][2][4][2];
#pragma unroll
    for (int a = 0; a < 2; ++a)
#pragma unroll
        for (int b = 0; b < 2; ++b)
#pragma unroll
            for (int m = 0; m < 4; ++m)
#pragma unroll
                for (int n = 0; n < 2; ++n) acc[a][b][m][n] = (f32x4){0.f, 0.f, 0.f, 0.f};
    bf16x8 At[4][2], B0[2][2], B1[2][2];
    const char* cA = (const char*)g.A + (size_t)cur.pm * tstepA; const char* cB = (const char*)g.Bt + (size_t)cur.pn * tstepB;
    PG8_STAGE(PG8_SB(0, 0), cB, voffB); PG8_STAGE(PG8_SB(0, 1), cB + hstepB, voffB); PG8_STAGE(PG8_SA(0, 0), cA, voffA); PG8_STAGE(PG8_SA(0, 1), cA + hstepA, voffA);
    if (wr == 1) PG8_BAR;
    PG8_WAIT_V(2); PG8_BAR;
    PG8_STAGE(PG8_SB(1, 0), cB + kstep, voffB); PG8_STAGE(PG8_SA(1, 0), cA + kstep, voffA); PG8_STAGE(PG8_SB(1, 1), cB + hstepB + kstep, voffB);
    PG8_WAIT_V(6); PG8_BAR;
    for (;;) {
        const bool has_next = S.next(ui + 1, nxt);
        const char* nA = has_next ? (const char*)g.A + (size_t)nxt.pm * tstepA : cA; const char* nB = has_next ? (const char*)g.Bt + (size_t)nxt.pn * tstepB : cB;
        for (int t = 0; t < nt; t += 2) {
            const bool last = (t == nt - 2);
            const char* a1 = cA + (size_t)(t + 1) * kstep;
            const char* a2 = last ? nA : cA + (size_t)(t + 2) * kstep; const char* b2 = last ? nB : cB + (size_t)(t + 2) * kstep;
            const char* a3 = a2 + kstep; const char* b3 = b2 + kstep;
            PG8_LDB(B0, 0, 0); PG8_LDB(B1, 0, 1); PG8_SCHED; PG8_LDA(At, 0, 0); PG8_STAGE(PG8_SA(1, 1), a1 + hstepA, voffA);
            PG8_WAIT_V(8); PG8_WAIT_L(0); PG8_BAR; PG8_MMA(0, 0, At, B0); PG8_MMA(0, 1, At, B1); PG8_BAR; PG8_SCHED;
            PG8_LDA(At, 0, 1); PG8_STAGE(PG8_SB(0, 0), b2, voffB); PG8_STAGE(PG8_SB(0, 1), b2 + hstepB, voffB); PG8_STAGE(PG8_SA(0, 0), a2, voffA);
            PG8_WAIT_V(8); PG8_WAIT_L(0); PG8_BAR; PG8_MMA(1, 0, At, B0); PG8_MMA(1, 1, At, B1); PG8_BAR; PG8_SCHED;
            PG8_LDB(B0, 1, 0); PG8_LDB(B1, 1, 1); PG8_SCHED; PG8_LDA(At, 1, 0); PG8_STAGE(PG8_SA(0, 1), a2 + hstepA, voffA);
            PG8_WAIT_V(8); PG8_WAIT_L(0); PG8_BAR; PG8_MMA(0, 0, At, B0); PG8_MMA(0, 1, At, B1); PG8_BAR; PG8_SCHED;
            PG8_LDA(At, 1, 1); PG8_STAGE(PG8_SB(1, 0), b3, voffB); PG8_STAGE(PG8_SB(1, 1), b3 + hstepB, voffB); PG8_STAGE(PG8_SA(1, 0), a3, voffA);
            PG8_WAIT_V(8); PG8_WAIT_L(0); PG8_BAR; PG8_MMA(1, 0, At, B0); PG8_MMA(1, 1, At, B1); PG8_BAR; PG8_SCHED;
        }
        if (wr == 0) PG8_BAR;
        E(acc, cur, wr, wc, fr, fq);
        if (!has_next) break;
#pragma unroll
        for (int a = 0; a < 2; ++a)
#pragma unroll
            for (int b = 0; b < 2; ++b)
#pragma unroll
                for (int m = 0; m < 4; ++m)
#pragma unroll
                    for (int n = 0; n < 2; ++n) acc[a][b][m][n] = (f32x4){0.f, 0.f, 0.f, 0.f};
        cur = nxt; cA = nA; cB = nB; ++ui;
        if (wr == 1) PG8_BAR;
    }
    PG8_WAIT_V(0);
    PG8_BAR;
#undef PG8_SA
#undef PG8_SB
#undef PG8_STAGE
#undef PG8_LDA
#undef PG8_LDB
#undef PG8_MMA
#undef PG8_WAIT_V
#undef PG8_WAIT_L
#undef PG8_BAR
#undef PG8_SCHED
}
}

struct Args { const float* in[32]; float* out; unsigned char* ws; };

struct Frame {
    LAS unsigned char* lds;
    int tid, lane, wave, vcu, G, gw, NGW, bx;
    const float* const* in;
};
enum { I_X = 0, I_C, I_CTX, I_CCTX, I_ADAW, I_ADAB, I_NORMG, I_FWIN, I_FWOUT, I_DAWIN, I_DAWOUT, I_DALAM, I_DASUB, I_NAWIN, I_NAWOUT, I_NARPB,
       I_RWMU, I_RWWIN, I_RWWOUT, I_RWW0, I_RWW1, I_RWW2, I_RWA0, I_RWA1, I_RWA2, I_RWG1, I_RWG2, I_RWKK, I_RWKA, I_RWRK, I_RWLNG, I_RWLNB };

DI void conv_item(const float* W, int ldw, int k0, int n0, int kmax, const float* mu, bf16_t* dst, int ldd, int dst_row0, int dst_k0, LAS float* scr, int lane) {
#pragma unroll 8
    for (int i = 0; i < 32; ++i) { const int kk = 2 * i + (lane >> 5); const int k = k0 + kk;
        float v = 0.f; if (k < kmax) { v = W[(size_t)k * ldw + n0 + (lane & 31)]; if (mu) v *= mu[k]; }
        scr[kk * 33 + (lane & 31)] = v; }
    asm volatile("s_waitcnt lgkmcnt(0)" ::: "memory");
    const int c = lane & 7;
#pragma unroll
    for (int j = 0; j < 4; ++j) { const int n = (lane >> 3) + 8 * j; const LAS float* s = scr + (8 * c) * 33 + n;
        u32x4 o; o.x = pk2(s[0 * 33], s[1 * 33]); o.y = pk2(s[2 * 33], s[3 * 33]); o.z = pk2(s[4 * 33], s[5 * 33]); o.w = pk2(s[6 * 33], s[7 * 33]);
        *(u32x4*)(dst + (size_t)(dst_row0 + n) * ldd + dst_k0 + k0 + 8 * c) = o; }
    asm volatile("s_waitcnt lgkmcnt(0)" ::: "memory");
}

DI void convert_layer(Frame& F, unsigned char* ws, int l) {
    bf16_t* WB = (bf16_t*)(ws + WS_WB);
    LAS float* scr = (LAS float*)(F.lds + F.wave * 16384);
    const int kind = l % 3, slot = l / 3;
    constexpr int I_FIN = 16 * 176, I_FOUT = 44 * 32, I_MIN = 16 * 96, I_MOUT = 16 * 32;
    const float* fwin = F.in[I_FWIN] + (size_t)l * 2 * 1024 * 5632;
    const float* fwout = F.in[I_FWOUT] + (size_t)l * 2 * 2816 * 1024;
    int nitems = 2 * I_FIN + 2 * I_FOUT + I_MOUT;
    if (kind == 2) nitems += 2 * I_MIN + 4 * 16 * 2 * 2 + 16 * 5 * 2 + 4 * 32 + 96;
    else nitems += I_MIN;
    for (int it = F.gw; it < nitems; it += F.NGW) {
        int r = it;
        if (r < 2 * I_FIN) { const int s = r / I_FIN; r -= s * I_FIN; const int kb = r / 176, nb = r % 176, n0 = nb * 32;
            const int hf = n0 / 2816, rem = n0 % 2816, p = rem / 128, i = rem % 128;
            conv_item(fwin + (size_t)s * 1024 * 5632, 5632, kb * 64, n0, 1024, nullptr, WB + (s ? WB_IN1 : WB_IN0), 1024, p * 256 + hf * 128 + i, 0, scr, F.lane); continue; }
        r -= 2 * I_FIN;
        if (r < 2 * I_FOUT) { const int s = r / I_FOUT; r -= s * I_FOUT; const int kb = r / 32, nb = r % 32;
            conv_item(fwout + (size_t)s * 2816 * 1024, 1024, kb * 64, nb * 32, 2816, nullptr, WB + (s ? WB_OUT1 : WB_OUT0), 2816, nb * 32, 0, scr, F.lane); continue; }
        r -= 2 * I_FOUT;
        if (r < I_MOUT) { const float* w = kind == 0 ? F.in[I_DAWOUT] + (size_t)slot * 1024 * 1024 : kind == 1 ? F.in[I_NAWOUT] : F.in[I_RWWOUT];
            const int kb = r / 32, nb = r % 32;
            conv_item(w, 1024, kb * 64, nb * 32, 1024, nullptr, WB + WB_MIXOUT, 1024, nb * 32, 0, scr, F.lane); continue; }
        r -= I_MOUT;
        if (kind != 2) { const float* w = kind == 0 ? F.in[I_DAWIN] + (size_t)slot * 1024 * 3072 : F.in[I_NAWIN];
            const int kb = r / 96, nb = r % 96;
            conv_item(w, 3072, kb * 64, nb * 32, 1024, nullptr, WB + WB_MIXIN, 1024, nb * 32, 0, scr, F.lane); continue; }
        const float* mu = F.in[I_RWMU];
        if (r < 2 * I_MIN) { const int var = r / I_MIN; r -= var * I_MIN; const int kb = r / 96, nb = r % 96, n0 = nb * 32;
            const int mj = n0 < 1024 ? 0 : (n0 < 2048 ? 2 : 3);
            conv_item(F.in[I_RWWIN], 3072, kb * 64, n0, 1024, var ? mu + mj * 1024 : nullptr, WB + WB_MIXIN, 2048, n0, var * 1024, scr, F.lane); continue; }
        r -= 2 * I_MIN;
        if (r < 4 * 16 * 2 * 2) { const int var = r & 1; r >>= 1; const int nb = r & 1; r >>= 1; const int kb = r & 15; r >>= 4; const int dir = r & 1, isa = r >> 1;
            const float* w = (isa ? F.in[I_RWA1] : F.in[I_RWW1]) + (size_t)dir * 1024 * 64;
            conv_item(w, 64, kb * 64, nb * 32, 1024, var ? mu + (isa ? 4 : 1) * 1024 : nullptr, WB + WB_MIXIN, 2048, (isa ? 3200 : 3072) + dir * 64 + nb * 32, var * 1024, scr, F.lane); continue; }
        r -= 4 * 16 * 2 * 2;
        if (r < 16 * 5 * 2) { const int var = r & 1; r >>= 1; const int nb = r % 5, kb = r / 5;
            conv_item(F.in[I_RWG1], 160, kb * 64, nb * 32, 1024, var ? mu + 5 * 1024 : nullptr, WB + WB_MIXIN, 2048, 3328 + nb * 32, var * 1024, scr, F.lane); continue; }
        r -= 16 * 5 * 2;
        if (r < 4 * 32) { const int kb = r / 32, nb = r % 32;
            conv_item(F.in[I_RWG2], 1024, kb * 64, nb * 32, 160, nullptr, WB + WB_G2T, 256, nb * 32, 0, scr, F.lane); continue; }
        r -= 4 * 32;
        { bf16_t* z = WB + WB_MIXIN + (size_t)(3488 + r) * 2048;
#pragma unroll
          for (int j = 0; j < 4; ++j) *(u32x4*)(z + (j * 64 + F.lane) * 8) = (u32x4){0u, 0u, 0u, 0u}; }
    }
}

DI void phase0(Frame& F, unsigned char* ws) {
    LAS float* sl = (LAS float*)F.lds;
    LAS float* part = (LAS float*)(F.lds + 69632);
    float* MOD = (float*)(ws + WS_MOD);
    for (int i = F.tid; i < 17 * 1024; i += 512) { const float v = i < 16384 ? F.in[I_C][i] : F.in[I_CCTX][i - 16384]; sl[i] = v / (1.f + expf(-v)); }
    __syncthreads();
    for (int item = F.vcu; item < 4 * 72; item += F.G) {
        const int l = item / 72, n0 = (item % 72) * 128;
        const float* W = F.in[I_ADAW] + (size_t)l * 1024 * NMOD + n0 + 2 * F.lane;
        float acc[17][2];
#pragma unroll
        for (int r = 0; r < 17; ++r) { acc[r][0] = 0.f; acc[r][1] = 0.f; }
        const int kbase = F.wave * 128;
        for (int k4 = 0; k4 < 128; k4 += 4) {
            f32x2 w[4];
#pragma unroll
            for (int e = 0; e < 4; ++e) w[e] = *(const f32x2*)(W + (size_t)(kbase + k4 + e) * NMOD);
#pragma unroll
            for (int r = 0; r < 17; ++r) { const f32x4 s = *(const LAS f32x4*)(sl + r * 1024 + kbase + k4);
#pragma unroll
                for (int e = 0; e < 4; ++e) { acc[r][0] += s[e] * w[e].x; acc[r][1] += s[e] * w[e].y; } }
        }
#pragma unroll
        for (int r = 0; r < 17; ++r) *(LAS f32x2*)(part + (F.wave * 17 + r) * 128 + 2 * F.lane) = (f32x2){acc[r][0], acc[r][1]};
        __syncthreads();
        for (int idx = F.tid; idx < 17 * 128; idx += 512) { const int r = idx >> 7, cI = idx & 127; float s = 0.f;
#pragma unroll
            for (int w = 0; w < 8; ++w) s += part[(w * 17 + r) * 128 + cI];
            MOD[((size_t)l * 17 + r) * NMOD + n0 + cI] = s + F.in[I_ADAB][(size_t)l * NMOD + n0 + cI]; }
        __syncthreads();
    }
    if (F.bx == 0) {
        for (int i = F.tid; i < 3456; i += 512) ((unsigned*)(ws + WS_BAR))[i] = 0u;
        float* cosT = (float*)(ws + WS_ROPE); float* sinT = cosT + 1024;
        for (int i = F.tid; i < 1024; i += 512) { const int pos = i >> 4, p = i & 15; const float fr = powf(10000.f, -(float)p / 16.f); const float ang = (float)pos * fr; cosT[i] = cosf(ang); sinT[i] = sinf(ang); }
        if (F.tid < 2) { const float* lv = F.in[I_DALAM] + F.tid * 256; float d0 = 0.f, d1 = 0.f;
            for (int i = 0; i < 64; ++i) { d0 += lv[i] * lv[64 + i]; d1 += lv[128 + i] * lv[192 + i]; }
            const float li = 0.8f - 0.6f * expf(-0.3f * (float)(F.tid * 3));
            float* lam = (float*)(ws + WS_LAM); lam[2 * F.tid] = expf(d0) - expf(d1) + li; lam[2 * F.tid + 1] = li; }
    }
    __syncthreads();
    convert_layer(F, ws, 0);
}

struct RowPass {
    const float* hsrc_lat; const float* hsrc_ctx; float* hdst_lat; float* hdst_ctx;
    const bf16_t* Y;
    const float* gpost; int gate_idx; float coef; int lpost;
    const float* gpre; int shift_idx; int lpre;
    bf16_t* U; int ldu; int skip_ctx;
};
DI void row_pass(Frame& F, unsigned char* ws, const RowPass& P, int row_lo, int row_hi, int widx, int nw) {
    const float* MOD = (const float*)(ws + WS_MOD);
    const int rpw = (row_hi - row_lo + nw - 1) / nw;
    const int rbeg = row_lo + widx * rpw, rend = min(rbeg + rpw, row_hi);
    if (rbeg >= rend) return;
    const int l4 = 4 * F.lane;
    f32x4 gpo[4], gpr[4], gat[4], shf[4], scl[4];
#pragma unroll
    for (int j = 0; j < 4; ++j) { gpo[j] = *(const f32x4*)(P.gpost + l4 + 256 * j); gpr[j] = P.gpre ? *(const f32x4*)(P.gpre + l4 + 256 * j) : (f32x4){0.f, 0.f, 0.f, 0.f}; }
    int cur_mrow = -1;
    f32x4 hn[4]; u32x2 yn[4];
#define RP_ADDR(row, isctx, hoff) const int _b = (row) / LROW, _t = (row) % LROW; const bool isctx = _t < CTX; \
        const size_t hoff = isctx ? ((size_t)_b * CTX + _t) * DM : ((size_t)_b * SEQ + (_t - CTX)) * DM;
#define RP_LOAD(row) do { RP_ADDR(row, ic_, ho_) if (!(ic_ && P.skip_ctx)) { const float* hs_ = (ic_ ? P.hsrc_ctx : P.hsrc_lat) + ho_ + l4; \
        _Pragma("unroll") for (int j = 0; j < 4; ++j) hn[j] = *(const f32x4*)(hs_ + 256 * j); \
        if (P.Y) { const bf16_t* yr_ = P.Y + (size_t)(row) * DM + l4; _Pragma("unroll") for (int j = 0; j < 4; ++j) yn[j] = *(const u32x2*)(yr_ + 256 * j); } } } while (0)
    RP_LOAD(rbeg);
    for (int row = rbeg; row < rend; ++row) {
        f32x4 h[4]; u32x2 yv[4];
#pragma unroll
        for (int j = 0; j < 4; ++j) { h[j] = hn[j]; yv[j] = yn[j]; }
        if (row + 1 < rend) RP_LOAD(row + 1);
        RP_ADDR(row, isctx, hoff)
        if (isctx && P.skip_ctx) continue;
        float* hd = (isctx ? P.hdst_ctx : P.hdst_lat) + hoff + l4;
        const bool copy_h = ((isctx ? P.hsrc_ctx : P.hsrc_lat) != (isctx ? P.hdst_ctx : P.hdst_lat));
        const int mrow = isctx ? 16 : _b;
        if (mrow != cur_mrow) { cur_mrow = mrow;
            const float* gate = MOD + ((size_t)P.lpost * 17 + mrow) * NMOD + P.gate_idx * DM + l4;
            const float* sh = MOD + ((size_t)P.lpre * 17 + mrow) * NMOD + P.shift_idx * DM + l4;
#pragma unroll
            for (int j = 0; j < 4; ++j) { gat[j] = *(const f32x4*)(gate + 256 * j) * P.coef; shf[j] = *(const f32x4*)(sh + 256 * j); scl[j] = *(const f32x4*)(sh + DM + 256 * j) + 1.f; } }
        if (P.Y) {
            f32x4 y[4]; float ss = 0.f;
#pragma unroll
            for (int j = 0; j < 4; ++j) { y[j] = (f32x4){bflo(yv[j].x), bfhi(yv[j].x), bflo(yv[j].y), bfhi(yv[j].y)};
                ss += (y[j].x * y[j].x + y[j].y * y[j].y) + (y[j].z * y[j].z + y[j].w * y[j].w); }
            const float rstd = 1.f / sqrtf(wave_sum(ss) * (1.f / DM) + NORM_EPS);
#pragma unroll
            for (int j = 0; j < 4; ++j) h[j] = h[j] + gat[j] * ((y[j] * rstd) * gpo[j]);
        }
        if (P.Y || copy_h) {
#pragma unroll
            for (int j = 0; j < 4; ++j) *(f32x4*)(hd + 256 * j) = h[j];
        }
        if (P.gpre) {
            float ss = 0.f;
#pragma unroll
            for (int j = 0; j < 4; ++j) ss += (h[j].x * h[j].x + h[j].y * h[j].y) + (h[j].z * h[j].z + h[j].w * h[j].w);
            const float rstd = 1.f / sqrtf(wave_sum(ss) * (1.f / DM) + NORM_EPS);
            bf16_t* ur = P.U + (size_t)row * P.ldu + l4;
#pragma unroll
            for (int j = 0; j < 4; ++j) { const f32x4 u = ((h[j] * rstd) * gpr[j]) * scl[j] + shf[j];
                *(u32x2*)(ur + 256 * j) = (u32x2){pk2(u.x, u.y), pk2(u.z, u.w)}; }
        }
    }
#undef RP_ADDR
#undef RP_LOAD
}

DI void xx_pass(Frame& F, unsigned char* ws) {
    bf16_t* U = (bf16_t*)(ws + WS_U);
    for (int row = F.gw; row < MROWS; row += F.NGW) {
        const int t = row % LROW;
        const bool first = (t == 0) || (t == CTX), lastr = (t == CTX - 1) || (t == LROW - 1);
        const bf16_t* ur = U + (size_t)row * 2048 + 8 * F.lane;
#pragma unroll
        for (int j = 0; j < 2; ++j) {
            const u32x4 c = *(const u32x4*)(ur + 512 * j);
            u32x4 p = {0u, 0u, 0u, 0u}, n = {0u, 0u, 0u, 0u};
            if (!first) p = *(const u32x4*)(ur - 2048 + 512 * j);
            if (!lastr) n = *(const u32x4*)(ur + 2048 + 512 * j);
            u32x4 o;
#pragma unroll
            for (int e = 0; e < 4; ++e) { const float lo = 0.5f * (bflo(p[e]) + bflo(n[e])) - bflo(c[e]); const float hi = 0.5f * (bfhi(p[e]) + bfhi(n[e])) - bfhi(c[e]); o[e] = pk2(lo, hi); }
            *(u32x4*)((bf16_t*)ur + 1024 + 512 * j) = o;
        }
    }
}

DI f32x16 mfma32(bf16x8 a, bf16x8 b, f32x16 c) { return __builtin_amdgcn_mfma_f32_32x32x16_bf16(a, b, c, 0, 0, 0); }
DI bf16x8 pack8(const f32x16& x, int s) { u32x4 p; p.x = pk2(x[8 * s], x[8 * s + 1]); p.y = pk2(x[8 * s + 2], x[8 * s + 3]); p.z = pk2(x[8 * s + 4], x[8 * s + 5]); p.w = pk2(x[8 * s + 6], x[8 * s + 7]); return __builtin_bit_cast(bf16x8, p); }
typedef short v4i16_t __attribute__((ext_vector_type(4)));
DI s16x4 vtr(LAS const unsigned char* p) { return __builtin_bit_cast(s16x4, __builtin_amdgcn_ds_read_tr16_b64_v4i16((LAS v4i16_t*)p)); }
DI float max3f(float a, float b, float c) { return __builtin_fmaxf(__builtin_fmaxf(a, b), c); }
DI float max16(const f32x16& p) { float a = max3f(p[0], p[1], p[2]), b = max3f(p[3], p[4], p[5]);
    a = max3f(a, p[6], p[7]); b = max3f(b, p[8], p[9]); a = max3f(a, p[10], p[11]); b = max3f(b, p[12], p[13]); a = max3f(a, p[14], p[15]); return __builtin_fmaxf(a, b); }

template <int NDB>
DI void softmax_pv(f32x16& p0, f32x16& p1, f32x16 (&o)[NDB], f32x16& negm, float& m_run, float& l_run, const bool first, LAS float* wsf, LAS const unsigned char* Vb, int KP, int r, int hh, int lane) {
    float mx = __builtin_fmaxf(max16(p0), max16(p1)); mx = __builtin_fmaxf(mx, __shfl_xor(mx, 32));
    if (first || __any(mx > 8.f)) {
        const float delta = first ? mx : __builtin_fmaxf(mx, 0.f);
        m_run += delta;
#pragma unroll
        for (int i = 0; i < 16; ++i) { p0[i] -= delta; p1[i] -= delta; negm[i] = -m_run; }
        if (!first) {
            const float alpha = __builtin_amdgcn_exp2f(-delta);
            l_run *= alpha;
            if (hh == 0) wsf[r] = alpha;
#pragma unroll
            for (int g4 = 0; g4 < 4; ++g4) { const f32x4 a4 = *(const LAS f32x4*)(wsf + 8 * g4 + 4 * hh);
#pragma unroll
                for (int d = 0; d < NDB; ++d)
#pragma unroll
                    for (int e = 0; e < 4; ++e) o[d][4 * g4 + e] *= a4[e]; }
        }
    }
    f32x2 ls2 = {0.f, 0.f};
#pragma unroll
    for (int i = 0; i < 16; i += 2) {
        p0[i] = __builtin_amdgcn_exp2f(p0[i]); p0[i + 1] = __builtin_amdgcn_exp2f(p0[i + 1]); p1[i] = __builtin_amdgcn_exp2f(p1[i]); p1[i + 1] = __builtin_amdgcn_exp2f(p1[i + 1]);
        ls2 += (f32x2){p0[i], p0[i + 1]}; ls2 += (f32x2){p1[i], p1[i + 1]};
    }
    l_run += ls2.x + ls2.y;
    const int i16 = lane & 15, q4 = i16 >> 2, p4 = i16 & 3, g1 = (lane >> 4) & 1;
    LAS const unsigned char* vl = Vb + (4 * hh + q4) * 64 + 32 * g1 + 8 * p4;
    const bf16x8 pa[4] = {pack8(p0, 0), pack8(p0, 1), pack8(p1, 0), pack8(p1, 1)};
    s16x4 flo[2][NDB], fhi[2][NDB];
#pragma unroll
    for (int d = 0; d < NDB; ++d) { flo[0][d] = vtr(vl + d * 4096); fhi[0][d] = vtr(vl + 8 * 64 + d * 4096); }
#pragma unroll
    for (int k = 0; k < 4; ++k) {
        if (k + 1 < 4) {
            LAS const unsigned char* vk = vl + 16 * (k + 1) * 64;
#pragma unroll
            for (int d = 0; d < NDB; ++d) { flo[(k + 1) & 1][d] = vtr(vk + d * 4096); fhi[(k + 1) & 1][d] = vtr(vk + 8 * 64 + d * 4096); }
        }
        __builtin_amdgcn_sched_barrier(0);
#pragma unroll
        for (int d = 0; d < NDB; ++d) { const bf16x8 vb = __builtin_shufflevector(flo[k & 1][d], fhi[k & 1][d], 0, 1, 2, 3, 4, 5, 6, 7); o[d] = mfma32(pa[k], vb, o[d]); }
        __builtin_amdgcn_sched_barrier(0);
    }
}

DI void da_unit(LAS unsigned char* lds, const int tid, const bf16_t* QKV, bf16_t* O, int q_row0, int kv_row0, int NT, int h, float lam, float one_m_li, const float* subg) {
    const int lane = tid & 63, wid = __builtin_amdgcn_readfirstlane(tid >> 6), r = lane & 31, hh = lane >> 5;
    const int qg = wid >> 1, j = wid & 1;
    constexpr int KP = 272, STG = 2 * 64 * KP;
    LAS float* wsf = (LAS float*)(lds + 2 * STG) + wid * 64;
    const bf16_t* gbase = QKV + (size_t)(kv_row0 + (tid >> 4)) * 3072 + 1024 + h * 128 + (tid & 15) * 8;
    const int lbase = (tid >> 4) * KP + (tid & 15) * 16;
    const int vbase = ((tid & 15) >> 2) * 4096 + (tid >> 4) * 64 + (tid & 3) * 16;
    u32x4 st[4];
#define DA_LOAD(t) do { _Pragma("unroll") for (int i = 0; i < 4; ++i) st[i] = *(const u32x4*)(gbase + (size_t)(t) * 64 * 3072 + (size_t)(i & 1) * 32 * 3072 + (i >> 1) * 1024); } while (0)
#define DA_STORE(buf) do { _Pragma("unroll") for (int i = 0; i < 2; ++i) { *(LAS u32x4*)(lds + (buf) * STG + lbase + i * 32 * KP) = st[i]; *(LAS u32x4*)(lds + (buf) * STG + 64 * KP + vbase + i * 32 * 64) = st[2 + i]; } } while (0)
    const bf16_t* qp = QKV + (size_t)(q_row0 + 32 * qg + r) * 3072 + h * 128 + j * 64 + 8 * hh;
    bf16x8 qr[4];
#pragma unroll
    for (int d0 = 0; d0 < 4; ++d0) qr[d0] = *(const bf16x8*)(qp + 16 * d0);
    f32x16 o[4];
#pragma unroll
    for (int d = 0; d < 4; ++d)
#pragma unroll
        for (int i = 0; i < 16; ++i) o[d][i] = 0.f;
    float m_run = 0.f, l_run = 0.f;
    f32x16 negm;
#pragma unroll
    for (int i = 0; i < 16; ++i) negm[i] = 0.f;
    DA_LOAD(0); DA_STORE(0); __syncthreads();
    for (int t = 0; t < NT; ++t) {
        const int cur = t & 1;
        if (t + 1 < NT) DA_LOAD(t + 1);
        LAS const unsigned char* Kb = lds + cur * STG + j * 128 + r * KP + hh * 16;
        LAS const unsigned char* Vb = lds + cur * STG + 64 * KP;
        f32x16 p0 = negm, p1 = negm;
#pragma unroll
        for (int d0 = 0; d0 < 4; ++d0) { const bf16x8 k0 = *(const LAS bf16x8*)(Kb + d0 * 32), k1 = *(const LAS bf16x8*)(Kb + 32 * KP + d0 * 32);
            p0 = mfma32(k0, qr[d0], p0); p1 = mfma32(k1, qr[d0], p1); }
        softmax_pv<4>(p0, p1, o, negm, m_run, l_run, t == 0, wsf, Vb, KP, r, hh, lane);
        if (t + 1 < NT) DA_STORE(cur ^ 1);
        LDS_BARRIER();
    }
#undef DA_LOAD
#undef DA_STORE
    const float lt = l_run + __shfl_xor(l_run, 32);
    if (hh == 0) wsf[r] = 1.f / lt;
    float rl[16];
#pragma unroll
    for (int g4 = 0; g4 < 4; ++g4) { const f32x4 a4 = *(const LAS f32x4*)(wsf + 8 * g4 + 4 * hh);
#pragma unroll
        for (int e = 0; e < 4; ++e) rl[4 * g4 + e] = a4[e]; }
    LAS float* R = (LAS float*)lds + qg * 32 * 132;
    if (j == 1) {
#pragma unroll
        for (int d = 0; d < 4; ++d)
#pragma unroll
            for (int i = 0; i < 16; ++i) R[((i & 3) + 8 * (i >> 2) + 4 * hh) * 132 + d * 32 + r] = o[d][i] * rl[i] * lam;
    }
    __syncthreads();
    if (j == 0) {
#pragma unroll
        for (int d = 0; d < 4; ++d)
#pragma unroll
            for (int i = 0; i < 16; ++i) { const int idx = ((i & 3) + 8 * (i >> 2) + 4 * hh) * 132 + d * 32 + r; R[idx] = o[d][i] * rl[i] - R[idx]; }
    }
    __syncthreads();
    {
        const int row = tid >> 2, qtr = tid & 3;
        LAS const float* rp = (LAS const float*)lds + (row >> 5) * 32 * 132 + (row & 31) * 132 + qtr * 32;
        f32x4 v[8]; float ss = 0.f;
#pragma unroll
        for (int c = 0; c < 8; ++c) { v[c] = *(const LAS f32x4*)(rp + 4 * c); ss += (v[c].x * v[c].x + v[c].y * v[c].y) + (v[c].z * v[c].z + v[c].w * v[c].w); }
        ss += __shfl_xor(ss, 1); ss += __shfl_xor(ss, 2);
        const float rs = one_m_li / sqrtf(ss * (1.f / 128.f) + NORM_EPS);
        bf16_t* op = O + (size_t)(q_row0 + row) * DM + h * 128 + qtr * 32;
        const float* gp = subg + qtr * 32;
#pragma unroll
        for (int c = 0; c < 4; ++c) { const f32x4 g0 = *(const f32x4*)(gp + 8 * c), g1 = *(const f32x4*)(gp + 8 * c + 4); const f32x4 a = v[2 * c] * rs * g0, b = v[2 * c + 1] * rs * g1;
            *(u32x4*)(op + 8 * c) = (u32x4){pk2(a.x, a.y), pk2(a.z, a.w), pk2(b.x, b.y), pk2(b.z, b.w)}; }
    }
    __syncthreads();
}

DI void da_phase(Frame& F, unsigned char* ws, int l) {
    const bf16_t* QKV = (const bf16_t*)(ws + WS_ACT); bf16_t* O = (bf16_t*)(ws + WS_U);
    const int slot = l / 3; const bool last = (l == 3);
    const float* lamv = (const float*)(ws + WS_LAM); const float lam = lamv[2 * slot], li = lamv[2 * slot + 1];
    const float* subg = F.in[I_DASUB] + slot * 128;
    const int nunits = 2048 + (last ? 0 : 256);
    for (int u = F.vcu; u < nunits; u += F.G) {
        if (u < 2048) { const int bh = u >> 4, qt = u & 15, b = bh >> 3, h = bh & 7;
            da_unit(F.lds, F.tid, QKV, O, b * LROW + CTX + qt * 128, b * LROW, 36, h, lam, 1.f - li, subg); }
        else { const int v = u - 2048, bh = v >> 1, qt = v & 1, b = bh >> 3, h = bh & 7;
            da_unit(F.lds, F.tid, QKV, O, b * LROW + qt * 128, b * LROW, 4, h, lam, 1.f - li, subg); }
    }
}

DI void na_unit(LAS unsigned char* lds, const int tid, const bf16_t* QKV, bf16_t* O, const float* rpb, int b, int h, int R, int ctxq) {
    const int lane = tid & 63, wid = __builtin_amdgcn_readfirstlane(tid >> 6), r = lane & 31, hh = lane >> 5;
    constexpr int KP = 144, STG = 2 * 64 * KP;
    LAS float* wsf = (LAS float*)(lds + 2 * STG) + wid * 64;
    LAS float* rpbL = (LAS float*)(lds + 2 * STG + 2048);
    const int rw = 4 * R + (wid >> 1), cq = 32 * (wid & 1) + r;
    const int rs_w = min(max(rw - 4, 0), 24);
    const int rlo = min(max(4 * R - 4, 0), 24), rhi = min(max(4 * R - 1, 0), 24) + 7;
    const int NT = ctxq ? 4 : 4 + (rhi - rlo + 1);
    const int q_row = ctxq ? b * LROW + 32 * wid + r : b * LROW + CTX + R * 256 + 32 * wid + r;
    if (!ctxq) for (int i = tid; i < 465; i += 512) rpbL[i] = rpb[h * 465 + i] * LOG2E;
    const int srow = tid >> 3, sch = tid & 7;
    const bf16_t* gb = QKV + (size_t)(b * LROW) * 3072 + 1024 + h * 64 + sch * 8;
    const int lbase = srow * KP + sch * 16;
    u32x4 st[2];
#define NA_ROW(t) ((t) < 4 ? 64 * (t) : CTX + (rlo + (t) - 4) * 64)
#define NA_LOAD(t) do { const bf16_t* _g = gb + (size_t)(NA_ROW(t) + srow) * 3072; st[0] = *(const u32x4*)_g; st[1] = *(const u32x4*)(_g + 1024); } while (0)
#define NA_STORE(buf) do { *(LAS u32x4*)(lds + (buf) * STG + lbase) = st[0]; *(LAS u32x4*)(lds + (buf) * STG + 64 * KP + (sch >> 2) * 4096 + srow * 64 + (sch & 3) * 16) = st[1]; } while (0)
    const bf16_t* qp = QKV + (size_t)q_row * 3072 + h * 64 + 8 * hh;
    bf16x8 qr[4];
#pragma unroll
    for (int d0 = 0; d0 < 4; ++d0) qr[d0] = *(const bf16x8*)(qp + 16 * d0);
    f32x16 o[2];
#pragma unroll
    for (int d = 0; d < 2; ++d)
#pragma unroll
        for (int i = 0; i < 16; ++i) o[d][i] = 0.f;
    float m_run = 0.f, l_run = 0.f;
    f32x16 negm;
#pragma unroll
    for (int i = 0; i < 16; ++i) negm[i] = 0.f;
    const int cs = min(max(cq - 8, 0), 48);
    NA_LOAD(0); NA_STORE(0); __syncthreads();
    for (int t = 0; t < NT; ++t) {
        const int cur = t & 1;
        if (t + 1 < NT) NA_LOAD(t + 1);
        const int ri = rlo + t - 4;
        const bool active = (t < 4) || (ri >= rs_w && ri <= rs_w + 7);
        if (active) {
            LAS const unsigned char* Kb = lds + cur * STG + r * KP + hh * 16;
            LAS const unsigned char* Vb = lds + cur * STG + 64 * KP;
            f32x16 p0 = negm, p1 = negm;
#pragma unroll
            for (int d0 = 0; d0 < 4; ++d0) { const bf16x8 k0 = *(const LAS bf16x8*)(Kb + d0 * 32), k1 = *(const LAS bf16x8*)(Kb + 32 * KP + d0 * 32);
                p0 = mfma32(k0, qr[d0], p0); p1 = mfma32(k1, qr[d0], p1); }
            if (t >= 4) {
                LAS const float* bt = rpbL + (ri - rw + 7) * 31 + 15 - cq;
#pragma unroll
                for (int i = 0; i < 16; ++i) { const int ck = (i & 3) + 8 * (i >> 2) + 4 * hh;
                    { const bool in = (ck >= cs) && (ck < cs + 16); const float bv = bt[in ? ck : cq]; p0[i] = in ? p0[i] + bv : -1e30f; }
                    { const int ck2 = ck + 32; const bool in = (ck2 >= cs) && (ck2 < cs + 16); const float bv = bt[in ? ck2 : cq]; p1[i] = in ? p1[i] + bv : -1e30f; } }
            }
            softmax_pv<2>(p0, p1, o, negm, m_run, l_run, t == 0, wsf, Vb, KP, r, hh, lane);
        }
        if (t + 1 < NT) NA_STORE(cur ^ 1);
        LDS_BARRIER();
    }
#undef NA_ROW
#undef NA_LOAD
#undef NA_STORE
    const float lt = l_run + __shfl_xor(l_run, 32);
    if (hh == 0) wsf[r] = 1.f / lt;
    const int orow0 = (ctxq ? b * LROW : b * LROW + CTX + R * 256) + 32 * wid;
#pragma unroll
    for (int g4 = 0; g4 < 4; ++g4) { const f32x4 a4 = *(const LAS f32x4*)(wsf + 8 * g4 + 4 * hh);
#pragma unroll
        for (int e = 0; e < 4; ++e) { const int i = 4 * g4 + e; const int q = 8 * g4 + 4 * hh + e;
            bf16_t* op = O + (size_t)(orow0 + q) * DM + h * 64 + r;
            op[0] = (bf16_t)(pk2(o[0][i] * a4[e], 0.f) & 0xffffu); op[32] = (bf16_t)(pk2(o[1][i] * a4[e], 0.f) & 0xffffu); } }
    __syncthreads();
}

DI void na_phase(Frame& F, unsigned char* ws) {
    const bf16_t* QKV = (const bf16_t*)(ws + WS_ACT); bf16_t* O = (bf16_t*)(ws + WS_U);
    for (int u = F.vcu; u < 2048 + 256; u += F.G) {
        if (u < 2048) { const int bh = u >> 3, R = u & 7; na_unit(F.lds, F.tid, QKV, O, F.in[I_NARPB], bh >> 4, bh & 15, R, 0); }
        else { const int bh = u - 2048; na_unit(F.lds, F.tid, QKV, O, F.in[I_NARPB], bh >> 4, bh & 15, 0, 1); }
    }
}

template <int CTRL> DI float dppf(float x) { return __int_as_float(__builtin_amdgcn_update_dpp(0, __float_as_int(x), CTRL, 0xf, 0xf, false)); }
DI float allred8(float x) {
    float a, b, c;
    asm volatile("s_nop 1\n\tv_add_f32_dpp %0, %1, %1 row_half_mirror row_mask:0xf bank_mask:0xf bound_ctrl:1" : "=v"(a) : "v"(x));
    asm volatile("s_nop 1\n\tv_add_f32_dpp %0, %1, %1 quad_perm:[1,0,3,2] row_mask:0xf bank_mask:0xf bound_ctrl:1" : "=v"(b) : "v"(a));
    asm volatile("s_nop 1\n\tv_add_f32_dpp %0, %1, %1 quad_perm:[2,3,0,1] row_mask:0xf bank_mask:0xf bound_ctrl:1" : "=v"(c) : "v"(b));
    return c;
}
DI float allred8_ref(float x) { x += dppf<0x141>(x); x += dppf<0xB1>(x); x += dppf<0x4E>(x); return x; }
DI float allred16(float x) { x += dppf<0x128>(x); x += dppf<0x124>(x); x += dppf<0x122>(x); x += dppf<0x121>(x); return x; }
DI void rwkv_scan(Frame& F, unsigned char* ws) {
    const bf16_t* X = (const bf16_t*)(ws + WS_ACT);
    bf16_t* Y0 = (bf16_t*)(ws + WS_U) + (size_t)MROWS * DM;
    bf16_t* Y1 = (bf16_t*)(ws + WS_Y);
    float* CD = (float*)(ws + WS_CD);
    const int tid = F.tid, lane = F.lane, g = tid >> 8, gt = tid & 255, gwv = (tid >> 6) & 3;
    LAS float* buf = (LAS float*)(F.lds) + g * 5120;
    LAS float* ybuf = (LAS float*)(F.lds + 40960) + g * 1024;
    LAS float* red = (LAS float*)(F.lds + 49152) + g * 128;
    for (int s0 = F.vcu * 2; s0 < 512; s0 += F.G * 2) {
        const int s = s0 + g, dir = s >> 8, b = (s >> 4) & 15, h = s & 15;
        const int ch = 16 * gwv + (lane & 15), chn = h * 64 + ch, rq = lane >> 4;
        bf16x8 bw[2], ba[2];
#pragma unroll
        for (int ks = 0; ks < 2; ++ks) { u32x4 pw, pa;
#pragma unroll
            for (int e = 0; e < 4; ++e) { const int k = 32 * ks + 8 * rq + 2 * e;
                pw[e] = pk2(F.in[I_RWW2][(size_t)(dir * 64 + k) * 1024 + chn], F.in[I_RWW2][(size_t)(dir * 64 + k + 1) * 1024 + chn]);
                pa[e] = pk2(F.in[I_RWA2][(size_t)(dir * 64 + k) * 1024 + chn], F.in[I_RWA2][(size_t)(dir * 64 + k + 1) * 1024 + chn]); }
            bw[ks] = __builtin_bit_cast(bf16x8, pw); ba[ks] = __builtin_bit_cast(bf16x8, pa); }
        const float w0c = F.in[I_RWW0][dir * 1024 + chn], a0c = F.in[I_RWA0][dir * 1024 + chn], kkc = F.in[I_RWKK][chn], kac = F.in[I_RWKA][chn], rkc = F.in[I_RWRK][chn];
        const bf16_t* Xb = X + (size_t)(b * LROW) * 3584;
        bf16_t* Yd = (dir ? Y1 : Y0) + (size_t)(b * LROW) * DM + h * 64;
        float* CDd = CD + ((size_t)dir * MROWS + (size_t)b * LROW) * 16 + h;
        f32x2 S2[8];
#pragma unroll
        for (int i = 0; i < 8; ++i) S2[i] = (f32x2){0.f, 0.f};
        bf16x8 Bs[2];
        Bs[0] = (bf16x8){0, 0, 0, 0, 0, 0, 0, 0}; Bs[1] = Bs[0];
        const int vl = lane & 15, kq = lane >> 4;
        bf16x8 ahw[2], aha[2]; bf16_t rr_[4], kr_[4], vr_[4];
#define SC_RLO(c) (dir ? (((c) < 16 ? 255 - 16 * (c) : 2559 - 16 * (c)) - 15) : 16 * (c))
#define SC_LOAD(c) do { const int _rlo = SC_RLO(c); const bf16_t* _p = Xb + (size_t)(_rlo + (lane & 15)) * 3584 + 3072 + dir * 64 + 8 * rq; \
        ahw[0] = *(const bf16x8*)_p; ahw[1] = *(const bf16x8*)(_p + 32); aha[0] = *(const bf16x8*)(_p + 128); aha[1] = *(const bf16x8*)(_p + 160); \
        _Pragma("unroll") for (int j = 0; j < 4; ++j) { const bf16_t* _q = Xb + (size_t)(_rlo + 4 * rq + j) * 3584 + chn; rr_[j] = _q[0]; kr_[j] = _q[1024]; vr_[j] = _q[2048]; } } while (0)
        SC_LOAD(0);
        for (int c = 0; c < 144; ++c) {
            const int rlo = SC_RLO(c);
            LAS float* cb = buf;
            f32x4 accw = {0.f, 0.f, 0.f, 0.f}, acca = {0.f, 0.f, 0.f, 0.f};
#pragma unroll
            for (int ks = 0; ks < 2; ++ks) { accw = __builtin_amdgcn_mfma_f32_16x16x32_bf16(ahw[ks], bw[ks], accw, 0, 0, 0); acca = __builtin_amdgcn_mfma_f32_16x16x32_bf16(aha[ks], ba[ks], acca, 0, 0, 0); }
            float dec[4], av[4], kkv[4], kd[4], rv[4], vv[4];
#pragma unroll
            for (int j = 0; j < 4; ++j) {
                const float z = w0c + accw[j]; dec[j] = fast_exp(-0.6065306597126334f * sigmoidf_(z));
                av[j] = sigmoidf_(a0c + acca[j]);
                const float kx = bf2f(kr_[j]); rv[j] = bf2f(rr_[j]); vv[j] = bf2f(vr_[j]);
                kkv[j] = kx * kkc; kd[j] = kx * (1.f + (av[j] - 1.f) * kac);
                const float nsq = allred16(kkv[j] * kkv[j]), cp = allred16(rv[j] * kd[j] * rkc);
                if ((lane & 15) == 0) { red[(4 * rq + j) * 4 + gwv] = nsq; red[64 + (4 * rq + j) * 4 + gwv] = cp; }
            }
            LDS_BARRIER();
            const bf16_t rr_s[4] = {rr_[0], rr_[1], rr_[2], rr_[3]};
#pragma unroll
            for (int j = 0; j < 4; ++j) {
                const int rr = 4 * rq + j, js = dir ? 15 - rr : rr;
                const f32x4 n4 = *(const LAS f32x4*)(red + rr * 4);
                const float inv = __builtin_amdgcn_rsqf(fmaxf((n4.x + n4.y) + (n4.z + n4.w), 1e-24f));
                const float kkn = kkv[j] * inv;
                LAS float* d = cb + js * 320 + ch;
                d[0] = dec[j]; d[64] = kkn * av[j]; d[128] = kd[j]; d[192] = vv[j];
                LAS bf16_t* db = (LAS bf16_t*)(cb + js * 320 + 256) + ch;
                db[0] = (bf16_t)(pk2(-kkn, 0.f) & 0xffffu); db[64] = rr_s[j];
            }
            if (gt < 16) { const f32x4 c4 = *(const LAS f32x4*)(red + 64 + gt * 4); CDd[(size_t)(rlo + gt) * 16] = (c4.x + c4.y) + (c4.z + c4.w); }
            if (c + 1 < 144) SC_LOAD(c + 1);
            LDS_BARRIER();
            bf16x8 oa[2][2], orr[2][2]; f32x4 ow[2][4]; float ovt[2];
#define SC_OPS(P, js_) do { LAS const float* sb_ = cb + (js_) * 320; LAS const bf16_t* ab_ = (LAS const bf16_t*)(sb_ + 256) + 8 * kq; \
                oa[P][0] = *(const LAS bf16x8*)(ab_); oa[P][1] = *(const LAS bf16x8*)(ab_ + 32); orr[P][0] = *(const LAS bf16x8*)(ab_ + 64); orr[P][1] = *(const LAS bf16x8*)(ab_ + 96); \
                _Pragma("unroll") for (int s_ = 0; s_ < 2; ++s_) { LAS const float* ob2_ = sb_ + 32 * s_ + 8 * kq; ow[P][2 * s_] = *(const LAS f32x4*)(ob2_); ow[P][2 * s_ + 1] = *(const LAS f32x4*)(ob2_ + 4); } \
                ovt[P] = sb_[192 + 16 * gwv + vl]; } while (0)
            SC_OPS(0, 0);
#pragma unroll
            for (int js = 0; js < 16; ++js) {
                const int P = js & 1;
                f32x4 obv[4], odv[4];
                { LAS const float* sb_ = cb + js * 320 + 8 * kq;
#pragma unroll
                  for (int s_ = 0; s_ < 2; ++s_) { obv[2 * s_] = *(const LAS f32x4*)(sb_ + 32 * s_ + 64); obv[2 * s_ + 1] = *(const LAS f32x4*)(sb_ + 32 * s_ + 68); odv[2 * s_] = *(const LAS f32x4*)(sb_ + 32 * s_ + 128); odv[2 * s_ + 1] = *(const LAS f32x4*)(sb_ + 32 * s_ + 132); } }
                __builtin_amdgcn_sched_barrier(0);
                if (js + 1 < 16) SC_OPS(P ^ 1, js + 1);
                __builtin_amdgcn_sched_barrier(0);
                f32x4 acs = {0.f, 0.f, 0.f, 0.f};
                acs = __builtin_amdgcn_mfma_f32_16x16x32_bf16(oa[P][0], Bs[0], acs, 0, 0, 0); acs = __builtin_amdgcn_mfma_f32_16x16x32_bf16(oa[P][1], Bs[1], acs, 0, 0, 0);
                const float vt = ovt[P];
                const float sa = acs[0];
#pragma unroll
                for (int s_ = 0; s_ < 2; ++s_) {
                    const f32x4 w0 = ow[P][2 * s_], w1 = ow[P][2 * s_ + 1], b0 = obv[2 * s_], b1 = obv[2 * s_ + 1], d0 = odv[2 * s_], d1 = odv[2 * s_ + 1];
                    S2[4 * s_ + 0] = S2[4 * s_ + 0] * (f32x2){w0.x, w0.y} + ((f32x2){b0.x, b0.y} * sa + (f32x2){d0.x, d0.y} * vt);
                    S2[4 * s_ + 1] = S2[4 * s_ + 1] * (f32x2){w0.z, w0.w} + ((f32x2){b0.z, b0.w} * sa + (f32x2){d0.z, d0.w} * vt);
                    S2[4 * s_ + 2] = S2[4 * s_ + 2] * (f32x2){w1.x, w1.y} + ((f32x2){b1.x, b1.y} * sa + (f32x2){d1.x, d1.y} * vt);
                    S2[4 * s_ + 3] = S2[4 * s_ + 3] * (f32x2){w1.z, w1.w} + ((f32x2){b1.z, b1.w} * sa + (f32x2){d1.z, d1.w} * vt);
                    u32x4 pk; pk.x = pk2(S2[4 * s_ + 0].x, S2[4 * s_ + 0].y); pk.y = pk2(S2[4 * s_ + 1].x, S2[4 * s_ + 1].y); pk.z = pk2(S2[4 * s_ + 2].x, S2[4 * s_ + 2].y); pk.w = pk2(S2[4 * s_ + 3].x, S2[4 * s_ + 3].y);
                    Bs[s_] = __builtin_bit_cast(bf16x8, pk);
                }
                f32x4 acy = {0.f, 0.f, 0.f, 0.f};
                acy = __builtin_amdgcn_mfma_f32_16x16x32_bf16(orr[P][0], Bs[0], acy, 0, 0, 0); acy = __builtin_amdgcn_mfma_f32_16x16x32_bf16(orr[P][1], Bs[1], acy, 0, 0, 0);
                if (kq == 0) ybuf[js * 64 + 16 * gwv + vl] = acy[0];
                __builtin_amdgcn_sched_barrier(0);
            }
#undef SC_OPS
            LDS_BARRIER();
            { const int rr = gt >> 4, c4 = (gt & 15) * 4, js = dir ? 15 - rr : rr;
              const f32x4 yv = *(const LAS f32x4*)(ybuf + js * 64 + c4);
              *(u32x2*)(Yd + (size_t)(rlo + rr) * DM + c4) = (u32x2){pk2(yv.x, yv.y), pk2(yv.z, yv.w)}; }
        }
#undef SC_RLO
#undef SC_LOAD
        __syncthreads();
    }
}

DI void rwkv_readout(Frame& F, unsigned char* ws) {
    const bf16_t* X = (const bf16_t*)(ws + WS_ACT);
    bf16_t* G = (bf16_t*)(ws + WS_U);
    const bf16_t* Y0 = G + (size_t)MROWS * DM; const bf16_t* Y1 = (const bf16_t*)(ws + WS_Y);
    const float* CD = (const float*)(ws + WS_CD);
    const int c0 = 16 * F.lane, hd = F.lane >> 2;
    for (int row = F.gw; row < MROWS; row += F.NGW) {
        float y[16], vv[16], gg[16];
#pragma unroll
        for (int j = 0; j < 2; ++j) {
            const u32x4 a = *(const u32x4*)(Y0 + (size_t)row * DM + c0 + 8 * j), bq = *(const u32x4*)(Y1 + (size_t)row * DM + c0 + 8 * j);
            const u32x4 v4 = *(const u32x4*)(X + (size_t)row * 3584 + 2048 + c0 + 8 * j), g4 = *(const u32x4*)(G + (size_t)row * DM + c0 + 8 * j);
#pragma unroll
            for (int e = 0; e < 4; ++e) { y[8 * j + 2 * e] = bflo(a[e]) + bflo(bq[e]); y[8 * j + 2 * e + 1] = bfhi(a[e]) + bfhi(bq[e]);
                vv[8 * j + 2 * e] = bflo(v4[e]); vv[8 * j + 2 * e + 1] = bfhi(v4[e]); gg[8 * j + 2 * e] = bflo(g4[e]); gg[8 * j + 2 * e + 1] = bfhi(g4[e]); }
        }
        float s = 0.f;
#pragma unroll
        for (int i = 0; i < 16; ++i) s += y[i];
        s += __shfl_xor(s, 1); s += __shfl_xor(s, 2);
        const float mean = s * (1.f / 64.f); float q = 0.f;
#pragma unroll
        for (int i = 0; i < 16; ++i) { y[i] -= mean; q += y[i] * y[i]; }
        q += __shfl_xor(q, 1); q += __shfl_xor(q, 2);
        const float rstd = 1.f / sqrtf(q * (1.f / 64.f) + 64e-5f);
        const float cc = CD[(size_t)row * 16 + hd] + CD[((size_t)MROWS + row) * 16 + hd];
        u32x4 o[2];
#pragma unroll
        for (int j = 0; j < 2; ++j)
#pragma unroll
            for (int e = 0; e < 4; ++e) { const int i = 8 * j + 2 * e;
                const float z0 = ((y[i] * rstd) * F.in[I_RWLNG][c0 + i] + F.in[I_RWLNB][c0 + i] + cc * vv[i]) * gg[i];
                const float z1 = ((y[i + 1] * rstd) * F.in[I_RWLNG][c0 + i + 1] + F.in[I_RWLNB][c0 + i + 1] + cc * vv[i + 1]) * gg[i + 1];
                o[j][e] = pk2(z0, z1); }
        *(u32x4*)(G + (size_t)row * DM + c0) = o[0]; *(u32x4*)(G + (size_t)row * DM + c0 + 8) = o[1];
    }
}


#define XB_TMO      128
#define XB_XCNT(j)  (256  + 64 * (j))
#define XB_XSUB(j)  (1280 + 64 * (j))
#define XB_XGEN(j)  (2304 + 64 * (j))
#define XB_TOP      3328
#define XB_TOPGEN   3392
#define XCD_BAR_WORDS 3456
#define XB_SPIN_CAP (1u << 18)
DI unsigned xb_ld(unsigned* p)              { return __hip_atomic_load(p, __ATOMIC_RELAXED, __HIP_MEMORY_SCOPE_AGENT); }
DI unsigned xb_add(unsigned* p, unsigned v) { return __hip_atomic_fetch_add(p, v, __ATOMIC_RELAXED, __HIP_MEMORY_SCOPE_AGENT); }
DI unsigned xb_xcc_id() { return (unsigned)__builtin_amdgcn_s_getreg((3 << 11) | 20) & 0xFu; }
#define XB_SPIN(cond, bar) do { unsigned _sp = 0; while (cond) { __builtin_amdgcn_s_sleep(1); \
    if ((++_sp & 255u) == 0u) { if (xb_ld(&(bar)[XB_TMO])) break; if (_sp > XB_SPIN_CAP) { atomicAdd(&(bar)[XB_TMO], 1u); break; } } } } while (0)
struct XcdBarrier { unsigned* bar; unsigned x; volatile LAS unsigned* st; };
DI XcdBarrier xcd_barrier_post(unsigned* bar, volatile LAS unsigned* st) {
    XcdBarrier b; b.bar = bar; b.x = xb_xcc_id(); b.st = st;
    if (threadIdx.x == 0) (void)xb_add(&bar[XB_XCNT(b.x)], 1u);
    return b;
}
DI void xcd_barrier_complete(unsigned* bar, unsigned x, unsigned& nloc, unsigned& nx) {
    const unsigned G = gridDim.x * gridDim.y * gridDim.z;
    unsigned sum, cnt, mine, sp = 0u;
    for (;;) {
        sum = 0u; cnt = 0u; mine = 0u;
#pragma unroll
        for (unsigned j = 0; j < 16; ++j) { const unsigned c = xb_ld(&bar[XB_XCNT(j)]); sum += c; cnt += (c > 0u) ? 1u : 0u; mine = (j == x) ? c : mine; }
        if (sum == G) break;
        __builtin_amdgcn_s_sleep(1);
        if ((++sp & 255u) == 0u) { if (xb_ld(&bar[XB_TMO])) break; if (sp > XB_SPIN_CAP) { atomicAdd(&bar[XB_TMO], 1u); break; } }
    }
    nloc = mine > 0u ? mine : 1u; nx = cnt > 0u ? cnt : 1u;
}
DI void xcd_barrier(const XcdBarrier& b) {
    asm volatile("s_waitcnt vmcnt(0)" ::: "memory");
    __syncthreads();
    if (threadIdx.x == 0) {
        unsigned* bar = b.bar;
        __builtin_amdgcn_s_waitcnt(0);
        unsigned nloc = b.st[0], nx = b.st[1];
        if (nloc == 0u) { xcd_barrier_complete(bar, b.x, nloc, nx); b.st[0] = nloc; b.st[1] = nx; }
        const unsigned old = xb_add(&bar[XB_XSUB(b.x)], 1u);
        const unsigned gen = old / nloc;
        if (old + 1u == (gen + 1u) * nloc) {
            __builtin_amdgcn_fence(__ATOMIC_RELEASE, "agent");
            asm volatile("s_waitcnt vmcnt(0)" ::: "memory");
            const unsigned og = xb_add(&bar[XB_TOP], 1u);
            const unsigned tg = og / nx;
            if (og + 1u == (tg + 1u) * nx) xb_add(&bar[XB_TOPGEN], 1u);
            else XB_SPIN(xb_ld(&bar[XB_TOPGEN]) == tg, bar);
            __builtin_amdgcn_fence(__ATOMIC_ACQUIRE, "agent");
            xb_add(&bar[XB_XGEN(b.x)], 1u);
            asm volatile("s_waitcnt vmcnt(0)" ::: "memory");
        } else {
            XB_SPIN(xb_ld(&bar[XB_XGEN(b.x)]) == gen, bar);
            __builtin_amdgcn_fence(__ATOMIC_ACQUIRE, "agent");
            asm volatile("s_waitcnt vmcnt(0)" ::: "memory");
        }
    }
    __syncthreads();
}

enum { OP_RP0 = 0, OP_G1, OP_G2, OP_RP1, OP_XX, OP_RKVH, OP_GG, OP_SCAN, OP_RDOUT, OP_QKV, OP_ATT, OP_OPROJ, OP_RP2, OP_G5, OP_G6, OP_RP3, OP_END };
DI int next_op(int kind, int op) {
    switch (op) {
        case OP_RP0: return OP_G1; case OP_G1: return OP_G2; case OP_G2: return OP_RP1;
        case OP_RP1: return kind == 2 ? OP_XX : OP_QKV;
        case OP_XX: return OP_RKVH; case OP_RKVH: return OP_GG; case OP_GG: return OP_SCAN; case OP_SCAN: return OP_RDOUT; case OP_RDOUT: return OP_OPROJ;
        case OP_QKV: return OP_ATT; case OP_ATT: return OP_OPROJ; case OP_OPROJ: return OP_RP2;
        case OP_RP2: return OP_G5; case OP_G5: return OP_G6; case OP_G6: return OP_RP3; default: return OP_END;
    }
}

__global__ void __launch_bounds__(512, 2) mega(const float* i0, const float* i1, const float* i2, const float* i3, const float* i4, const float* i5, const float* i6, const float* i7, const float* i8, const float* i9, const float* i10, const float* i11, const float* i12, const float* i13, const float* i14, const float* i15, const float* i16, const float* i17, const float* i18, const float* i19, const float* i20, const float* i21, const float* i22, const float* i23, const float* i24, const float* i25, const float* i26, const float* i27, const float* i28, const float* i29, const float* i30, const float* i31, float* out, unsigned char* ws0) {
    const float* in_[32] = {i0, i1, i2, i3, i4, i5, i6, i7, i8, i9, i10, i11, i12, i13, i14, i15, i16, i17, i18, i19, i20, i21, i22, i23, i24, i25, i26, i27, i28, i29, i30, i31};
    extern __shared__ __attribute__((aligned(16))) unsigned char lds_raw[];
    cg::grid_group grid = cg::this_grid();
    Frame F;
#define BUILD_FRAME() do { int tid_ = threadIdx.x; asm volatile("" : "+v"(tid_)); int bx_ = blockIdx.x; asm volatile("" : "+s"(bx_)); \
    F.lds = (LAS unsigned char*)lds_raw; F.tid = tid_; F.lane = tid_ & 63; F.wave = __builtin_amdgcn_readfirstlane(tid_ >> 6); \
    F.G = gridDim.x; F.bx = bx_; F.vcu = (F.G % 8 == 0) ? (bx_ % 8) * (F.G / 8) + bx_ / 8 : bx_; \
    F.gw = F.vcu * 8 + F.wave; F.NGW = F.G * 8; F.in = in_; } while (0)
    BUILD_FRAME();
    unsigned char* ws = ws0;

#ifndef NO_P0
    phase0(F, ws);
#endif
    grid.sync();
    volatile LAS unsigned* bst = (volatile LAS unsigned*)(F.lds + LDS_BYTES - 64);
    if (F.tid < 2) bst[F.tid] = 0u;
    __syncthreads();
    const XcdBarrier xbar = xcd_barrier_post((unsigned*)(ws0 + WS_BAR), bst);

    for (int l = 0; l < 4; ++l) {
        const int kind = l % 3; const bool last = (l == 3);
        const float* ng = F.in[I_NORMG] + l * 6 * DM;
        int op = (l == 0) ? OP_RP0 : OP_G1;
        int sub = 0, rp_lo = 0;
        while (op != OP_END) {
            { size_t zoff = 0; asm volatile("" : "+s"(zoff)); ws = ws0 + zoff; }
            BUILD_FRAME();
            float* HC = (float*)(ws + WS_HC); bf16_t* WB = (bf16_t*)(ws + WS_WB); bf16_t* U = (bf16_t*)(ws + WS_U); bf16_t* ACT = (bf16_t*)(ws + WS_ACT); bf16_t* YB = (bf16_t*)(ws + WS_Y);
            const float* cosT = (const float*)(ws + WS_ROPE); const float* sinT = cosT + 1024;
            int rpop = -1, rlo = 0, rhi = MROWS, rwidx = F.gw, rnw = F.NGW; bool fill = false;
            if (op == OP_G1 || op == OP_G2 || op == OP_G5 || op == OP_G6 || op == OP_QKV || op == OP_RKVH || op == OP_GG || op == OP_OPROJ) {
                pg8::Gemm g; pg8::Epi E; E.cosT = cosT; E.sinT = sinT; int skip = 0;
                if (op == OP_G1 || op == OP_G5) { g.A = U; g.lda = 1024; g.Bt = WB + (op == OP_G1 ? WB_IN0 : WB_IN1); g.ldb = 1024; g.N = 5632; g.K = 1024; E.mode = pg8::EPI_SWIGLU; E.O = ACT; E.ldc = FF; skip = (last && op == OP_G5); }
                else if (op == OP_G2 || op == OP_G6) { g.A = ACT; g.lda = FF; g.Bt = WB + (op == OP_G2 ? WB_OUT0 : WB_OUT1); g.ldb = FF; g.N = 1024; g.K = FF; E.mode = pg8::EPI_PLAIN; E.O = YB; E.ldc = 1024; skip = (last && op == OP_G6); }
                else if (op == OP_QKV) { g.A = U; g.lda = 1024; g.Bt = WB + WB_MIXIN; g.ldb = 1024; g.N = 3072; g.K = 1024; E.mode = kind == 0 ? pg8::EPI_QKV_DA : pg8::EPI_QKV_NA; E.O = ACT; E.ldc = 3072; }
                else if (op == OP_RKVH) { g.A = U; g.lda = 2048; g.Bt = WB + WB_MIXIN; g.ldb = 2048; g.N = 3584; g.K = 2048; E.mode = pg8::EPI_RWKV; E.O = ACT; E.ldc = 3584; }
                else if (op == OP_GG) { g.A = ACT + 3328; g.lda = 3584; g.Bt = WB + WB_G2T; g.ldb = 256; g.N = 1024; g.K = 256; E.mode = pg8::EPI_PLAIN; E.O = U; E.ldc = 1024; }
                else { g.A = U; g.lda = 1024; g.Bt = WB + WB_MIXOUT; g.ldb = 1024; g.N = 1024; g.K = 1024; E.mode = pg8::EPI_PLAIN; E.O = YB; E.ldc = 1024; skip = last; }
                g.nM = skip ? 128 : 144; g.skip = skip;
                pg8::StaticOrder S; S.init(g.nM, g.N, F.G, F.bx, skip);
                fill = (op == OP_G2 || op == OP_G6 || op == OP_OPROJ) && !skip && F.G == 256;
                if (fill) { S.pmode = 1; S.r0 = sub ? 2 : 0; S.nr = sub ? 1 : 2;
                    if (sub == 1 && F.bx >= 64) { rpop = (op == OP_G2) ? OP_RP1 : (op == OP_G6 ? OP_RP3 : OP_RP2); rlo = 0; rhi = 128 * 256; rwidx = (F.bx - 64) * 8 + F.wave; rnw = 192 * 8; } }
#ifndef NO_GEMM
                pg8::gemm_phase(F.lds, F.tid, g, S, E);
#endif
            } else if (op == OP_RP0 || op == OP_RP1 || op == OP_RP2 || op == OP_RP3) { rpop = op; rlo = rp_lo; }
            if (rpop >= 0) {
                RowPass P;
                P.hsrc_lat = out; P.hsrc_ctx = HC; P.hdst_lat = out; P.hdst_ctx = HC; P.U = U; P.ldu = 1024; P.skip_ctx = 0; P.lpost = l; P.lpre = l;
                if (rpop == OP_RP0) { P.hsrc_lat = F.in[I_X]; P.hsrc_ctx = F.in[I_CTX]; P.hdst_lat = (float*)F.in[I_X]; P.hdst_ctx = (float*)F.in[I_CTX];   P.Y = nullptr; P.gpost = ng; P.gate_idx = 0; P.coef = 0.f; P.gpre = ng; P.shift_idx = 0; }
                else if (rpop == OP_RP1) { if (l == 0) { P.hsrc_lat = F.in[I_X]; P.hsrc_ctx = F.in[I_CTX]; } P.Y = YB; P.gpost = ng + DM; P.gate_idx = 2; P.coef = 0.5f; P.gpre = ng + 2 * DM; P.shift_idx = 3; P.ldu = (kind == 2) ? 2048 : 1024; }
                else if (rpop == OP_RP2) { P.Y = YB; P.gpost = ng + 3 * DM; P.gate_idx = 5; P.coef = 1.f; P.gpre = ng + 4 * DM; P.shift_idx = 6; P.skip_ctx = last; }
                else { P.Y = YB; P.gpost = ng + 5 * DM; P.gate_idx = 8; P.coef = 0.5f; P.gpre = last ? nullptr : ng + 6 * DM; P.shift_idx = 0; P.lpre = l + 1; P.skip_ctx = last; }
#ifndef NO_RP
                row_pass(F, ws, P, rlo, rhi, rwidx, rnw);
#endif
#ifndef NO_CONV
                if (op == OP_RP3 && !last) { __syncthreads(); convert_layer(F, ws, l + 1); }
#endif
            }
#ifndef NO_XX
            if (op == OP_XX) { xx_pass(F, ws); }
#endif

#ifndef NO_SCAN
            if (op == OP_SCAN) { rwkv_scan(F, ws); }
#endif

#ifndef NO_RDOUT
            if (op == OP_RDOUT) { rwkv_readout(F, ws); }
#endif

#ifndef NO_ATT
            if (op == OP_ATT) {
#ifndef NO_DA
 if (kind == 0) da_phase(F, ws, l);
#endif
#ifndef NO_NA
 if (kind == 1) na_phase(F, ws);
#endif
 }
#endif
            xcd_barrier(xbar);
            if (fill) { if (sub == 0) { sub = 1; continue; } sub = 0; rp_lo = 128 * 256; }
            else if (rpop >= 0) rp_lo = 0;
            op = next_op(kind, op);
        }
    }
}

extern "C" void kernel_launch(void* const* d_in, const int* in_sizes, int n_in, void* d_out, int out_size,
                              void* d_ws, size_t ws_size, hipStream_t stream) {
    static int grid = 0;
    if (grid == 0) {
        if (n_in != 32 || ws_size < WS_END) { fprintf(stderr, "kernel_launch: need 32 inputs and %zu B of workspace; got %d, %zu\n", (size_t)WS_END, n_in, ws_size); grid = -1; return; }
        int dev = 0, cus = 0, per_cu = 0;
        (void)hipGetDevice(&dev);
        (void)hipDeviceGetAttribute(&cus, hipDeviceAttributeMultiprocessorCount, dev);
        (void)hipFuncSetAttribute((const void*)mega, hipFuncAttributeMaxDynamicSharedMemorySize, LDS_BYTES);
        (void)hipOccupancyMaxActiveBlocksPerMultiprocessor(&per_cu, (const void*)mega, 512, LDS_BYTES);
        if (per_cu < 1) per_cu = 1;
        grid = cus * per_cu;
    }
    if (grid < 0) return;
    const float* inp[32]; for (int i = 0; i < 32; ++i) inp[i] = (const float*)d_in[i];
    float* outp = (float*)d_out; unsigned char* wsp = (unsigned char*)d_ws;
    void* kargs[34]; for (int i = 0; i < 32; ++i) kargs[i] = (void*)&inp[i];
    kargs[32] = (void*)&outp; kargs[33] = (void*)&wsp;
    hipError_t e = hipLaunchCooperativeKernel((const void*)mega, dim3(grid), dim3(512), kargs, LDS_BYTES, stream);
    if (e != hipSuccess) fprintf(stderr, "cooperative launch failed: %s (grid %d)\n", hipGetErrorString(e), grid);
}
```

```cpp
#include <hip/hip_runtime.h>
#include <hip/hip_cooperative_groups.h>
#include <cstdio>
#include <cstdint>
namespace cg = cooperative_groups;
#ifndef REP_MASK
#define REP_MASK 0
#endif

#define LAS __attribute__((address_space(3)))
#define DI __device__ __forceinline__
typedef unsigned short bf16_t;
typedef short bf16x8 __attribute__((ext_vector_type(8)));
typedef short s16x4 __attribute__((ext_vector_type(4)));
typedef float f32x2 __attribute__((ext_vector_type(2)));
typedef float f32x4 __attribute__((ext_vector_type(4)));
typedef float f32x16 __attribute__((ext_vector_type(16)));
typedef unsigned u32x4 __attribute__((ext_vector_type(4)));
typedef unsigned u32x2 __attribute__((ext_vector_type(2)));
typedef __bf16 bf2_t __attribute__((ext_vector_type(2)));

constexpr int DM = 1024, NB = 16, SEQ = 2048, CTX = 256, LROW = 2304, MROWS = NB * LROW, FF = 2816, NMOD = 9216;
constexpr float NORM_EPS = 1e-6f;
constexpr float LOG2E = 1.4426950408889634f;
constexpr float QSCALE = 0.125f * LOG2E;

constexpr size_t MiB = 1u << 20;
constexpr size_t WS_MOD = 0, WS_ROPE = 3 * MiB, WS_LAM = 3 * MiB + 16384, WS_BAR = 3 * MiB + 32768, WS_CD = 4 * MiB, WS_HC = 9 * MiB, WS_WB = 25 * MiB,
                 WS_U = 75 * MiB, WS_ACT = 219 * MiB, WS_Y = 471 * MiB, WS_END = 543 * MiB;
constexpr size_t WB_IN0 = 0, WB_OUT0 = 5767168, WB_IN1 = 8650752, WB_OUT1 = 14417920, WB_MIXIN = 17301504, WB_MIXOUT = 24641536, WB_G2T = 25690112;
constexpr int LDS_BYTES = 147456;

DI unsigned pk2(float lo, float hi) { f32x2 v = {lo, hi}; bf2_t b = __builtin_convertvector(v, bf2_t); return __builtin_bit_cast(unsigned, b); }
DI float bf2f(bf16_t h) { return __uint_as_float(((unsigned)h) << 16); }
DI float bflo(unsigned w) { return __uint_as_float(w << 16); }
DI float bfhi(unsigned w) { return __uint_as_float(w & 0xffff0000u); }
DI float wave_sum(float v) {
#pragma unroll
    for (int o = 1; o < 64; o <<= 1) v += __shfl_xor(v, o);
    return v;
}
#define LDS_BARRIER() asm volatile("s_waitcnt lgkmcnt(0)\n\ts_barrier" ::: "memory")
DI float fast_exp(float x) { return __builtin_amdgcn_exp2f(x * LOG2E); }
DI float sigmoidf_(float x) { return __builtin_amdgcn_rcpf(1.f + fast_exp(-x)); }
DI float siluf_(float x) { return x * sigmoidf_(x); }
DI float tanhf_(float x) { return 1.f - 2.f * __builtin_amdgcn_rcpf(1.f + fast_exp(2.f * x)); }

namespace pg8 {
constexpr int BM = 256, BK = 64, HALF = 128, HTB = HALF * BK * 2, NXCD = 8, WGM = 4;
__host__ __device__ __forceinline__ int lds_byte(int r, int c) { const int st = (r >> 4) * 2 + (c >> 5), rr = r & 15, cc = c & 31, ob = rr * 64 + cc * 2; return st * 1024 + (ob ^ (((ob >> 9) & 1) << 5)); }
__host__ __device__ __forceinline__ void stage_rc(int b, int& R, int& C) { const int st = b / 1024, sb = b % 1024, swz = sb ^ (((sb >> 9) & 1) << 5); R = (st >> 1) * 16 + swz / 64; C = (st & 1) * 32 + (swz % 64) / 2; }
__host__ __device__ __forceinline__ int perm32(int rho) { const int n = rho >> 4, i = rho & 15; return 8 * (i >> 2) + 4 * n + (i & 3); }

struct Unit { int pm, pn; };
struct Gemm { const bf16_t* A; const bf16_t* Bt; int lda, ldb, N, K, nM, skip; };

struct StaticOrder {
    int nM, nN, nwg, G, c, skip;
    int pmode, r0, nr;
    DI void init(int nM_, int N, int G_, int c_, int skip_) { nM = nM_; nN = N / BM; nwg = nM * nN; G = G_; c = c_; skip = skip_; pmode = 0; r0 = 0; nr = 0; }
    DI bool next(int i, Unit& u) const {
        if (pmode) {
            if (i >= nr) return false;
            const int round = r0 + i, xcd = c & 7, j = c >> 3, full = nM >> 6; int panel;
            if (round < full) { panel = round * 64 + xcd * 8 + (j & 7); u.pn = j >> 3; }
            else { if (j >= 8) return false; panel = full * 64 + 2 * xcd + (j & 1); u.pn = j >> 1; if (panel >= nM) return false; }
            u.pm = skip ? (panel + panel / 8 + 1) : panel;
            return true;
        }
        const long L = (long)i * G + c; if (L >= nwg) return false;
        int wgid = (int)L; { const int q = nwg / NXCD, r = nwg % NXCD, xcd = wgid % NXCD, off = wgid / NXCD; wgid = (xcd < r ? xcd * (q + 1) : r * (q + 1) + (xcd - r) * q) + off; }
        const int nig = WGM * nN, gid = wgid / nig, fm = gid * WGM, gsz = (nM - fm) < WGM ? (nM - fm) : WGM;
        int pm = fm + ((wgid % nig) % gsz); u.pn = (wgid % nig) / gsz;
        u.pm = skip ? (pm + pm / 8 + 1) : pm;
        return true;
    }
};

enum { EPI_PLAIN = 0, EPI_SWIGLU = 1, EPI_QKV_DA = 2, EPI_QKV_NA = 3, EPI_RWKV = 4 };
struct Epi {
    static constexpr bool PERM = true;
    int mode; bf16_t* O; int ldc; const float* cosT; const float* sinT;
    DI void operator()(const f32x4 (&acc)[2][2][4][2], const Unit& u, int wr, int wc, int fr, int fq) const {
        const int row0 = u.pm * BM + wr * 64 + fr;
        if (mode == EPI_SWIGLU) {
            const int col0 = u.pn * 128 + wc * 32 + 8 * fq;
#pragma unroll
            for (int ai = 0; ai < 2; ++ai)
#pragma unroll
                for (int m = 0; m < 4; ++m) {
                    bf16_t* rowp = O + (size_t)(row0 + ai * HALF + m * 16) * ldc + col0;
                    const f32x4 a0 = acc[ai][0][m][0], a1 = acc[ai][0][m][1], b0 = acc[ai][1][m][0], b1 = acc[ai][1][m][1];
                    u32x4 w;
                    w.x = pk2(siluf_(a0[0]) * b0[0], siluf_(a0[1]) * b0[1]); w.y = pk2(siluf_(a0[2]) * b0[2], siluf_(a0[3]) * b0[3]);
                    w.z = pk2(siluf_(a1[0]) * b1[0], siluf_(a1[1]) * b1[1]); w.w = pk2(siluf_(a1[2]) * b1[2], siluf_(a1[3]) * b1[3]);
                    *(u32x4*)rowp = w;
                }
        } else {
            const int col0 = u.pn * BM + wc * 32 + 8 * fq;
            const int jt = u.pm % 9;
            float sc = 1.f; bool rope = false; int act0 = 0, act1 = 0;
            if (mode == EPI_QKV_DA) { if (u.pn < 4) sc = QSCALE; if (u.pn < 8 && jt != 0) rope = true; }
            else if (mode == EPI_QKV_NA) { if (u.pn < 4) sc = QSCALE; }
            else if (mode == EPI_RWKV) { if (u.pn == 12) act0 = 1; if (u.pn == 13) { act0 = 2; act1 = 2; } }
#pragma unroll
            for (int ai = 0; ai < 2; ++ai)
#pragma unroll
                for (int m = 0; m < 4; ++m) {
                    bf16_t* rowp = O + (size_t)(row0 + ai * HALF + m * 16) * ldc + col0;
                    f32x4 c0 = {1.f, 1.f, 1.f, 1.f}, c1 = c0, s0 = {0.f, 0.f, 0.f, 0.f}, s1 = s0;
                    if (rope) {
                        const int t = (jt - 1) * 256 + ai * HALF + wr * 64 + m * 16 + fr;
                        const int pos = (wc & 1) ? (t & 63) : (t >> 6);
                        const float* cp = cosT + pos * 16 + 8 * (fq & 1); const float* sp = sinT + pos * 16 + 8 * (fq & 1);
                        c0 = *(const f32x4*)cp; c1 = *(const f32x4*)(cp + 4); s0 = *(const f32x4*)sp; s1 = *(const f32x4*)(sp + 4);
                        if (!(fq & 2)) { s0 = -s0; s1 = -s1; }
                    }
#pragma unroll
                    for (int bj = 0; bj < 2; ++bj) {
                        f32x4 v0 = acc[ai][bj][m][0], v1 = acc[ai][bj][m][1];
                        if (rope) {
                            f32x4 p0, p1;
#pragma unroll
                            for (int e = 0; e < 4; ++e) { p0[e] = __shfl_xor(v0[e], 32); p1[e] = __shfl_xor(v1[e], 32); }
                            v0 = v0 * c0 + p0 * s0; v1 = v1 * c1 + p1 * s1;
                        }
                        v0 = v0 * sc; v1 = v1 * sc;
                        const int act = bj ? act1 : act0;
                        if (act == 1) {
#pragma unroll
                            for (int e = 0; e < 4; ++e) { v0[e] = tanhf_(v0[e]); v1[e] = tanhf_(v1[e]); }
                        } else if (act == 2) {
#pragma unroll
                            for (int e = 0; e < 4; ++e) { v0[e] = sigmoidf_(v0[e]); v1[e] = sigmoidf_(v1[e]); }
                        }
                        u32x4 w; w.x = pk2(v0[0], v0[1]); w.y = pk2(v0[2], v0[3]); w.z = pk2(v1[0], v1[1]); w.w = pk2(v1[2], v1[3]);
                        *(u32x4*)(rowp + bj * HALF) = w;
                    }
                }
        }
    }
};

DI void gemm_phase(LAS unsigned char* lds, const int tid, const Gemm g, const StaticOrder& S, const Epi& E) {
    const int wid = __builtin_amdgcn_readfirstlane(tid >> 6), lane = tid & 63, wr = wid >> 2, wc = wid & 3, fr = lane & 15, fq = lane >> 4;
    const int K = g.K, nt = K / BK;
    unsigned voffA[2], voffB[2];
#pragma unroll
    for (int i = 0; i < 2; ++i) { int R, C; stage_rc(tid * 16 + i * 8192, R, C); const int Rb = (R & ~31) + perm32(R & 31);
        voffA[i] = (unsigned)(R * g.lda + C) * 2u; voffB[i] = (unsigned)(Rb * g.ldb + C) * 2u; }
    const size_t kstep = (size_t)(BK * 2);
    const size_t hstepA = (size_t)HALF * g.lda * 2, hstepB = (size_t)HALF * g.ldb * 2;
    const size_t tstepA = 2 * hstepA, tstepB = 2 * hstepB;
    const unsigned ldsw = (unsigned)wid * 1024u;
    const int aoff = lds_byte(wr * 64 + fr, fq * 8), boff = lds_byte(wc * 32 + fr, fq * 8);
#define PG8_SA(b, h) (((b) * 2 + (h)) * HTB)
#define PG8_SB(b, h) ((4 + (b) * 2 + (h)) * HTB)
#define PG8_STAGE(bufoff, gbase, voff) do { _Pragma("unroll") for (int _i = 0; _i < 2; ++_i) \
        __builtin_amdgcn_global_load_lds((const unsigned*)((const char*)(gbase) + (voff)[_i]), (LAS unsigned*)(lds + (bufoff) + ldsw + _i * 8192), 16, 0, 0); } while (0)
#define PG8_LDA(dst, b, h) do { _Pragma("unroll") for (int m = 0; m < 4; ++m) _Pragma("unroll") for (int k = 0; k < 2; ++k) dst[m][k] = *(const LAS bf16x8*)(lds + PG8_SA(b, h) + aoff + m * 2048 + k * 1024); } while (0)
#define PG8_LDB(dst, b, h) do { _Pragma("unroll") for (int n = 0; n < 2; ++n) _Pragma("unroll") for (int k = 0; k < 2; ++k) dst[n][k] = *(const LAS bf16x8*)(lds + PG8_SB(b, h) + boff + n * 2048 + k * 1024); } while (0)
#define PG8_MMA(ai, bj, At, Bt) do { __builtin_amdgcn_s_setprio(1); _Pragma("unroll") for (int m = 0; m < 4; ++m) _Pragma("unroll") for (int n = 0; n < 2; ++n) _Pragma("unroll") for (int k = 0; k < 2; ++k) \
        acc[ai][bj][m][n] = __builtin_amdgcn_mfma_f32_16x16x32_bf16(Bt[n][k], At[m][k], acc[ai][bj][m][n], 0, 0, 0); __builtin_amdgcn_s_setprio(0); } while (0)
#define PG8_WAIT_V(n) asm volatile("s_waitcnt vmcnt(" #n ")" ::: "memory")
#define PG8_WAIT_L(n) asm volatile("s_waitcnt lgkmcnt(" #n ")" ::: "memory")
#define PG8_BAR __builtin_amdgcn_s_barrier()
#define PG8_SCHED __builtin_amdgcn_sched_barrier(0)
    Unit cur, nxt; int ui = 0;
    if (!S.next(0, cur)) return;
    f32x4 acc[2][2][4][2];
#pragma unroll
    for (int a = 0; a < 2; ++a)
#pragma unroll
        for (int b = 0; b < 2; ++b)
#pragma unroll
            for (int m = 0; m < 4; ++m)
#pragma unroll
                for (int n = 0; n < 2; ++n) acc[a][b][m][n] = (f32x4){0.f, 0.f, 0.f, 0.f};
    bf16x8 At[4][2], B0[2][2], B1[2][2];
    const char* cA = (const char*)g.A + (size_t)cur.pm * tstepA; const char* cB = (const char*)g.Bt + (size_t)cur.pn * tstepB;
    PG8_STAGE(PG8_SB(0, 0), cB, voffB); PG8_STAGE(PG8_SB(0, 1), cB + hstepB, voffB); PG8_STAGE(PG8_SA(0, 0), cA, voffA); PG8_STAGE(PG8_SA(0, 1), cA + hstepA, voffA);
    if (wr == 1) PG8_BAR;
    PG8_WAIT_V(2); PG8_BAR;
    PG8_STAGE(PG8_SB(1, 0), cB + kstep, voffB); PG8_STAGE(PG8_SA(1, 0), cA + kstep, voffA); PG8_STAGE(PG8_SB(1, 1), cB + hstepB + kstep, voffB);
    PG8_WAIT_V(6); PG8_BAR;
    for (;;) {
        const bool has_next = S.next(ui + 1, nxt);
        const char* nA = has_next ? (const char*)g.A + (size_t)nxt.pm * tstepA : cA; const char* nB = has_next ? (const char*)g.Bt + (size_t)nxt.pn * tstepB : cB;
        for (int t = 0; t < nt; t += 2) {
            const bool last = (t == nt - 2);
            const char* a1 = cA + (size_t)(t + 1) * kstep;
            const char* a2 = last ? nA : cA + (size_t)(t + 2) * kstep; const char* b2 = last ? nB : cB + (size_t)(t + 2) * kstep;
            const char* a3 = a2 + kstep; const char* b3 = b2 + kstep;
            PG8_LDB(B0, 0, 0); PG8_LDB(B1, 0, 1); PG8_SCHED; PG8_LDA(At, 0, 0); PG8_STAGE(PG8_SA(1, 1), a1 + hstepA, voffA);
            PG8_WAIT_V(8); PG8_WAIT_L(0); PG8_BAR; PG8_MMA(0, 0, At, B0); PG8_MMA(0, 1, At, B1); PG8_BAR; PG8_SCHED;
            PG8_LDA(At, 0, 1); PG8_STAGE(PG8_SB(0, 0), b2, voffB); PG8_STAGE(PG8_SB(0, 1), b2 + hstepB, voffB); PG8_STAGE(PG8_SA(0, 0), a2, voffA);
            PG8_WAIT_V(8); PG8_WAIT_L(0); PG8_BAR; PG8_MMA(1, 0, At, B0); PG8_MMA(1, 1, At, B1); PG8_BAR; PG8_SCHED;
            PG8_LDB(B0, 1, 0); PG8_LDB(B1, 1, 1); PG8_SCHED; PG8_LDA(At, 1, 0); PG8_STAGE(PG8_SA(0, 1), a2 + hstepA, voffA);
            PG8_WAIT_V(8); PG8_WAIT_L(0); PG8_BAR; PG8_MMA(0, 0, At, B0); PG8_MMA(0, 1, At, B1); PG8_BAR; PG8_SCHED;
            PG8_LDA(At, 1, 1); PG8_STAGE(PG8_SB(1, 0), b3, voffB); PG8_STAGE(PG8_SB(1, 1), b3 + hstepB, voffB); PG8_STAGE(PG8_SA(1, 0), a3, voffA);
            PG8_WAIT_V(8); PG8_WAIT_L(0); PG8_BAR; PG8_MMA(1, 0, At, B0); PG8_MMA(1, 1, At, B1); PG8_BAR; PG8_SCHED;
        }
        if (wr == 0) PG8_BAR;
        E(acc, cur, wr, wc, fr, fq);
        if (!has_next) break;
#pragma unroll
        for (int a = 0; a < 2; ++a)
#pragma unroll
            for (int b = 0; b < 2; ++b)
#pragma unroll
                for (int m = 0; m < 4; ++m)
#pragma unroll
                    for (int n = 0; n < 2; ++n) acc[a][b][m][n] = (f32x4){0.f, 0.f, 0.f, 0.f};
        cur = nxt; cA = nA; cB = nB; ++ui;
        if (wr == 1) PG8_BAR;
    }
    PG8_WAIT_V(0);
    PG8_BAR;
#undef PG8_SA
#undef PG8_SB
#undef PG8_STAGE
#undef PG8_LDA
#undef PG8_LDB
#undef PG8_MMA
#undef PG8_WAIT_V
#undef PG8_WAIT_L
#undef PG8_BAR
#undef PG8_SCHED
}
}

struct Args { const float* in[32]; float* out; unsigned char* ws; };

struct Frame {
    LAS unsigned char* lds;
    int tid, lane, wave, vcu, G, gw, NGW, bx;
    const float* const* in;
};
enum { I_X = 0, I_C, I_CTX, I_CCTX, I_ADAW, I_ADAB, I_NORMG, I_FWIN, I_FWOUT, I_DAWIN, I_DAWOUT, I_DALAM, I_DASUB, I_NAWIN, I_NAWOUT, I_NARPB,
       I_RWMU, I_RWWIN, I_RWWOUT, I_RWW0, I_RWW1, I_RWW2, I_RWA0, I_RWA1, I_RWA2, I_RWG1, I_RWG2, I_RWKK, I_RWKA, I_RWRK, I_RWLNG, I_RWLNB };

DI void conv_item(const float* W, int ldw, int k0, int n0, int kmax, const float* mu, bf16_t* dst, int ldd, int dst_row0, int dst_k0, LAS float* scr, int lane) {
    float cv[32];
#pragma unroll
    for (int i = 0; i < 32; ++i) { const int k = k0 + 2 * i + (lane >> 5); cv[i] = (k < kmax) ? W[(size_t)k * ldw + n0 + (lane & 31)] : 0.f; }
    if (mu) {
#pragma unroll
        for (int i = 0; i < 32; ++i) { const int k = k0 + 2 * i + (lane >> 5); cv[i] *= (k < kmax) ? mu[k] : 0.f; }
    }
#pragma unroll
    for (int i = 0; i < 32; ++i) scr[(2 * i + (lane >> 5)) * 33 + (lane & 31)] = cv[i];
    asm volatile("s_waitcnt lgkmcnt(0)" ::: "memory");
    const int c = lane & 7;
#pragma unroll
    for (int j = 0; j < 4; ++j) { const int n = (lane >> 3) + 8 * j; const LAS float* s = scr + (8 * c) * 33 + n;
        u32x4 o; o.x = pk2(s[0 * 33], s[1 * 33]); o.y = pk2(s[2 * 33], s[3 * 33]); o.z = pk2(s[4 * 33], s[5 * 33]); o.w = pk2(s[6 * 33], s[7 * 33]);
        *(u32x4*)(dst + (size_t)(dst_row0 + n) * ldd + dst_k0 + k0 + 8 * c) = o; }
    asm volatile("s_waitcnt lgkmcnt(0)" ::: "memory");
}

DI void convert_layer(Frame& F, unsigned char* ws, int l) {
    bf16_t* WB = (bf16_t*)(ws + WS_WB);
    LAS float* scr = (LAS float*)(F.lds + F.wave * 16384);
    const int kind = l % 3, slot = l / 3;
    constexpr int I_FIN = 16 * 176, I_FOUT = 44 * 32, I_MIN = 16 * 96, I_MOUT = 16 * 32;
    const float* fwin = F.in[I_FWIN] + (size_t)l * 2 * 1024 * 5632;
    const float* fwout = F.in[I_FWOUT] + (size_t)l * 2 * 2816 * 1024;
    int nitems = 2 * I_FIN + 2 * I_FOUT + I_MOUT;
    if (kind == 2) nitems += 2 * I_MIN + 4 * 16 * 2 * 2 + 16 * 5 * 2 + 4 * 32 + 96;
    else nitems += I_MIN;
    for (int it = F.gw; it < nitems; it += F.NGW) {
        int r = it;
        if (r < 2 * I_FIN) { const int s = r / I_FIN; r -= s * I_FIN; const int kb = r / 176, nb = r % 176, n0 = nb * 32;
            const int hf = n0 / 2816, rem = n0 % 2816, p = rem / 128, i = rem % 128;
            conv_item(fwin + (size_t)s * 1024 * 5632, 5632, kb * 64, n0, 1024, nullptr, WB + (s ? WB_IN1 : WB_IN0), 1024, p * 256 + hf * 128 + i, 0, scr, F.lane); continue; }
        r -= 2 * I_FIN;
        if (r < 2 * I_FOUT) { const int s = r / I_FOUT; r -= s * I_FOUT; const int kb = r / 32, nb = r % 32;
            conv_item(fwout + (size_t)s * 2816 * 1024, 1024, kb * 64, nb * 32, 2816, nullptr, WB + (s ? WB_OUT1 : WB_OUT0), 2816, nb * 32, 0, scr, F.lane); continue; }
        r -= 2 * I_FOUT;
        if (r < I_MOUT) { const float* w = kind == 0 ? F.in[I_DAWOUT] + (size_t)slot * 1024 * 1024 : kind == 1 ? F.in[I_NAWOUT] : F.in[I_RWWOUT];
            const int kb = r / 32, nb = r % 32;
            conv_item(w, 1024, kb * 64, nb * 32, 1024, nullptr, WB + WB_MIXOUT, 1024, nb * 32, 0, scr, F.lane); continue; }
        r -= I_MOUT;
        if (kind != 2) { const float* w = kind == 0 ? F.in[I_DAWIN] + (size_t)slot * 1024 * 3072 : F.in[I_NAWIN];
            const int kb = r / 96, nb = r % 96;
            conv_item(w, 3072, kb * 64, nb * 32, 1024, nullptr, WB + WB_MIXIN, 1024, nb * 32, 0, scr, F.lane); continue; }
        const float* mu = F.in[I_RWMU];
        if (r < 2 * I_MIN) { const int var = r / I_MIN; r -= var * I_MIN; const int kb = r / 96, nb = r % 96, n0 = nb * 32;
            const int mj = n0 < 1024 ? 0 : (n0 < 2048 ? 2 : 3);
            conv_item(F.in[I_RWWIN], 3072, kb * 64, n0, 1024, var ? mu + mj * 1024 : nullptr, WB + WB_MIXIN, 2048, n0, var * 1024, scr, F.lane); continue; }
        r -= 2 * I_MIN;
        if (r < 4 * 16 * 2 * 2) { const int var = r & 1; r >>= 1; const int nb = r & 1; r >>= 1; const int kb = r & 15; r >>= 4; const int dir = r & 1, isa = r >> 1;
            const float* w = (isa ? F.in[I_RWA1] : F.in[I_RWW1]) + (size_t)dir * 1024 * 64;
            conv_item(w, 64, kb * 64, nb * 32, 1024, var ? mu + (isa ? 4 : 1) * 1024 : nullptr, WB + WB_MIXIN, 2048, (isa ? 3200 : 3072) + dir * 64 + nb * 32, var * 1024, scr, F.lane); continue; }
        r -= 4 * 16 * 2 * 2;
        if (r < 16 * 5 * 2) { const int var = r & 1; r >>= 1; const int nb = r % 5, kb = r / 5;
            conv_item(F.in[I_RWG1], 160, kb * 64, nb * 32, 1024, var ? mu + 5 * 1024 : nullptr, WB + WB_MIXIN, 2048, 3328 + nb * 32, var * 1024, scr, F.lane); continue; }
        r -= 16 * 5 * 2;
        if (r < 4 * 32) { const int kb = r / 32, nb = r % 32;
            conv_item(F.in[I_RWG2], 1024, kb * 64, nb * 32, 160, nullptr, WB + WB_G2T, 256, nb * 32, 0, scr, F.lane); continue; }
        r -= 4 * 32;
        { bf16_t* z = WB + WB_MIXIN + (size_t)(3488 + r) * 2048;
#pragma unroll
          for (int j = 0; j < 4; ++j) *(u32x4*)(z + (j * 64 + F.lane) * 8) = (u32x4){0u, 0u, 0u, 0u}; }
    }
}

DI void phase0(Frame& F, unsigned char* ws) {
    LAS float* sl = (LAS float*)F.lds;
    LAS float* part = (LAS float*)(F.lds + 69632);
    float* MOD = (float*)(ws + WS_MOD);
    for (int i = F.tid; i < 17 * 1024; i += 512) { const float v = i < 16384 ? F.in[I_C][i] : F.in[I_CCTX][i - 16384]; sl[i] = v / (1.f + expf(-v)); }
    __syncthreads();
    for (int item = F.vcu; item < 4 * 72; item += F.G) {
        const int l = item / 72, n0 = (item % 72) * 128;
        const float* W = F.in[I_ADAW] + (size_t)l * 1024 * NMOD + n0 + 2 * F.lane;
        float acc[17][2];
#pragma unroll
        for (int r = 0; r < 17; ++r) { acc[r][0] = 0.f; acc[r][1] = 0.f; }
        const int kbase = F.wave * 128;
        f32x2 wn[16];
#pragma unroll
        for (int e = 0; e < 16; ++e) wn[e] = *(const f32x2*)(W + (size_t)(kbase + e) * NMOD);
        for (int k16 = 0; k16 < 128; k16 += 16) {
            f32x2 w[16];
#pragma unroll
            for (int e = 0; e < 16; ++e) w[e] = wn[e];
            if (k16 + 16 < 128) {
#pragma unroll
                for (int e = 0; e < 16; ++e) wn[e] = *(const f32x2*)(W + (size_t)(kbase + k16 + 16 + e) * NMOD);
            }
#pragma unroll
            for (int q = 0; q < 4; ++q)
#pragma unroll
                for (int r = 0; r < 17; ++r) { const f32x4 s = *(const LAS f32x4*)(sl + r * 1024 + kbase + k16 + 4 * q);
#pragma unroll
                    for (int e = 0; e < 4; ++e) { acc[r][0] += s[e] * w[4 * q + e].x; acc[r][1] += s[e] * w[4 * q + e].y; } }
        }
#pragma unroll
        for (int r = 0; r < 17; ++r) *(LAS f32x2*)(part + (F.wave * 17 + r) * 128 + 2 * F.lane) = (f32x2){acc[r][0], acc[r][1]};
        __syncthreads();
        for (int idx = F.tid; idx < 17 * 128; idx += 512) { const int r = idx >> 7, cI = idx & 127; float s = 0.f;
#pragma unroll
            for (int w = 0; w < 8; ++w) s += part[(w * 17 + r) * 128 + cI];
            MOD[((size_t)l * 17 + r) * NMOD + n0 + cI] = s + F.in[I_ADAB][(size_t)l * NMOD + n0 + cI]; }
        __syncthreads();
    }
    if (F.bx == 0) {
        for (int i = F.tid; i < 3456; i += 512) ((unsigned*)(ws + WS_BAR))[i] = 0u;
        float* cosT = (float*)(ws + WS_ROPE); float* sinT = cosT + 1024;
        for (int i = F.tid; i < 1024; i += 512) { const int pos = i >> 4, p = i & 15; const float fr = powf(10000.f, -(float)p / 16.f); const float ang = (float)pos * fr; cosT[i] = cosf(ang); sinT[i] = sinf(ang); }
        if (F.tid < 2) { const float* lv = F.in[I_DALAM] + F.tid * 256; float d0 = 0.f, d1 = 0.f;
            for (int i = 0; i < 64; ++i) { d0 += lv[i] * lv[64 + i]; d1 += lv[128 + i] * lv[192 + i]; }
            const float li = 0.8f - 0.6f * expf(-0.3f * (float)(F.tid * 3));
            float* lam = (float*)(ws + WS_LAM); lam[2 * F.tid] = expf(d0) - expf(d1) + li; lam[2 * F.tid + 1] = li; }
    }
    __syncthreads();
    convert_layer(F, ws, 0);
}

struct RowPass {
    const float* hsrc_lat; const float* hsrc_ctx; float* hdst_lat; float* hdst_ctx;
    const bf16_t* Y;
    const float* gpost; int gate_idx; float coef; int lpost;
    const float* gpre; int shift_idx; int lpre;
    bf16_t* U; int ldu; int skip_ctx;
};
DI void row_pass(Frame& F, unsigned char* ws, const RowPass& P, int row_lo, int row_hi, int widx, int nw) {
    const float* MOD = (const float*)(ws + WS_MOD);
    const int rpw = (row_hi - row_lo + nw - 1) / nw;
    const int rbeg = row_lo + widx * rpw, rend = min(rbeg + rpw, row_hi);
    if (rbeg >= rend) return;
    const int l4 = 4 * F.lane;
    f32x4 gpo[4], gpr[4], gat[4], shf[4], scl[4];
#pragma unroll
    for (int j = 0; j < 4; ++j) { gpo[j] = *(const f32x4*)(P.gpost + l4 + 256 * j); gpr[j] = P.gpre ? *(const f32x4*)(P.gpre + l4 + 256 * j) : (f32x4){0.f, 0.f, 0.f, 0.f}; }
    int cur_mrow = -1;
    f32x4 hn[4]; u32x2 yn[4];
#define RP_ADDR(row, isctx, hoff) const int _b = (row) / LROW, _t = (row) % LROW; const bool isctx = _t < CTX; \
        const size_t hoff = isctx ? ((size_t)_b * CTX + _t) * DM : ((size_t)_b * SEQ + (_t - CTX)) * DM;
#define RP_LOAD(row) do { RP_ADDR(row, ic_, ho_) if (!(ic_ && P.skip_ctx)) { const float* hs_ = (ic_ ? P.hsrc_ctx : P.hsrc_lat) + ho_ + l4; \
        _Pragma("unroll") for (int j = 0; j < 4; ++j) hn[j] = *(const f32x4*)(hs_ + 256 * j); \
        if (P.Y) { const bf16_t* yr_ = P.Y + (size_t)(row) * DM + l4; _Pragma("unroll") for (int j = 0; j < 4; ++j) yn[j] = *(const u32x2*)(yr_ + 256 * j); } } } while (0)
    RP_LOAD(rbeg);
    for (int row = rbeg; row < rend; ++row) {
        f32x4 h[4]; u32x2 yv[4];
#pragma unroll
        for (int j = 0; j < 4; ++j) { h[j] = hn[j]; yv[j] = yn[j]; }
        if (row + 1 < rend) RP_LOAD(row + 1);
        RP_ADDR(row, isctx, hoff)
        if (isctx && P.skip_ctx) continue;
        float* hd = (isctx ? P.hdst_ctx : P.hdst_lat) + hoff + l4;
        const bool copy_h = ((isctx ? P.hsrc_ctx : P.hsrc_lat) != (isctx ? P.hdst_ctx : P.hdst_lat));
        const int mrow = isctx ? 16 : _b;
        if (mrow != cur_mrow) { cur_mrow = mrow;
            const float* gate = MOD + ((size_t)P.lpost * 17 + mrow) * NMOD + P.gate_idx * DM + l4;
            const float* sh = MOD + ((size_t)P.lpre * 17 + mrow) * NMOD + P.shift_idx * DM + l4;
#pragma unroll
            for (int j = 0; j < 4; ++j) { gat[j] = *(const f32x4*)(gate + 256 * j) * P.coef; shf[j] = *(const f32x4*)(sh + 256 * j); scl[j] = *(const f32x4*)(sh + DM + 256 * j) + 1.f; } }
        if (P.Y) {
            f32x4 y[4]; float ss = 0.f;
#pragma unroll
            for (int j = 0; j < 4; ++j) { y[j] = (f32x4){bflo(yv[j].x), bfhi(yv[j].x), bflo(yv[j].y), bfhi(yv[j].y)};
                ss += (y[j].x * y[j].x + y[j].y * y[j].y) + (y[j].z * y[j].z + y[j].w * y[j].w); }
            const float rstd = 1.f / sqrtf(wave_sum(ss) * (1.f / DM) + NORM_EPS);
#pragma unroll
            for (int j = 0; j < 4; ++j) h[j] = h[j] + gat[j] * ((y[j] * rstd) * gpo[j]);
        }
        if (P.Y || copy_h) {
#pragma unroll
            for (int j = 0; j < 4; ++j) *(f32x4*)(hd + 256 * j) = h[j];
        }
        if (P.gpre) {
            float ss = 0.f;
#pragma unroll
            for (int j = 0; j < 4; ++j) ss += (h[j].x * h[j].x + h[j].y * h[j].y) + (h[j].z * h[j].z + h[j].w * h[j].w);
            const float rstd = 1.f / sqrtf(wave_sum(ss) * (1.f / DM) + NORM_EPS);
            bf16_t* ur = P.U + (size_t)row * P.ldu + l4;
#pragma unroll
            for (int j = 0; j < 4; ++j) { const f32x4 u = ((h[j] * rstd) * gpr[j]) * scl[j] + shf[j];
                *(u32x2*)(ur + 256 * j) = (u32x2){pk2(u.x, u.y), pk2(u.z, u.w)}; }
        }
    }
#undef RP_ADDR
#undef RP_LOAD
}

DI void xx_pass(Frame& F, unsigned char* ws) {
    bf16_t* U = (bf16_t*)(ws + WS_U);
    for (int row = F.gw; row < MROWS; row += F.NGW) {
        const int t = row % LROW;
        const bool first = (t == 0) || (t == CTX), lastr = (t == CTX - 1) || (t == LROW - 1);
        const bf16_t* ur = U + (size_t)row * 2048 + 8 * F.lane;
#pragma unroll
        for (int j = 0; j < 2; ++j) {
            const u32x4 c = *(const u32x4*)(ur + 512 * j);
            u32x4 p = {0u, 0u, 0u, 0u}, n = {0u, 0u, 0u, 0u};
            if (!first) p = *(const u32x4*)(ur - 2048 + 512 * j);
            if (!lastr) n = *(const u32x4*)(ur + 2048 + 512 * j);
            u32x4 o;
#pragma unroll
            for (int e = 0; e < 4; ++e) { const float lo = 0.5f * (bflo(p[e]) + bflo(n[e])) - bflo(c[e]); const float hi = 0.5f * (bfhi(p[e]) + bfhi(n[e])) - bfhi(c[e]); o[e] = pk2(lo, hi); }
            *(u32x4*)((bf16_t*)ur + 1024 + 512 * j) = o;
        }
    }
}

DI f32x16 mfma32(bf16x8 a, bf16x8 b, f32x16 c) { return __builtin_amdgcn_mfma_f32_32x32x16_bf16(a, b, c, 0, 0, 0); }
DI bf16x8 pack8(const f32x16& x, int s) { u32x4 p; p.x = pk2(x[8 * s], x[8 * s + 1]); p.y = pk2(x[8 * s + 2], x[8 * s + 3]); p.z = pk2(x[8 * s + 4], x[8 * s + 5]); p.w = pk2(x[8 * s + 6], x[8 * s + 7]); return __builtin_bit_cast(bf16x8, p); }
typedef short v4i16_t __attribute__((ext_vector_type(4)));
DI s16x4 vtr(LAS const unsigned char* p) { return __builtin_bit_cast(s16x4, __builtin_amdgcn_ds_read_tr16_b64_v4i16((LAS v4i16_t*)p)); }
DI float max3f(float a, float b, float c) { return __builtin_fmaxf(__builtin_fmaxf(a, b), c); }
DI float max16(const f32x16& p) { float a = max3f(p[0], p[1], p[2]), b = max3f(p[3], p[4], p[5]);
    a = max3f(a, p[6], p[7]); b = max3f(b, p[8], p[9]); a = max3f(a, p[10], p[11]); b = max3f(b, p[12], p[13]); a = max3f(a, p[14], p[15]); return __builtin_fmaxf(a, b); }

template <int NDB>
DI void softmax_pv(f32x16& p0, f32x16& p1, f32x16 (&o)[NDB], f32x16& negm, float& m_run, float& l_run, const bool first, LAS float* wsf, LAS const unsigned char* Vb, int KP, int r, int hh, int lane) {
    float mx = __builtin_fmaxf(max16(p0), max16(p1)); mx = __builtin_fmaxf(mx, __shfl_xor(mx, 32));
    if (first || __any(mx > 8.f)) {
        const float delta = first ? mx : __builtin_fmaxf(mx, 0.f);
        m_run += delta;
#pragma unroll
        for (int i = 0; i < 16; ++i) { p0[i] -= delta; p1[i] -= delta; negm[i] = -m_run; }
        if (!first) {
            const float alpha = __builtin_amdgcn_exp2f(-delta);
            l_run *= alpha;
            if (hh == 0) wsf[r] = alpha;
#pragma unroll
            for (int g4 = 0; g4 < 4; ++g4) { const f32x4 a4 = *(const LAS f32x4*)(wsf + 8 * g4 + 4 * hh);
#pragma unroll
                for (int d = 0; d < NDB; ++d)
#pragma unroll
                    for (int e = 0; e < 4; ++e) o[d][4 * g4 + e] *= a4[e]; }
        }
    }
    f32x2 ls2 = {0.f, 0.f};
#pragma unroll
    for (int i = 0; i < 16; i += 2) {
        p0[i] = __builtin_amdgcn_exp2f(p0[i]); p0[i + 1] = __builtin_amdgcn_exp2f(p0[i + 1]); p1[i] = __builtin_amdgcn_exp2f(p1[i]); p1[i + 1] = __builtin_amdgcn_exp2f(p1[i + 1]);
        ls2 += (f32x2){p0[i], p0[i + 1]}; ls2 += (f32x2){p1[i], p1[i + 1]};
    }
    l_run += ls2.x + ls2.y;
    const int i16 = lane & 15, q4 = i16 >> 2, p4 = i16 & 3, g1 = (lane >> 4) & 1;
    LAS const unsigned char* vl = Vb + (4 * hh + q4) * 64 + 32 * g1 + 8 * p4;
    const bf16x8 pa[4] = {pack8(p0, 0), pack8(p0, 1), pack8(p1, 0), pack8(p1, 1)};
    s16x4 flo[2][NDB], fhi[2][NDB];
#pragma unroll
    for (int d = 0; d < NDB; ++d) { flo[0][d] = vtr(vl + d * 4096); fhi[0][d] = vtr(vl + 8 * 64 + d * 4096); }
#pragma unroll
    for (int k = 0; k < 4; ++k) {
        if (k + 1 < 4) {
            LAS const unsigned char* vk = vl + 16 * (k + 1) * 64;
#pragma unroll
            for (int d = 0; d < NDB; ++d) { flo[(k + 1) & 1][d] = vtr(vk + d * 4096); fhi[(k + 1) & 1][d] = vtr(vk + 8 * 64 + d * 4096); }
        }
        __builtin_amdgcn_sched_barrier(0);
#pragma unroll
        for (int d = 0; d < NDB; ++d) { const bf16x8 vb = __builtin_shufflevector(flo[k & 1][d], fhi[k & 1][d], 0, 1, 2, 3, 4, 5, 6, 7); o[d] = mfma32(pa[k], vb, o[d]); }
        __builtin_amdgcn_sched_barrier(0);
    }
}

DI void da_unit(LAS unsigned char* lds, const int tid, const bf16_t* QKV, bf16_t* O, int q_row0, int kv_row0, int NT, int h, float lam, float one_m_li, const float* subg) {
    const int lane = tid & 63, wid = __builtin_amdgcn_readfirstlane(tid >> 6), r = lane & 31, hh = lane >> 5;
    const int qg = wid >> 1, j = wid & 1;
    constexpr int KP = 272, STG = 2 * 64 * KP;
    LAS float* wsf = (LAS float*)(lds + 2 * STG) + wid * 64;
    const bf16_t* gbase = QKV + (size_t)(kv_row0 + (tid >> 4)) * 3072 + 1024 + h * 128 + (tid & 15) * 8;
    const int lbase = (tid >> 4) * KP + (tid & 15) * 16;
    const int vbase = ((tid & 15) >> 2) * 4096 + (tid >> 4) * 64 + (tid & 3) * 16;
    u32x4 st[4];
#define DA_LOAD(t) do { _Pragma("unroll") for (int i = 0; i < 4; ++i) st[i] = *(const u32x4*)(gbase + (size_t)(t) * 64 * 3072 + (size_t)(i & 1) * 32 * 3072 + (i >> 1) * 1024); } while (0)
#define DA_STORE(buf) do { _Pragma("unroll") for (int i = 0; i < 2; ++i) { *(LAS u32x4*)(lds + (buf) * STG + lbase + i * 32 * KP) = st[i]; *(LAS u32x4*)(lds + (buf) * STG + 64 * KP + vbase + i * 32 * 64) = st[2 + i]; } } while (0)
    const bf16_t* qp = QKV + (size_t)(q_row0 + 32 * qg + r) * 3072 + h * 128 + j * 64 + 8 * hh;
    bf16x8 qr[4];
#pragma unroll
    for (int d0 = 0; d0 < 4; ++d0) qr[d0] = *(const bf16x8*)(qp + 16 * d0);
    f32x16 o[4];
#pragma unroll
    for (int d = 0; d < 4; ++d)
#pragma unroll
        for (int i = 0; i < 16; ++i) o[d][i] = 0.f;
    float m_run = 0.f, l_run = 0.f;
    f32x16 negm;
#pragma unroll
    for (int i = 0; i < 16; ++i) negm[i] = 0.f;
    DA_LOAD(0); DA_STORE(0); __syncthreads();
    for (int t = 0; t < NT; ++t) {
        const int cur = t & 1;
        if (t + 1 < NT) DA_LOAD(t + 1);
        LAS const unsigned char* Kb = lds + cur * STG + j * 128 + r * KP + hh * 16;
        LAS const unsigned char* Vb = lds + cur * STG + 64 * KP;
        f32x16 p0 = negm, p1 = negm;
#pragma unroll
        for (int d0 = 0; d0 < 4; ++d0) { const bf16x8 k0 = *(const LAS bf16x8*)(Kb + d0 * 32), k1 = *(const LAS bf16x8*)(Kb + 32 * KP + d0 * 32);
            p0 = mfma32(k0, qr[d0], p0); p1 = mfma32(k1, qr[d0], p1); }
        softmax_pv<4>(p0, p1, o, negm, m_run, l_run, t == 0, wsf, Vb, KP, r, hh, lane);
        if (t + 1 < NT) DA_STORE(cur ^ 1);
        LDS_BARRIER();
    }
#undef DA_LOAD
#undef DA_STORE
    const float lt = l_run + __shfl_xor(l_run, 32);
    if (hh == 0) wsf[r] = 1.f / lt;
    float rl[16];
#pragma unroll
    for (int g4 = 0; g4 < 4; ++g4) { const f32x4 a4 = *(const LAS f32x4*)(wsf + 8 * g4 + 4 * hh);
#pragma unroll
        for (int e = 0; e < 4; ++e) rl[4 * g4 + e] = a4[e]; }
    LAS float* R = (LAS float*)lds + qg * 32 * 132;
    if (j == 1) {
#pragma unroll
        for (int d = 0; d < 4; ++d)
#pragma unroll
            for (int i = 0; i < 16; ++i) R[((i & 3) + 8 * (i >> 2) + 4 * hh) * 132 + d * 32 + r] = o[d][i] * rl[i] * lam;
    }
    __syncthreads();
    if (j == 0) {
#pragma unroll
        for (int d = 0; d < 4; ++d)
#pragma unroll
            for (int i = 0; i < 16; ++i) { const int idx = ((i & 3) + 8 * (i >> 2) + 4 * hh) * 132 + d * 32 + r; R[idx] = o[d][i] * rl[i] - R[idx]; }
    }
    __syncthreads();
    {
        const int row = tid >> 2, qtr = tid & 3;
        LAS const float* rp = (LAS const float*)lds + (row >> 5) * 32 * 132 + (row & 31) * 132 + qtr * 32;
        f32x4 v[8]; float ss = 0.f;
#pragma unroll
        for (int c = 0; c < 8; ++c) { v[c] = *(const LAS f32x4*)(rp + 4 * c); ss += (v[c].x * v[c].x + v[c].y * v[c].y) + (v[c].z * v[c].z + v[c].w * v[c].w); }
        ss += __shfl_xor(ss, 1); ss += __shfl_xor(ss, 2);
        const float rs = one_m_li / sqrtf(ss * (1.f / 128.f) + NORM_EPS);
        bf16_t* op = O + (size_t)(q_row0 + row) * DM + h * 128 + qtr * 32;
        const float* gp = subg + qtr * 32;
#pragma unroll
        for (int c = 0; c < 4; ++c) { const f32x4 g0 = *(const f32x4*)(gp + 8 * c), g1 = *(const f32x4*)(gp + 8 * c + 4); const f32x4 a = v[2 * c] * rs * g0, b = v[2 * c + 1] * rs * g1;
            *(u32x4*)(op + 8 * c) = (u32x4){pk2(a.x, a.y), pk2(a.z, a.w), pk2(b.x, b.y), pk2(b.z, b.w)}; }
    }
    __syncthreads();
}

DI void da_phase(Frame& F, unsigned char* ws, int l) {
    const bf16_t* QKV = (const bf16_t*)(ws + WS_ACT); bf16_t* O = (bf16_t*)(ws + WS_U);
    const int slot = l / 3; const bool last = (l == 3);
    const float* lamv = (const float*)(ws + WS_LAM); const float lam = lamv[2 * slot], li = lamv[2 * slot + 1];
    const float* subg = F.in[I_DASUB] + slot * 128;
    const int nunits = 2048 + (last ? 0 : 256);
    for (int u = F.vcu; u < nunits; u += F.G) {
        if (u < 2048) { const int bh = u >> 4, qt = u & 15, b = bh >> 3, h = bh & 7;
            da_unit(F.lds, F.tid, QKV, O, b * LROW + CTX + qt * 128, b * LROW, 36, h, lam, 1.f - li, subg); }
        else { const int v = u - 2048, bh = v >> 1, qt = v & 1, b = bh >> 3, h = bh & 7;
            da_unit(F.lds, F.tid, QKV, O, b * LROW + qt * 128, b * LROW, 4, h, lam, 1.f - li, subg); }
    }
}

DI void na_unit(LAS unsigned char* lds, const int tid, const bf16_t* QKV, bf16_t* O, const float* rpb, int b, int h, int R, int ctxq) {
    const int lane = tid & 63, wid = __builtin_amdgcn_readfirstlane(tid >> 6), r = lane & 31, hh = lane >> 5;
    constexpr int KP = 144, STG = 2 * 64 * KP;
    LAS float* wsf = (LAS float*)(lds + 2 * STG) + wid * 64;
    LAS float* rpbL = (LAS float*)(lds + 2 * STG + 2048);
    const int rw = 4 * R + (wid >> 1), cq = 32 * (wid & 1) + r;
    const int rs_w = min(max(rw - 4, 0), 24);
    const int rlo = min(max(4 * R - 4, 0), 24), rhi = min(max(4 * R - 1, 0), 24) + 7;
    const int NT = ctxq ? 4 : 4 + (rhi - rlo + 1);
    const int q_row = ctxq ? b * LROW + 32 * wid + r : b * LROW + CTX + R * 256 + 32 * wid + r;
    if (!ctxq) for (int i = tid; i < 465; i += 512) rpbL[i] = rpb[h * 465 + i] * LOG2E;
    const int srow = tid >> 3, sch = tid & 7;
    const bf16_t* gb = QKV + (size_t)(b * LROW) * 3072 + 1024 + h * 64 + sch * 8;
    const int lbase = srow * KP + sch * 16;
    u32x4 st[2];
#define NA_ROW(t) ((t) < 4 ? 64 * (t) : CTX + (rlo + (t) - 4) * 64)
#define NA_LOAD(t) do { const bf16_t* _g = gb + (size_t)(NA_ROW(t) + srow) * 3072; st[0] = *(const u32x4*)_g; st[1] = *(const u32x4*)(_g + 1024); } while (0)
#define NA_STORE(buf) do { *(LAS u32x4*)(lds + (buf) * STG + lbase) = st[0]; *(LAS u32x4*)(lds + (buf) * STG + 64 * KP + (sch >> 2) * 4096 + srow * 64 + (sch & 3) * 16) = st[1]; } while (0)
    const bf16_t* qp = QKV + (size_t)q_row * 3072 + h * 64 + 8 * hh;
    bf16x8 qr[4];
#pragma unroll
    for (int d0 = 0; d0 < 4; ++d0) qr[d0] = *(const bf16x8*)(qp + 16 * d0);
    f32x16 o[2];
#pragma unroll
    for (int d = 0; d < 2; ++d)
#pragma unroll
        for (int i = 0; i < 16; ++i) o[d][i] = 0.f;
    float m_run = 0.f, l_run = 0.f;
    f32x16 negm;
#pragma unroll
    for (int i = 0; i < 16; ++i) negm[i] = 0.f;
    const int cs = min(max(cq - 8, 0), 48);
    NA_LOAD(0); NA_STORE(0); __syncthreads();
    for (int t = 0; t < NT; ++t) {
        const int cur = t & 1;
        if (t + 1 < NT) NA_LOAD(t + 1);
        const int ri = rlo + t - 4;
        const bool active = (t < 4) || (ri >= rs_w && ri <= rs_w + 7);
        if (active) {
            LAS const unsigned char* Kb = lds + cur * STG + r * KP + hh * 16;
            LAS const unsigned char* Vb = lds + cur * STG + 64 * KP;
            f32x16 p0 = negm, p1 = negm;
#pragma unroll
            for (int d0 = 0; d0 < 4; ++d0) { const bf16x8 k0 = *(const LAS bf16x8*)(Kb + d0 * 32), k1 = *(const LAS bf16x8*)(Kb + 32 * KP + d0 * 32);
                p0 = mfma32(k0, qr[d0], p0); p1 = mfma32(k1, qr[d0], p1); }
            if (t >= 4) {
                LAS const float* bt = rpbL + (ri - rw + 7) * 31 + 15 - cq;
#pragma unroll
                for (int i = 0; i < 16; ++i) { const int ck = (i & 3) + 8 * (i >> 2) + 4 * hh;
                    { const bool in = (ck >= cs) && (ck < cs + 16); const float bv = bt[in ? ck : cq]; p0[i] = in ? p0[i] + bv : -1e30f; }
                    { const int ck2 = ck + 32; const bool in = (ck2 >= cs) && (ck2 < cs + 16); const float bv = bt[in ? ck2 : cq]; p1[i] = in ? p1[i] + bv : -1e30f; } }
            }
            softmax_pv<2>(p0, p1, o, negm, m_run, l_run, t == 0, wsf, Vb, KP, r, hh, lane);
        }
        if (t + 1 < NT) NA_STORE(cur ^ 1);
        LDS_BARRIER();
    }
#undef NA_ROW
#undef NA_LOAD
#undef NA_STORE
    const float lt = l_run + __shfl_xor(l_run, 32);
    if (hh == 0) wsf[r] = 1.f / lt;
    const int orow0 = (ctxq ? b * LROW : b * LROW + CTX + R * 256) + 32 * wid;
#pragma unroll
    for (int g4 = 0; g4 < 4; ++g4) { const f32x4 a4 = *(const LAS f32x4*)(wsf + 8 * g4 + 4 * hh);
#pragma unroll
        for (int e = 0; e < 4; ++e) { const int i = 4 * g4 + e; const int q = 8 * g4 + 4 * hh + e;
            bf16_t* op = O + (size_t)(orow0 + q) * DM + h * 64 + r;
            op[0] = (bf16_t)(pk2(o[0][i] * a4[e], 0.f) & 0xffffu); op[32] = (bf16_t)(pk2(o[1][i] * a4[e], 0.f) & 0xffffu); } }
    __syncthreads();
}

DI void na_phase(Frame& F, unsigned char* ws) {
    const bf16_t* QKV = (const bf16_t*)(ws + WS_ACT); bf16_t* O = (bf16_t*)(ws + WS_U);
    for (int u = F.vcu; u < 2048 + 256; u += F.G) {
        if (u < 2048) { const int bh = u >> 3, R = u & 7; na_unit(F.lds, F.tid, QKV, O, F.in[I_NARPB], bh >> 4, bh & 15, R, 0); }
        else { const int bh = u - 2048; na_unit(F.lds, F.tid, QKV, O, F.in[I_NARPB], bh >> 4, bh & 15, 0, 1); }
    }
}

template <int CTRL> DI float dppf(float x) { return __int_as_float(__builtin_amdgcn_update_dpp(0, __float_as_int(x), CTRL, 0xf, 0xf, false)); }
DI float allred8(float x) {
    float a, b, c;
    asm volatile("s_nop 1\n\tv_add_f32_dpp %0, %1, %1 row_half_mirror row_mask:0xf bank_mask:0xf bound_ctrl:1" : "=v"(a) : "v"(x));
    asm volatile("s_nop 1\n\tv_add_f32_dpp %0, %1, %1 quad_perm:[1,0,3,2] row_mask:0xf bank_mask:0xf bound_ctrl:1" : "=v"(b) : "v"(a));
    asm volatile("s_nop 1\n\tv_add_f32_dpp %0, %1, %1 quad_perm:[2,3,0,1] row_mask:0xf bank_mask:0xf bound_ctrl:1" : "=v"(c) : "v"(b));
    return c;
}
DI float allred8_ref(float x) { x += dppf<0x141>(x); x += dppf<0xB1>(x); x += dppf<0x4E>(x); return x; }
DI float allred16(float x) { x += dppf<0x128>(x); x += dppf<0x124>(x); x += dppf<0x122>(x); x += dppf<0x121>(x); return x; }
DI void rwkv_scan(Frame& F, unsigned char* ws) {
    const bf16_t* X = (const bf16_t*)(ws + WS_ACT);
    bf16_t* Y0 = (bf16_t*)(ws + WS_U) + (size_t)MROWS * DM;
    bf16_t* Y1 = (bf16_t*)(ws + WS_Y);
    float* CD = (float*)(ws + WS_CD);
    const int tid = F.tid, lane = F.lane, g = tid >> 8, gt = tid & 255, gwv = (tid >> 6) & 3;
    LAS float* buf = (LAS float*)(F.lds) + g * 5120;
    LAS float* ybuf0 = (LAS float*)(F.lds + 40960) + g * 2048;
    LAS float* red = (LAS float*)(F.lds + 57344) + g * 128;
    for (int s0 = F.vcu * 2; s0 < 512; s0 += F.G * 2) {
        const int s = s0 + g, dir = s >> 8, b = (s >> 4) & 15, h = s & 15;
        const int ch = 16 * gwv + (lane & 15), chn = h * 64 + ch, rq = lane >> 4;
        bf16x8 bw[2], ba[2];
#pragma unroll
        for (int ks = 0; ks < 2; ++ks) { u32x4 pw, pa;
#pragma unroll
            for (int e = 0; e < 4; ++e) { const int k = 32 * ks + 8 * rq + 2 * e;
                pw[e] = pk2(F.in[I_RWW2][(size_t)(dir * 64 + k) * 1024 + chn], F.in[I_RWW2][(size_t)(dir * 64 + k + 1) * 1024 + chn]);
                pa[e] = pk2(F.in[I_RWA2][(size_t)(dir * 64 + k) * 1024 + chn], F.in[I_RWA2][(size_t)(dir * 64 + k + 1) * 1024 + chn]); }
            bw[ks] = __builtin_bit_cast(bf16x8, pw); ba[ks] = __builtin_bit_cast(bf16x8, pa); }
        const float w0c = F.in[I_RWW0][dir * 1024 + chn], a0c = F.in[I_RWA0][dir * 1024 + chn], kkc = F.in[I_RWKK][chn], kac = F.in[I_RWKA][chn], rkc = F.in[I_RWRK][chn];
        const bf16_t* Xb = X + (size_t)(b * LROW) * 3584;
        bf16_t* Yd = (dir ? Y1 : Y0) + (size_t)(b * LROW) * DM + h * 64;
        float* CDd = CD + ((size_t)dir * MROWS + (size_t)b * LROW) * 16 + h;
        f32x2 S2[8];
#pragma unroll
        for (int i = 0; i < 8; ++i) S2[i] = (f32x2){0.f, 0.f};
        bf16x8 Bs[2];
        Bs[0] = (bf16x8){0, 0, 0, 0, 0, 0, 0, 0}; Bs[1] = Bs[0];
        const int vl = lane & 15, kq = lane >> 4;
        bf16x8 ahw[2], aha[2]; bf16_t rr_[4], kr_[4], vr_[4];
#define SC_RLO(c) (dir ? (((c) < 16 ? 255 - 16 * (c) : 2559 - 16 * (c)) - 15) : 16 * (c))
#define SC_LOAD(c) do { const int _rlo = SC_RLO(c); const bf16_t* _p = Xb + (size_t)(_rlo + (lane & 15)) * 3584 + 3072 + dir * 64 + 8 * rq; \
        ahw[0] = *(const bf16x8*)_p; ahw[1] = *(const bf16x8*)(_p + 32); aha[0] = *(const bf16x8*)(_p + 128); aha[1] = *(const bf16x8*)(_p + 160); \
        _Pragma("unroll") for (int j = 0; j < 4; ++j) { const bf16_t* _q = Xb + (size_t)(_rlo + 4 * rq + j) * 3584 + chn; rr_[j] = _q[0]; kr_[j] = _q[1024]; vr_[j] = _q[2048]; } } while (0)
#define SC_OUT(cc) do { const int rr_o = gt >> 4, c4_o = (gt & 15) * 4, js_o = dir ? 15 - rr_o : rr_o; const int rlo_o = SC_RLO(cc); \
        const f32x4 yv_o = *(const LAS f32x4*)(ybuf0 + ((cc) & 1) * 1024 + js_o * 64 + c4_o); \
        *(u32x2*)(Yd + (size_t)(rlo_o + rr_o) * DM + c4_o) = (u32x2){pk2(yv_o.x, yv_o.y), pk2(yv_o.z, yv_o.w)}; } while (0)
        SC_LOAD(0);
        for (int c = 0; c < 144; ++c) {
            const int rlo = SC_RLO(c);
            LAS float* cb = buf;
            LAS float* ybuf = ybuf0 + (c & 1) * 1024;
            f32x4 accw = {0.f, 0.f, 0.f, 0.f}, acca = {0.f, 0.f, 0.f, 0.f};
#pragma unroll
            for (int ks = 0; ks < 2; ++ks) { accw = __builtin_amdgcn_mfma_f32_16x16x32_bf16(ahw[ks], bw[ks], accw, 0, 0, 0); acca = __builtin_amdgcn_mfma_f32_16x16x32_bf16(aha[ks], ba[ks], acca, 0, 0, 0); }
            float dec[4], av[4], kkv[4], kd[4], rv[4], vv[4];
#pragma unroll
            for (int j = 0; j < 4; ++j) {
                const float z = w0c + accw[j]; dec[j] = fast_exp(-0.6065306597126334f * sigmoidf_(z));
                av[j] = sigmoidf_(a0c + acca[j]);
                const float kx = bf2f(kr_[j]); rv[j] = bf2f(rr_[j]); vv[j] = bf2f(vr_[j]);
                kkv[j] = kx * kkc; kd[j] = kx * (1.f + (av[j] - 1.f) * kac);
                const float nsq = allred16(kkv[j] * kkv[j]), cp = allred16(rv[j] * kd[j] * rkc);
                if ((lane & 15) == 0) { red[(4 * rq + j) * 4 + gwv] = nsq; red[64 + (4 * rq + j) * 4 + gwv] = cp; }
            }
            LDS_BARRIER();
            if (c > 0) SC_OUT(c - 1);
            const bf16_t rr_s[4] = {rr_[0], rr_[1], rr_[2], rr_[3]};
#pragma unroll
            for (int j = 0; j < 4; ++j) {
                const int rr = 4 * rq + j, js = dir ? 15 - rr : rr;
                const f32x4 n4 = *(const LAS f32x4*)(red + rr * 4);
                const float inv = __builtin_amdgcn_rsqf(fmaxf((n4.x + n4.y) + (n4.z + n4.w), 1e-24f));
                const float kkn = kkv[j] * inv;
                LAS float* d = cb + js * 320 + ch;
                d[0] = dec[j]; d[64] = kkn * av[j]; d[128] = kd[j]; d[192] = vv[j];
                LAS bf16_t* db = (LAS bf16_t*)(cb + js * 320 + 256) + ch;
                db[0] = (bf16_t)(pk2(-kkn, 0.f) & 0xffffu); db[64] = rr_s[j];
            }
            if (gt < 16) { const f32x4 c4 = *(const LAS f32x4*)(red + 64 + gt * 4); CDd[(size_t)(rlo + gt) * 16] = (c4.x + c4.y) + (c4.z + c4.w); }
            if (c + 1 < 144) SC_LOAD(c + 1);
            LDS_BARRIER();
            bf16x8 oa[2][2], orr[2][2]; f32x4 ow[2][4]; float ovt[2];
#define SC_OPS(P, js_) do { LAS const float* sb_ = cb + (js_) * 320; LAS const bf16_t* ab_ = (LAS const bf16_t*)(sb_ + 256) + 8 * kq; \
                oa[P][0] = *(const LAS bf16x8*)(ab_); oa[P][1] = *(const LAS bf16x8*)(ab_ + 32); orr[P][0] = *(const LAS bf16x8*)(ab_ + 64); orr[P][1] = *(const LAS bf16x8*)(ab_ + 96); \
                _Pragma("unroll") for (int s_ = 0; s_ < 2; ++s_) { LAS const float* ob2_ = sb_ + 32 * s_ + 8 * kq; ow[P][2 * s_] = *(const LAS f32x4*)(ob2_); ow[P][2 * s_ + 1] = *(const LAS f32x4*)(ob2_ + 4); } \
                ovt[P] = sb_[192 + 16 * gwv + vl]; } while (0)
            SC_OPS(0, 0);
#pragma unroll
            for (int js = 0; js < 16; ++js) {
                const int P = js & 1;
                f32x4 obv[4], odv[4];
                { LAS const float* sb_ = cb + js * 320 + 8 * kq;
#pragma unroll
                  for (int s_ = 0; s_ < 2; ++s_) { obv[2 * s_] = *(const LAS f32x4*)(sb_ + 32 * s_ + 64); obv[2 * s_ + 1] = *(const LAS f32x4*)(sb_ + 32 * s_ + 68); odv[2 * s_] = *(const LAS f32x4*)(sb_ + 32 * s_ + 128); odv[2 * s_ + 1] = *(const LAS f32x4*)(sb_ + 32 * s_ + 132); } }
                __builtin_amdgcn_sched_barrier(0);
                if (js + 1 < 16) SC_OPS(P ^ 1, js + 1);
                __builtin_amdgcn_sched_barrier(0);
                f32x4 acs = {0.f, 0.f, 0.f, 0.f};
                acs = __builtin_amdgcn_mfma_f32_16x16x32_bf16(oa[P][0], Bs[0], acs, 0, 0, 0); acs = __builtin_amdgcn_mfma_f32_16x16x32_bf16(oa[P][1], Bs[1], acs, 0, 0, 0);
                const float vt = ovt[P];
                const float sa = acs[0];
#pragma unroll
                for (int s_ = 0; s_ < 2; ++s_) {
                    const f32x4 w0 = ow[P][2 * s_], w1 = ow[P][2 * s_ + 1], b0 = obv[2 * s_], b1 = obv[2 * s_ + 1], d0 = odv[2 * s_], d1 = odv[2 * s_ + 1];
                    S2[4 * s_ + 0] = S2[4 * s_ + 0] * (f32x2){w0.x, w0.y} + ((f32x2){b0.x, b0.y} * sa + (f32x2){d0.x, d0.y} * vt);
                    S2[4 * s_ + 1] = S2[4 * s_ + 1] * (f32x2){w0.z, w0.w} + ((f32x2){b0.z, b0.w} * sa + (f32x2){d0.z, d0.w} * vt);
                    S2[4 * s_ + 2] = S2[4 * s_ + 2] * (f32x2){w1.x, w1.y} + ((f32x2){b1.x, b1.y} * sa + (f32x2){d1.x, d1.y} * vt);
                    S2[4 * s_ + 3] = S2[4 * s_ + 3] * (f32x2){w1.z, w1.w} + ((f32x2){b1.z, b1.w} * sa + (f32x2){d1.z, d1.w} * vt);
                    u32x4 pk; pk.x = pk2(S2[4 * s_ + 0].x, S2[4 * s_ + 0].y); pk.y = pk2(S2[4 * s_ + 1].x, S2[4 * s_ + 1].y); pk.z = pk2(S2[4 * s_ + 2].x, S2[4 * s_ + 2].y); pk.w = pk2(S2[4 * s_ + 3].x, S2[4 * s_ + 3].y);
                    Bs[s_] = __builtin_bit_cast(bf16x8, pk);
                }
                f32x4 acy = {0.f, 0.f, 0.f, 0.f};
                acy = __builtin_amdgcn_mfma_f32_16x16x32_bf16(orr[P][0], Bs[0], acy, 0, 0, 0); acy = __builtin_amdgcn_mfma_f32_16x16x32_bf16(orr[P][1], Bs[1], acy, 0, 0, 0);
                if (kq == 0) ybuf[js * 64 + 16 * gwv + vl] = acy[0];
                __builtin_amdgcn_sched_barrier(0);
            }
#undef SC_OPS
        }
        LDS_BARRIER();
        SC_OUT(143);
#undef SC_OUT
#undef SC_RLO
#undef SC_LOAD
        __syncthreads();
    }
}

DI void rwkv_readout(Frame& F, unsigned char* ws) {
    const bf16_t* X = (const bf16_t*)(ws + WS_ACT);
    bf16_t* G = (bf16_t*)(ws + WS_U);
    const bf16_t* Y0 = G + (size_t)MROWS * DM; const bf16_t* Y1 = (const bf16_t*)(ws + WS_Y);
    const float* CD = (const float*)(ws + WS_CD);
    const int c0 = 16 * F.lane, hd = F.lane >> 2;
    for (int row = F.gw; row < MROWS; row += F.NGW) {
        float y[16], vv[16], gg[16];
#pragma unroll
        for (int j = 0; j < 2; ++j) {
            const u32x4 a = *(const u32x4*)(Y0 + (size_t)row * DM + c0 + 8 * j), bq = *(const u32x4*)(Y1 + (size_t)row * DM + c0 + 8 * j);
            const u32x4 v4 = *(const u32x4*)(X + (size_t)row * 3584 + 2048 + c0 + 8 * j), g4 = *(const u32x4*)(G + (size_t)row * DM + c0 + 8 * j);
#pragma unroll
            for (int e = 0; e < 4; ++e) { y[8 * j + 2 * e] = bflo(a[e]) + bflo(bq[e]); y[8 * j + 2 * e + 1] = bfhi(a[e]) + bfhi(bq[e]);
                vv[8 * j + 2 * e] = bflo(v4[e]); vv[8 * j + 2 * e + 1] = bfhi(v4[e]); gg[8 * j + 2 * e] = bflo(g4[e]); gg[8 * j + 2 * e + 1] = bfhi(g4[e]); }
        }
        float s = 0.f;
#pragma unroll
        for (int i = 0; i < 16; ++i) s += y[i];
        s += __shfl_xor(s, 1); s += __shfl_xor(s, 2);
        const float mean = s * (1.f / 64.f); float q = 0.f;
#pragma unroll
        for (int i = 0; i < 16; ++i) { y[i] -= mean; q += y[i] * y[i]; }
        q += __shfl_xor(q, 1); q += __shfl_xor(q, 2);
        const float rstd = 1.f / sqrtf(q * (1.f / 64.f) + 64e-5f);
        const float cc = CD[(size_t)row * 16 + hd] + CD[((size_t)MROWS + row) * 16 + hd];
        u32x4 o[2];
#pragma unroll
        for (int j = 0; j < 2; ++j)
#pragma unroll
            for (int e = 0; e < 4; ++e) { const int i = 8 * j + 2 * e;
                const float z0 = ((y[i] * rstd) * F.in[I_RWLNG][c0 + i] + F.in[I_RWLNB][c0 + i] + cc * vv[i]) * gg[i];
                const float z1 = ((y[i + 1] * rstd) * F.in[I_RWLNG][c0 + i + 1] + F.in[I_RWLNB][c0 + i + 1] + cc * vv[i + 1]) * gg[i + 1];
                o[j][e] = pk2(z0, z1); }
        *(u32x4*)(G + (size_t)row * DM + c0) = o[0]; *(u32x4*)(G + (size_t)row * DM + c0 + 8) = o[1];
    }
}


#define XB_TMO      128
#define XB_XCNT(j)  (256  + 64 * (j))
#define XB_XSUB(j)  (1280 + 64 * (j))
#define XB_XGEN(j)  (2304 + 64 * (j))
#define XB_TOP      3328
#define XB_TOPGEN   3392
#define XCD_BAR_WORDS 3456
#define XB_SPIN_CAP (1u << 18)
DI unsigned xb_ld(unsigned* p)              { return __hip_atomic_load(p, __ATOMIC_RELAXED, __HIP_MEMORY_SCOPE_AGENT); }
DI unsigned xb_add(unsigned* p, unsigned v) { return __hip_atomic_fetch_add(p, v, __ATOMIC_RELAXED, __HIP_MEMORY_SCOPE_AGENT); }
DI unsigned xb_xcc_id() { return (unsigned)__builtin_amdgcn_s_getreg((3 << 11) | 20) & 0xFu; }
#define XB_SPIN(cond, bar) do { unsigned _sp = 0; while (cond) { __builtin_amdgcn_s_sleep(1); \
    if ((++_sp & 255u) == 0u) { if (xb_ld(&(bar)[XB_TMO])) break; if (_sp > XB_SPIN_CAP) { atomicAdd(&(bar)[XB_TMO], 1u); break; } } } } while (0)
struct XcdBarrier { unsigned* bar; unsigned x; volatile LAS unsigned* st; };
DI XcdBarrier xcd_barrier_post(unsigned* bar, volatile LAS unsigned* st) {
    XcdBarrier b; b.bar = bar; b.x = xb_xcc_id(); b.st = st;
    if (threadIdx.x == 0) (void)xb_add(&bar[XB_XCNT(b.x)], 1u);
    return b;
}
DI void xcd_barrier_complete(unsigned* bar, unsigned x, unsigned& nloc, unsigned& nx) {
    const unsigned G = gridDim.x * gridDim.y * gridDim.z;
    unsigned sum, cnt, mine, sp = 0u;
    for (;;) {
        sum = 0u; cnt = 0u; mine = 0u;
#pragma unroll
        for (unsigned j = 0; j < 16; ++j) { const unsigned c = xb_ld(&bar[XB_XCNT(j)]); sum += c; cnt += (c > 0u) ? 1u : 0u; mine = (j == x) ? c : mine; }
        if (sum == G) break;
        __builtin_amdgcn_s_sleep(1);
        if ((++sp & 255u) == 0u) { if (xb_ld(&bar[XB_TMO])) break; if (sp > XB_SPIN_CAP) { atomicAdd(&bar[XB_TMO], 1u); break; } }
    }
    nloc = mine > 0u ? mine : 1u; nx = cnt > 0u ? cnt : 1u;
}
DI void xcd_barrier(const XcdBarrier& b) {
    asm volatile("s_waitcnt vmcnt(0)" ::: "memory");
    __syncthreads();
    if (threadIdx.x == 0) {
        unsigned* bar = b.bar;
        __builtin_amdgcn_s_waitcnt(0);
        unsigned nloc = b.st[0], nx = b.st[1];
        if (nloc == 0u) { xcd_barrier_complete(bar, b.x, nloc, nx); b.st[0] = nloc; b.st[1] = nx; }
        const unsigned old = xb_add(&bar[XB_XSUB(b.x)], 1u);
        const unsigned gen = old / nloc;
        if (old + 1u == (gen + 1u) * nloc) {
            __builtin_amdgcn_fence(__ATOMIC_RELEASE, "agent");
            asm volatile("s_waitcnt vmcnt(0)" ::: "memory");
            const unsigned og = xb_add(&bar[XB_TOP], 1u);
            const unsigned tg = og / nx;
            if (og + 1u == (tg + 1u) * nx) xb_add(&bar[XB_TOPGEN], 1u);
            else XB_SPIN(xb_ld(&bar[XB_TOPGEN]) == tg, bar);
            __builtin_amdgcn_fence(__ATOMIC_ACQUIRE, "agent");
            xb_add(&bar[XB_XGEN(b.x)], 1u);
            asm volatile("s_waitcnt vmcnt(0)" ::: "memory");
        } else {
            XB_SPIN(xb_ld(&bar[XB_XGEN(b.x)]) == gen, bar);
            __builtin_amdgcn_fence(__ATOMIC_ACQUIRE, "agent");
            asm volatile("s_waitcnt vmcnt(0)" ::: "memory");
        }
    }
    __syncthreads();
}

enum { OP_RP0 = 0, OP_G1, OP_G2, OP_RP1, OP_XX, OP_RKVH, OP_GG, OP_SCAN, OP_RDOUT, OP_QKV, OP_ATT, OP_OPROJ, OP_RP2, OP_G5, OP_G6, OP_RP3, OP_END };
DI int next_op(int kind, int op) {
    switch (op) {
        case OP_RP0: return OP_G1; case OP_G1: return OP_G2; case OP_G2: return OP_RP1;
        case OP_RP1: return kind == 2 ? OP_XX : OP_QKV;
        case OP_XX: return OP_RKVH; case OP_RKVH: return OP_GG; case OP_GG: return OP_SCAN; case OP_SCAN: return OP_RDOUT; case OP_RDOUT: return OP_OPROJ;
        case OP_QKV: return OP_ATT; case OP_ATT: return OP_OPROJ; case OP_OPROJ: return OP_RP2;
        case OP_RP2: return OP_G5; case OP_G5: return OP_G6; case OP_G6: return OP_RP3; default: return OP_END;
    }
}

__global__ void __launch_bounds__(512, 2) mega(const float* i0, const float* i1, const float* i2, const float* i3, const float* i4, const float* i5, const float* i6, const float* i7, const float* i8, const float* i9, const float* i10, const float* i11, const float* i12, const float* i13, const float* i14, const float* i15, const float* i16, const float* i17, const float* i18, const float* i19, const float* i20, const float* i21, const float* i22, const float* i23, const float* i24, const float* i25, const float* i26, const float* i27, const float* i28, const float* i29, const float* i30, const float* i31, float* out, unsigned char* ws0) {
    const float* in_[32] = {i0, i1, i2, i3, i4, i5, i6, i7, i8, i9, i10, i11, i12, i13, i14, i15, i16, i17, i18, i19, i20, i21, i22, i23, i24, i25, i26, i27, i28, i29, i30, i31};
    extern __shared__ __attribute__((aligned(16))) unsigned char lds_raw[];
    cg::grid_group grid = cg::this_grid();
    Frame F;
#define BUILD_FRAME() do { int tid_ = threadIdx.x; asm volatile("" : "+v"(tid_)); int bx_ = blockIdx.x; asm volatile("" : "+s"(bx_)); \
    F.lds = (LAS unsigned char*)lds_raw; F.tid = tid_; F.lane = tid_ & 63; F.wave = __builtin_amdgcn_readfirstlane(tid_ >> 6); \
    F.G = gridDim.x; F.bx = bx_; F.vcu = (F.G % 8 == 0) ? (bx_ % 8) * (F.G / 8) + bx_ / 8 : bx_; \
    F.gw = F.vcu * 8 + F.wave; F.NGW = F.G * 8; F.in = in_; } while (0)
    BUILD_FRAME();
    unsigned char* ws = ws0;

#ifndef NO_P0
    phase0(F, ws);
#endif
    grid.sync();
    volatile LAS unsigned* bst = (volatile LAS unsigned*)(F.lds + LDS_BYTES - 64);
    if (F.tid < 2) bst[F.tid] = 0u;
    __syncthreads();
    const XcdBarrier xbar = xcd_barrier_post((unsigned*)(ws0 + WS_BAR), bst);

    for (int l = 0; l < 4; ++l) {
        const int kind = l % 3; const bool last = (l == 3);
        const float* ng = F.in[I_NORMG] + l * 6 * DM;
        int op = (l == 0) ? OP_RP0 : OP_G1;
        int sub = 0, rp_lo = 0;
        while (op != OP_END) {
            { size_t zoff = 0; asm volatile("" : "+s"(zoff)); ws = ws0 + zoff; }
            BUILD_FRAME();
            float* HC = (float*)(ws + WS_HC); bf16_t* WB = (bf16_t*)(ws + WS_WB); bf16_t* U = (bf16_t*)(ws + WS_U); bf16_t* ACT = (bf16_t*)(ws + WS_ACT); bf16_t* YB = (bf16_t*)(ws + WS_Y);
            const float* cosT = (const float*)(ws + WS_ROPE); const float* sinT = cosT + 1024;
            int rpop = -1, rlo = 0, rhi = MROWS, rwidx = F.gw, rnw = F.NGW; bool fill = false;
            if (op == OP_G1 || op == OP_G2 || op == OP_G5 || op == OP_G6 || op == OP_QKV || op == OP_RKVH || op == OP_GG || op == OP_OPROJ) {
                pg8::Gemm g; pg8::Epi E; E.cosT = cosT; E.sinT = sinT; int skip = 0;
                if (op == OP_G1 || op == OP_G5) { g.A = U; g.lda = 1024; g.Bt = WB + (op == OP_G1 ? WB_IN0 : WB_IN1); g.ldb = 1024; g.N = 5632; g.K = 1024; E.mode = pg8::EPI_SWIGLU; E.O = ACT; E.ldc = FF; skip = (last && op == OP_G5); }
                else if (op == OP_G2 || op == OP_G6) { g.A = ACT; g.lda = FF; g.Bt = WB + (op == OP_G2 ? WB_OUT0 : WB_OUT1); g.ldb = FF; g.N = 1024; g.K = FF; E.mode = pg8::EPI_PLAIN; E.O = YB; E.ldc = 1024; skip = (last && op == OP_G6); }
                else if (op == OP_QKV) { g.A = U; g.lda = 1024; g.Bt = WB + WB_MIXIN; g.ldb = 1024; g.N = 3072; g.K = 1024; E.mode = kind == 0 ? pg8::EPI_QKV_DA : pg8::EPI_QKV_NA; E.O = ACT; E.ldc = 3072; }
                else if (op == OP_RKVH) { g.A = U; g.lda = 2048; g.Bt = WB + WB_MIXIN; g.ldb = 2048; g.N = 3584; g.K = 2048; E.mode = pg8::EPI_RWKV; E.O = ACT; E.ldc = 3584; }
                else if (op == OP_GG) { g.A = ACT + 3328; g.lda = 3584; g.Bt = WB + WB_G2T; g.ldb = 256; g.N = 1024; g.K = 256; E.mode = pg8::EPI_PLAIN; E.O = U; E.ldc = 1024; }
                else { g.A = U; g.lda = 1024; g.Bt = WB + WB_MIXOUT; g.ldb = 1024; g.N = 1024; g.K = 1024; E.mode = pg8::EPI_PLAIN; E.O = YB; E.ldc = 1024; skip = last; }
                g.nM = skip ? 128 : 144; g.skip = skip;
                pg8::StaticOrder S; S.init(g.nM, g.N, F.G, F.bx, skip);
                fill = (op == OP_G2 || op == OP_G6 || op == OP_OPROJ) && !skip && F.G == 256;
                if (fill) { S.pmode = 1; S.r0 = sub ? 2 : 0; S.nr = sub ? 1 : 2;
                    if (sub == 1 && F.bx >= 64) { rpop = (op == OP_G2) ? OP_RP1 : (op == OP_G6 ? OP_RP3 : OP_RP2); rlo = 0; rhi = 128 * 256; rwidx = (F.bx - 64) * 8 + F.wave; rnw = 192 * 8; } }
#ifndef NO_GEMM
                pg8::gemm_phase(F.lds, F.tid, g, S, E);
#endif
            } else if (op == OP_RP0 || op == OP_RP1 || op == OP_RP2 || op == OP_RP3) { rpop = op; rlo = rp_lo; }
            if (rpop >= 0) {
                RowPass P;
                P.hsrc_lat = out; P.hsrc_ctx = HC; P.hdst_lat = out; P.hdst_ctx = HC; P.U = U; P.ldu = 1024; P.skip_ctx = 0; P.lpost = l; P.lpre = l;
                if (rpop == OP_RP0) { P.hsrc_lat = F.in[I_X]; P.hsrc_ctx = F.in[I_CTX]; P.hdst_lat = (float*)F.in[I_X]; P.hdst_ctx = (float*)F.in[I_CTX];   P.Y = nullptr; P.gpost = ng; P.gate_idx = 0; P.coef = 0.f; P.gpre = ng; P.shift_idx = 0; }
                else if (rpop == OP_RP1) { if (l == 0) { P.hsrc_lat = F.in[I_X]; P.hsrc_ctx = F.in[I_CTX]; } P.Y = YB; P.gpost = ng + DM; P.gate_idx = 2; P.coef = 0.5f; P.gpre = ng + 2 * DM; P.shift_idx = 3; P.ldu = (kind == 2) ? 2048 : 1024; }
                else if (rpop == OP_RP2) { P.Y = YB; P.gpost = ng + 3 * DM; P.gate_idx = 5; P.coef = 1.f; P.gpre = ng + 4 * DM; P.shift_idx = 6; P.skip_ctx = last; }
                else { P.Y = YB; P.gpost = ng + 5 * DM; P.gate_idx = 8; P.coef = 0.5f; P.gpre = last ? nullptr : ng + 6 * DM; P.shift_idx = 0; P.lpre = l + 1; P.skip_ctx = last; }
#ifndef NO_RP
                row_pass(F, ws, P, rlo, rhi, rwidx, rnw);
#endif
#ifndef NO_CONV
                if (op == OP_RP3 && !last) { __syncthreads(); convert_layer(F, ws, l + 1); }
#endif
            }
#ifndef NO_XX
            if (op == OP_XX) { xx_pass(F, ws); }
#endif

#ifndef NO_SCAN
            if (op == OP_SCAN) { rwkv_scan(F, ws); }
#endif

#ifndef NO_RDOUT
            if (op == OP_RDOUT) { rwkv_readout(F, ws); }
#endif

#ifndef NO_ATT
            if (op == OP_ATT) {
#ifndef NO_DA
 if (kind == 0) da_phase(F, ws, l);
#endif
#ifndef NO_NA
 if (kind == 1) na_phase(F, ws);
#endif
 }
#endif
            xcd_barrier(xbar);
            if (fill) { if (sub == 0) { sub = 1; continue; } sub = 0; rp_lo = 128 * 256; }
            else if (rpop >= 0) rp_lo = 0;
            op = next_op(kind, op);
        }
    }
}

extern "C" void kernel_launch(void* const* d_in, const int* in_sizes, int n_in, void* d_out, int out_size,
                              void* d_ws, size_t ws_size, hipStream_t stream) {
    static int grid = 0;
    if (grid == 0) {
        if (n_in != 32 || ws_size < WS_END) { fprintf(stderr, "kernel_launch: need 32 inputs and %zu B of workspace; got %d, %zu\n", (size_t)WS_END, n_in, ws_size); grid = -1; return; }
        int dev = 0, cus = 0, per_cu = 0;
        (void)hipGetDevice(&dev);
        (void)hipDeviceGetAttribute(&cus, hipDeviceAttributeMultiprocessorCount, dev);
        (void)hipFuncSetAttribute((const void*)mega, hipFuncAttributeMaxDynamicSharedMemorySize, LDS_BYTES);
        (void)hipOccupancyMaxActiveBlocksPerMultiprocessor(&per_cu, (const void*)mega, 512, LDS_BYTES);
        if (per_cu < 1) per_cu = 1;
        grid = cus * per_cu;
    }
    if (grid < 0) return;
    const float* inp[32]; for (int i = 0; i < 32; ++i) inp[i] = (const float*)d_in[i];
    float* outp = (float*)d_out; unsigned char* wsp = (unsigned char*)d_ws;
    void* kargs[34]; for (int i = 0; i < 32; ++i) kargs[i] = (void*)&inp[i];
    kargs[32] = (void*)&outp; kargs[33] = (void*)&wsp;
    hipError_t e = hipLaunchCooperativeKernel((const void*)mega, dim3(grid), dim3(512), kargs, LDS_BYTES, stream);
    if (e != hipSuccess) fprintf(stderr, "cooperative launch failed: %s (grid %d)\n", hipGetErrorString(e), grid);
}
```

```cpp
#include <hip/hip_runtime.h>
#include <hip/hip_cooperative_groups.h>
#include <cstdio>
#include <cstdint>
namespace cg = cooperative_groups;
#ifndef REP_MASK
#define REP_MASK 0
#endif

#define LAS __attribute__((address_space(3)))
#define DI __device__ __forceinline__
typedef unsigned short bf16_t;
typedef short bf16x8 __attribute__((ext_vector_type(8)));
typedef short s16x4 __attribute__((ext_vector_type(4)));
typedef float f32x2 __attribute__((ext_vector_type(2)));
typedef float f32x4 __attribute__((ext_vector_type(4)));
typedef float f32x16 __attribute__((ext_vector_type(16)));
typedef unsigned u32x4 __attribute__((ext_vector_type(4)));
typedef unsigned u32x2 __attribute__((ext_vector_type(2)));
typedef __bf16 bf2_t __attribute__((ext_vector_type(2)));

constexpr int DM = 1024, NB = 16, SEQ = 2048, CTX = 256, LROW = 2304, MROWS = NB * LROW, FF = 2816, NMOD = 9216;
constexpr float NORM_EPS = 1e-6f;
constexpr float LOG2E = 1.4426950408889634f;
constexpr float QSCALE = 0.125f * LOG2E;

constexpr size_t MiB = 1u << 20;
constexpr size_t WS_MOD = 0, WS_ROPE = 3 * MiB, WS_LAM = 3 * MiB + 16384, WS_BAR = 3 * MiB + 32768, WS_CD = 4 * MiB, WS_HC = 9 * MiB, WS_WB = 25 * MiB,
                 WS_U = 75 * MiB, WS_ACT = 219 * MiB, WS_Y = 471 * MiB, WS_END = 543 * MiB;
constexpr size_t WB_IN0 = 0, WB_OUT0 = 5767168, WB_IN1 = 8650752, WB_OUT1 = 14417920, WB_MIXIN = 17301504, WB_MIXOUT = 24641536, WB_G2T = 25690112;
constexpr int LDS_BYTES = 147456;

DI unsigned pk2(float lo, float hi) { f32x2 v = {lo, hi}; bf2_t b = __builtin_convertvector(v, bf2_t); return __builtin_bit_cast(unsigned, b); }
DI float bf2f(bf16_t h) { return __uint_as_float(((unsigned)h) << 16); }
DI float bflo(unsigned w) { return __uint_as_float(w << 16); }
DI float bfhi(unsigned w) { return __uint_as_float(w & 0xffff0000u); }
DI float wave_sum(float v) {
#pragma unroll
    for (int o = 1; o < 64; o <<= 1) v += __shfl_xor(v, o);
    return v;
}
#define LDS_BARRIER() asm volatile("s_waitcnt lgkmcnt(0)\n\ts_barrier" ::: "memory")
DI float fast_exp(float x) { return __builtin_amdgcn_exp2f(x * LOG2E); }
DI float sigmoidf_(float x) { return __builtin_amdgcn_rcpf(1.f + fast_exp(-x)); }
DI float siluf_(float x) { return x * sigmoidf_(x); }
DI float tanhf_(float x) { return 1.f - 2.f * __builtin_amdgcn_rcpf(1.f + fast_exp(2.f * x)); }

namespace pg8 {
constexpr int BM = 256, BK = 64, HALF = 128, HTB = HALF * BK * 2, NXCD = 8, WGM = 4;
__host__ __device__ __forceinline__ int lds_byte(int r, int c) { const int st = (r >> 4) * 2 + (c >> 5), rr = r & 15, cc = c & 31, ob = rr * 64 + cc * 2; return st * 1024 + (ob ^ (((ob >> 9) & 1) << 5)); }
__host__ __device__ __forceinline__ void stage_rc(int b, int& R, int& C) { const int st = b / 1024, sb = b % 1024, swz = sb ^ (((sb >> 9) & 1) << 5); R = (st >> 1) * 16 + swz / 64; C = (st & 1) * 32 + (swz % 64) / 2; }
__host__ __device__ __forceinline__ int perm32(int rho) { const int n = rho >> 4, i = rho & 15; return 8 * (i >> 2) + 4 * n + (i & 3); }

struct Unit { int pm, pn; };
struct Gemm { const bf16_t* A; const bf16_t* Bt; int lda, ldb, N, K, nM, skip; };

struct StaticOrder {
    int nM, nN, nwg, G, c, skip;
    int pmode, r0, nr;
    DI void init(int nM_, int N, int G_, int c_, int skip_) { nM = nM_; nN = N / BM; nwg = nM * nN; G = G_; c = c_; skip = skip_; pmode = 0; r0 = 0; nr = 0; }
    DI bool next(int i, Unit& u) const {
        if (pmode) {
            if (i >= nr) return false;
            const int round = r0 + i, xcd = c & 7, j = c >> 3, full = nM >> 6; int panel;
            if (round < full) { panel = round * 64 + xcd * 8 + (j & 7); u.pn = j >> 3; }
            else { if (j >= 8) return false; panel = full * 64 + 2 * xcd + (j & 1); u.pn = j >> 1; if (panel >= nM) return false; }
            u.pm = skip ? (panel + panel / 8 + 1) : panel;
            return true;
        }
        const long L = (long)i * G + c; if (L >= nwg) return false;
        int wgid = (int)L; { const int q = nwg / NXCD, r = nwg % NXCD, xcd = wgid % NXCD, off = wgid / NXCD; wgid = (xcd < r ? xcd * (q + 1) : r * (q + 1) + (xcd - r) * q) + off; }
        const int nig = WGM * nN, gid = wgid / nig, fm = gid * WGM, gsz = (nM - fm) < WGM ? (nM - fm) : WGM;
        int pm = fm + ((wgid % nig) % gsz); u.pn = (wgid % nig) / gsz;
        u.pm = skip ? (pm + pm / 8 + 1) : pm;
        return true;
    }
};

enum { EPI_PLAIN = 0, EPI_SWIGLU = 1, EPI_QKV_DA = 2, EPI_QKV_NA = 3, EPI_RWKV = 4 };
struct Epi {
    static constexpr bool PERM = true;
    int mode; bf16_t* O; int ldc; const float* cosT; const float* sinT;
    DI void operator()(const f32x4 (&acc)[2][2][4][2], const Unit& u, int wr, int wc, int fr, int fq) const {
        const int row0 = u.pm * BM + wr * 64 + fr;
        if (mode == EPI_SWIGLU) {
            const int col0 = u.pn * 128 + wc * 32 + 8 * fq;
#pragma unroll
            for (int ai = 0; ai < 2; ++ai)
#pragma unroll
                for (int m = 0; m < 4; ++m) {
                    bf16_t* rowp = O + (size_t)(row0 + ai * HALF + m * 16) * ldc + col0;
                    const f32x4 a0 = acc[ai][0][m][0], a1 = acc[ai][0][m][1], b0 = acc[ai][1][m][0], b1 = acc[ai][1][m][1];
                    u32x4 w;
                    w.x = pk2(siluf_(a0[0]) * b0[0], siluf_(a0[1]) * b0[1]); w.y = pk2(siluf_(a0[2]) * b0[2], siluf_(a0[3]) * b0[3]);
                    w.z = pk2(siluf_(a1[0]) * b1[0], siluf_(a1[1]) * b1[1]); w.w = pk2(siluf_(a1[2]) * b1[2], siluf_(a1[3]) * b1[3]);
                    *(u32x4*)rowp = w;
                }
        } else {
            const int col0 = u.pn * BM + wc * 32 + 8 * fq;
            const int jt = u.pm % 9;
            float sc = 1.f; bool rope = false; int act0 = 0, act1 = 0;
            if (mode == EPI_QKV_DA) { if (u.pn < 4) sc = QSCALE; if (u.pn < 8 && jt != 0) rope = true; }
            else if (mode == EPI_QKV_NA) { if (u.pn < 4) sc = QSCALE; }
            else if (mode == EPI_RWKV) { if (u.pn == 12) act0 = 1; if (u.pn == 13) { act0 = 2; act1 = 2; } }
#pragma unroll
            for (int ai = 0; ai < 2; ++ai)
#pragma unroll
                for (int m = 0; m < 4; ++m) {
                    bf16_t* rowp = O + (size_t)(row0 + ai * HALF + m * 16) * ldc + col0;
                    f32x4 c0 = {1.f, 1.f, 1.f, 1.f}, c1 = c0, s0 = {0.f, 0.f, 0.f, 0.f}, s1 = s0;
                    if (rope) {
                        const int t = (jt - 1) * 256 + ai * HALF + wr * 64 + m * 16 + fr;
                        const int pos = (wc & 1) ? (t & 63) : (t >> 6);
                        const float* cp = cosT + pos * 16 + 8 * (fq & 1); const float* sp = sinT + pos * 16 + 8 * (fq & 1);
                        c0 = *(const f32x4*)cp; c1 = *(const f32x4*)(cp + 4); s0 = *(const f32x4*)sp; s1 = *(const f32x4*)(sp + 4);
                        if (!(fq & 2)) { s0 = -s0; s1 = -s1; }
                    }
#pragma unroll
                    for (int bj = 0; bj < 2; ++bj) {
                        f32x4 v0 = acc[ai][bj][m][0], v1 = acc[ai][bj][m][1];
                        if (rope) {
                            f32x4 p0, p1;
#pragma unroll
                            for (int e = 0; e < 4; ++e) { p0[e] = __shfl_xor(v0[e], 32); p1[e] = __shfl_xor(v1[e], 32); }
                            v0 = v0 * c0 + p0 * s0; v1 = v1 * c1 + p1 * s1;
                        }
                        v0 = v0 * sc; v1 = v1 * sc;
                        const int act = bj ? act1 : act0;
                        if (act == 1) {
#pragma unroll
                            for (int e = 0; e < 4; ++e) { v0[e] = tanhf_(v0[e]); v1[e] = tanhf_(v1[e]); }
                        } else if (act == 2) {
#pragma unroll
                            for (int e = 0; e < 4; ++e) { v0[e] = sigmoidf_(v0[e]); v1[e] = sigmoidf_(v1[e]); }
                        }
                        u32x4 w; w.x = pk2(v0[0], v0[1]); w.y = pk2(v0[2], v0[3]); w.z = pk2(v1[0], v1[1]); w.w = pk2(v1[2], v1[3]);
                        *(u32x4*)(rowp + bj * HALF) = w;
                    }
                }
        }
    }
};

DI void gemm_phase(LAS unsigned char* lds, const int tid, const Gemm g, const StaticOrder& S, const Epi& E) {
    const int wid = __builtin_amdgcn_readfirstlane(tid >> 6), lane = tid & 63, wr = wid >> 2, wc = wid & 3, fr = lane & 15, fq = lane >> 4;
    const int K = g.K, nt = K / BK;
    unsigned voffA[2], voffB[2];
#pragma unroll
    for (int i = 0; i < 2; ++i) { int R, C; stage_rc(tid * 16 + i * 8192, R, C); const int Rb = (R & ~31) + perm32(R & 31);
        voffA[i] = (unsigned)(R * g.lda + C) * 2u; voffB[i] = (unsigned)(Rb * g.ldb + C) * 2u; }
    const size_t kstep = (size_t)(BK * 2);
    const size_t hstepA = (size_t)HALF * g.lda * 2, hstepB = (size_t)HALF * g.ldb * 2;
    const size_t tstepA = 2 * hstepA, tstepB = 2 * hstepB;
    const unsigned ldsw = (unsigned)wid * 1024u;
    const int aoff = lds_byte(wr * 64 + fr, fq * 8), boff = lds_byte(wc * 32 + fr, fq * 8);
#define PG8_SA(b, h) (((b) * 2 + (h)) * HTB)
#define PG8_SB(b, h) ((4 + (b) * 2 + (h)) * HTB)
#define PG8_STAGE(bufoff, gbase, voff) do { _Pragma("unroll") for (int _i = 0; _i < 2; ++_i) \
        __builtin_amdgcn_global_load_lds((const unsigned*)((const char*)(gbase) + (voff)[_i]), (LAS unsigned*)(lds + (bufoff) + ldsw + _i * 8192), 16, 0, 0); } while (0)
#define PG8_LDA(dst, b, h) do { _Pragma("unroll") for (int m = 0; m < 4; ++m) _Pragma("unroll") for (int k = 0; k < 2; ++k) dst[m][k] = *(const LAS bf16x8*)(lds + PG8_SA(b, h) + aoff + m * 2048 + k * 1024); } while (0)
#define PG8_LDB(dst, b, h) do { _Pragma("unroll") for (int n = 0; n < 2; ++n) _Pragma("unroll") for (int k = 0; k < 2; ++k) dst[n][k] = *(const LAS bf16x8*)(lds + PG8_SB(b, h) + boff + n * 2048 + k * 1024); } while (0)
#define PG8_MMA(ai, bj, At, Bt) do { __builtin_amdgcn_s_setprio(1); _Pragma("unroll") for (int m = 0; m < 4; ++m) _Pragma("unroll") for (int n = 0; n < 2; ++n) _Pragma("unroll") for (int k = 0; k < 2; ++k) \
        acc[ai][bj][m][n] = __builtin_amdgcn_mfma_f32_16x16x32_bf16(Bt[n][k], At[m][k], acc[ai][bj][m][n], 0, 0, 0); __builtin_amdgcn_s_setprio(0); } while (0)
#define PG8_WAIT_V(n) asm volatile("s_waitcnt vmcnt(" #n ")" ::: "memory")
#define PG8_WAIT_L(n) asm volatile("s_waitcnt lgkmcnt(" #n ")" ::: "memory")
#define PG8_BAR __builtin_amdgcn_s_barrier()
#define PG8_SCHED __builtin_amdgcn_sched_barrier(0)
    Unit cur, nxt; int ui = 0;
    if (!S.next(0, cur)) return;
    f32x4 acc[2][2][4][2];
#pragma unroll
    for (int a = 0; a < 2; ++a)
#pragma unroll
        for (int b = 0; b < 2; ++b)
#pragma unroll
            for (int m = 0; m < 4; ++m)
#pragma unroll
                for (int n = 0; n < 2; ++n) acc[a][b][m][n] = (f32x4){0.f, 0.f, 0.f, 0.f};
    bf16x8 At[4][2], B0[2][2], B1[2][2];
    const char* cA = (const char*)g.A + (size_t)cur.pm * tstepA; const char* cB = (const char*)g.Bt + (size_t)cur.pn * tstepB;
    PG8_STAGE(PG8_SB(0, 0), cB, voffB); PG8_STAGE(PG8_SB(0, 1), cB + hstepB, voffB); PG8_STAGE(PG8_SA(0, 0), cA, voffA); PG8_STAGE(PG8_SA(0, 1), cA + hstepA, voffA);
    if (wr == 1) PG8_BAR;
    PG8_WAIT_V(2); PG8_BAR;
    PG8_STAGE(PG8_SB(1, 0), cB + kstep, voffB); PG8_STAGE(PG8_SA(1, 0), cA + kstep, voffA); PG8_STAGE(PG8_SB(1, 1), cB + hstepB + kstep, voffB);
    PG8_WAIT_V(6); PG8_BAR;
    for (;;) {
        const bool has_next = S.next(ui + 1, nxt);
        const char* nA = has_next ? (const char*)g.A + (size_t)nxt.pm * tstepA : cA; const char* nB = has_next ? (const char*)g.Bt + (size_t)nxt.pn * tstepB : cB;
        for (int t = 0; t < nt; t += 2) {
            const bool last = (t == nt - 2);
            const char* a1 = cA + (size_t)(t + 1) * kstep;
            const char* a2 = last ? nA : cA + (size_t)(t + 2) * kstep; const char* b2 = last ? nB : cB + (size_t)(t + 2) * kstep;
            const char* a3 = a2 + kstep; const char* b3 = b2 + kstep;
            PG8_LDB(B0, 0, 0); PG8_LDB(B1, 0, 1); PG8_SCHED; PG8_LDA(At, 0, 0); PG8_STAGE(PG8_SA(1, 1), a1 + hstepA, voffA);
            PG8_WAIT_V(8); PG8_WAIT_L(0); PG8_BAR; PG8_MMA(0, 0, At, B0); PG8_MMA(0, 1, At, B1); PG8_BAR; PG8_SCHED;
            PG8_LDA(At, 0, 1); PG8_STAGE(PG8_SB(0, 0), b2, voffB); PG8_STAGE(PG8_SB(0, 1), b2 + hstepB, voffB); PG8_STAGE(PG8_SA(0, 0), a2, voffA);
            PG8_WAIT_V(8); PG8_WAIT_L(0); PG8_BAR; PG8_MMA(1, 0, At, B0); PG8_MMA(1, 1, At, B1); PG8_BAR; PG8_SCHED;
            PG8_LDB(B0, 1, 0); PG8_LDB(B1, 1, 1); PG8_SCHED; PG8_LDA(At, 1, 0); PG8_STAGE(PG8_SA(0, 1), a2 + hstepA, voffA);
            PG8_WAIT_V(8); PG8_WAIT_L(0); PG8_BAR; PG8_MMA(0, 0, At, B0); PG8_MMA(0, 1, At, B1); PG8_BAR; PG8_SCHED;
            PG8_LDA(At, 1, 1); PG8_STAGE(PG8_SB(1, 0), b3, voffB); PG8_STAGE(PG8_SB(1, 1), b3 + hstepB, voffB); PG8_STAGE(PG8_SA(1, 0), a3, voffA);
            PG8_WAIT_V(8); PG8_WAIT_L(0); PG8_BAR; PG8_MMA(1, 0, At, B0); PG8_MMA(1, 1, At, B1); PG8_BAR; PG8_SCHED;
        }
        if (wr == 0) PG8_BAR;
        E(acc, cur, wr, wc, fr, fq);
        if (!has_next) break;
#pragma unroll
        for (int a = 0; a < 2; ++a)
#pragma unroll
            for (int b = 0; b < 2; ++b)
#pragma unroll
                for (int m = 0; m < 4; ++m)
#pragma unroll
                    for (int n = 0; n < 2; ++n) acc[a][b][m][n] = (f32x4){0.f, 0.f, 0.f, 0.f};
        cur = nxt; cA = nA; cB = nB; ++ui;
        if (wr == 1) PG8_BAR;
    }
    PG8_WAIT_V(0);
    PG8_BAR;
#undef PG8_SA
#undef PG8_SB
#undef PG8_STAGE
#undef PG8_LDA
#undef PG8_LDB
#undef PG8_MMA
#undef PG8_WAIT_V
#undef PG8_WAIT_L
#undef PG8_BAR
#undef PG8_SCHED
}
}

struct Args { const float* in[32]; float* out; unsigned char* ws; };

struct Frame {
    LAS unsigned char* lds;
    int tid, lane, wave, vcu, G, gw, NGW, bx;
    const float* const* in;
};
enum { I_X = 0, I_C, I_CTX, I_CCTX, I_ADAW, I_ADAB, I_NORMG, I_FWIN, I_FWOUT, I_DAWIN, I_DAWOUT, I_DALAM, I_DASUB, I_NAWIN, I_NAWOUT, I_NARPB,
       I_RWMU, I_RWWIN, I_RWWOUT, I_RWW0, I_RWW1, I_RWW2, I_RWA0, I_RWA1, I_RWA2, I_RWG1, I_RWG2, I_RWKK, I_RWKA, I_RWRK, I_RWLNG, I_RWLNB };

DI void conv_item(const float* W, int ldw, int k0, int n0, int kmax, const float* mu, bf16_t* dst, int ldd, int dst_row0, int dst_k0, LAS float* scr, int lane) {
    float cv[32];
#pragma unroll
    for (int i = 0; i < 32; ++i) { const int k = k0 + 2 * i + (lane >> 5); cv[i] = (k < kmax) ? W[(size_t)k * ldw + n0 + (lane & 31)] : 0.f; }
    if (mu) {
#pragma unroll
        for (int i = 0; i < 32; ++i) { const int k = k0 + 2 * i + (lane >> 5); cv[i] *= (k < kmax) ? mu[k] : 0.f; }
    }
#pragma unroll
    for (int i = 0; i < 32; ++i) scr[(2 * i + (lane >> 5)) * 33 + (lane & 31)] = cv[i];
    asm volatile("s_waitcnt lgkmcnt(0)" ::: "memory");
    const int c = lane & 7;
#pragma unroll
    for (int j = 0; j < 4; ++j) { const int n = (lane >> 3) + 8 * j; const LAS float* s = scr + (8 * c) * 33 + n;
        u32x4 o; o.x = pk2(s[0 * 33], s[1 * 33]); o.y = pk2(s[2 * 33], s[3 * 33]); o.z = pk2(s[4 * 33], s[5 * 33]); o.w = pk2(s[6 * 33], s[7 * 33]);
        *(u32x4*)(dst + (size_t)(dst_row0 + n) * ldd + dst_k0 + k0 + 8 * c) = o; }
    asm volatile("s_waitcnt lgkmcnt(0)" ::: "memory");
}

DI void convert_layer(Frame& F, unsigned char* ws, int l) {
    bf16_t* WB = (bf16_t*)(ws + WS_WB);
    LAS float* scr = (LAS float*)(F.lds + F.wave * 16384);
    const int kind = l % 3, slot = l / 3;
    constexpr int I_FIN = 16 * 176, I_FOUT = 44 * 32, I_MIN = 16 * 96, I_MOUT = 16 * 32;
    const float* fwin = F.in[I_FWIN] + (size_t)l * 2 * 1024 * 5632;
    const float* fwout = F.in[I_FWOUT] + (size_t)l * 2 * 2816 * 1024;
    int nitems = 2 * I_FIN + 2 * I_FOUT + I_MOUT;
    if (kind == 2) nitems += 2 * I_MIN + 4 * 16 * 2 * 2 + 16 * 5 * 2 + 4 * 32 + 96;
    else nitems += I_MIN;
    for (int it = F.gw; it < nitems; it += F.NGW) {
        int r = it;
        if (r < 2 * I_FIN) { const int s = r / I_FIN; r -= s * I_FIN; const int kb = r / 176, nb = r % 176, n0 = nb * 32;
            const int hf = n0 / 2816, rem = n0 % 2816, p = rem / 128, i = rem % 128;
            conv_item(fwin + (size_t)s * 1024 * 5632, 5632, kb * 64, n0, 1024, nullptr, WB + (s ? WB_IN1 : WB_IN0), 1024, p * 256 + hf * 128 + i, 0, scr, F.lane); continue; }
        r -= 2 * I_FIN;
        if (r < 2 * I_FOUT) { const int s = r / I_FOUT; r -= s * I_FOUT; const int kb = r / 32, nb = r % 32;
            conv_item(fwout + (size_t)s * 2816 * 1024, 1024, kb * 64, nb * 32, 2816, nullptr, WB + (s ? WB_OUT1 : WB_OUT0), 2816, nb * 32, 0, scr, F.lane); continue; }
        r -= 2 * I_FOUT;
        if (r < I_MOUT) { const float* w = kind == 0 ? F.in[I_DAWOUT] + (size_t)slot * 1024 * 1024 : kind == 1 ? F.in[I_NAWOUT] : F.in[I_RWWOUT];
            const int kb = r / 32, nb = r % 32;
            conv_item(w, 1024, kb * 64, nb * 32, 1024, nullptr, WB + WB_MIXOUT, 1024, nb * 32, 0, scr, F.lane); continue; }
        r -= I_MOUT;
        if (kind != 2) { const float* w = kind == 0 ? F.in[I_DAWIN] + (size_t)slot * 1024 * 3072 : F.in[I_NAWIN];
            const int kb = r / 96, nb = r % 96;
            conv_item(w, 3072, kb * 64, nb * 32, 1024, nullptr, WB + WB_MIXIN, 1024, nb * 32, 0, scr, F.lane); continue; }
        const float* mu = F.in[I_RWMU];
        if (r < 2 * I_MIN) { const int var = r / I_MIN; r -= var * I_MIN; const int kb = r / 96, nb = r % 96, n0 = nb * 32;
            const int mj = n0 < 1024 ? 0 : (n0 < 2048 ? 2 : 3);
            conv_item(F.in[I_RWWIN], 3072, kb * 64, n0, 1024, var ? mu + mj * 1024 : nullptr, WB + WB_MIXIN, 2048, n0, var * 1024, scr, F.lane); continue; }
        r -= 2 * I_MIN;
        if (r < 4 * 16 * 2 * 2) { const int var = r & 1; r >>= 1; const int nb = r & 1; r >>= 1; const int kb = r & 15; r >>= 4; const int dir = r & 1, isa = r >> 1;
            const float* w = (isa ? F.in[I_RWA1] : F.in[I_RWW1]) + (size_t)dir * 1024 * 64;
            conv_item(w, 64, kb * 64, nb * 32, 1024, var ? mu + (isa ? 4 : 1) * 1024 : nullptr, WB + WB_MIXIN, 2048, (isa ? 3200 : 3072) + dir * 64 + nb * 32, var * 1024, scr, F.lane); continue; }
        r -= 4 * 16 * 2 * 2;
        if (r < 16 * 5 * 2) { const int var = r & 1; r >>= 1; const int nb = r % 5, kb = r / 5;
            conv_item(F.in[I_RWG1], 160, kb * 64, nb * 32, 1024, var ? mu + 5 * 1024 : nullptr, WB + WB_MIXIN, 2048, 3328 + nb * 32, var * 1024, scr, F.lane); continue; }
        r -= 16 * 5 * 2;
        if (r < 4 * 32) { const int kb = r / 32, nb = r % 32;
            conv_item(F.in[I_RWG2], 1024, kb * 64, nb * 32, 160, nullptr, WB + WB_G2T, 256, nb * 32, 0, scr, F.lane); continue; }
        r -= 4 * 32;
        { bf16_t* z = WB + WB_MIXIN + (size_t)(3488 + r) * 2048;
#pragma unroll
          for (int j = 0; j < 4; ++j) *(u32x4*)(z + (j * 64 + F.lane) * 8) = (u32x4){0u, 0u, 0u, 0u}; }
    }
}

DI void phase0(Frame& F, unsigned char* ws) {
    LAS float* sl = (LAS float*)F.lds;
    LAS float* part = (LAS float*)(F.lds + 69632);
    float* MOD = (float*)(ws + WS_MOD);
    for (int i = F.tid; i < 17 * 1024; i += 512) { const float v = i < 16384 ? F.in[I_C][i] : F.in[I_CCTX][i - 16384]; sl[i] = v / (1.f + expf(-v)); }
    __syncthreads();
    for (int item = F.vcu; item < 4 * 72; item += F.G) {
        const int l = item / 72, n0 = (item % 72) * 128;
        const float* W = F.in[I_ADAW] + (size_t)l * 1024 * NMOD + n0 + 2 * F.lane;
        float acc[17][2];
#pragma unroll
        for (int r = 0; r < 17; ++r) { acc[r][0] = 0.f; acc[r][1] = 0.f; }
        const int kbase = F.wave * 128;
        f32x2 wn[16];
#pragma unroll
        for (int e = 0; e < 16; ++e) wn[e] = *(const f32x2*)(W + (size_t)(kbase + e) * NMOD);
        for (int k16 = 0; k16 < 128; k16 += 16) {
            f32x2 w[16];
#pragma unroll
            for (int e = 0; e < 16; ++e) w[e] = wn[e];
            if (k16 + 16 < 128) {
#pragma unroll
                for (int e = 0; e < 16; ++e) wn[e] = *(const f32x2*)(W + (size_t)(kbase + k16 + 16 + e) * NMOD);
            }
#pragma unroll
            for (int q = 0; q < 4; ++q)
#pragma unroll
                for (int r = 0; r < 17; ++r) { const f32x4 s = *(const LAS f32x4*)(sl + r * 1024 + kbase + k16 + 4 * q);
#pragma unroll
                    for (int e = 0; e < 4; ++e) { acc[r][0] += s[e] * w[4 * q + e].x; acc[r][1] += s[e] * w[4 * q + e].y; } }
        }
#pragma unroll
        for (int r = 0; r < 17; ++r) *(LAS f32x2*)(part + (F.wave * 17 + r) * 128 + 2 * F.lane) = (f32x2){acc[r][0], acc[r][1]};
        __syncthreads();
        for (int idx = F.tid; idx < 17 * 128; idx += 512) { const int r = idx >> 7, cI = idx & 127; float s = 0.f;
#pragma unroll
            for (int w = 0; w < 8; ++w) s += part[(w * 17 + r) * 128 + cI];
            MOD[((size_t)l * 17 + r) * NMOD + n0 + cI] = s + F.in[I_ADAB][(size_t)l * NMOD + n0 + cI]; }
        __syncthreads();
    }
    if (F.bx == 0) {
        for (int i = F.tid; i < 3456; i += 512) ((unsigned*)(ws + WS_BAR))[i] = 0u;
        float* cosT = (float*)(ws + WS_ROPE); float* sinT = cosT + 1024;
        for (int i = F.tid; i < 1024; i += 512) { const int pos = i >> 4, p = i & 15; const float fr = powf(10000.f, -(float)p / 16.f); const float ang = (float)pos * fr; cosT[i] = cosf(ang); sinT[i] = sinf(ang); }
        if (F.tid < 2) { const float* lv = F.in[I_DALAM] + F.tid * 256; float d0 = 0.f, d1 = 0.f;
            for (int i = 0; i < 64; ++i) { d0 += lv[i] * lv[64 + i]; d1 += lv[128 + i] * lv[192 + i]; }
            const float li = 0.8f - 0.6f * expf(-0.3f * (float)(F.tid * 3));
            float* lam = (float*)(ws + WS_LAM); lam[2 * F.tid] = expf(d0) - expf(d1) + li; lam[2 * F.tid + 1] = li; }
    }
    __syncthreads();
    convert_layer(F, ws, 0);
}

struct RowPass {
    const float* hsrc_lat; const float* hsrc_ctx; float* hdst_lat; float* hdst_ctx;
    const bf16_t* Y;
    const float* gpost; int gate_idx; float coef; int lpost;
    const float* gpre; int shift_idx; int lpre;
    bf16_t* U; int ldu; int skip_ctx;
};
DI void row_pass(Frame& F, unsigned char* ws, const RowPass& P, int row_lo, int row_hi, int widx, int nw) {
    const float* MOD = (const float*)(ws + WS_MOD);
    const int rpw = (row_hi - row_lo + nw - 1) / nw;
    const int rbeg = row_lo + widx * rpw, rend = min(rbeg + rpw, row_hi);
    if (rbeg >= rend) return;
    const int l4 = 4 * F.lane;
    f32x4 gpo[4], gpr[4], gat[4], shf[4], scl[4];
#pragma unroll
    for (int j = 0; j < 4; ++j) { gpo[j] = *(const f32x4*)(P.gpost + l4 + 256 * j); gpr[j] = P.gpre ? *(const f32x4*)(P.gpre + l4 + 256 * j) : (f32x4){0.f, 0.f, 0.f, 0.f}; }
    int cur_mrow = -1;
    f32x4 hn[4]; u32x2 yn[4];
#define RP_ADDR(row, isctx, hoff) const int _b = (row) / LROW, _t = (row) % LROW; const bool isctx = _t < CTX; \
        const size_t hoff = isctx ? ((size_t)_b * CTX + _t) * DM : ((size_t)_b * SEQ + (_t - CTX)) * DM;
#define RP_LOAD(row) do { RP_ADDR(row, ic_, ho_) if (!(ic_ && P.skip_ctx)) { const float* hs_ = (ic_ ? P.hsrc_ctx : P.hsrc_lat) + ho_ + l4; \
        _Pragma("unroll") for (int j = 0; j < 4; ++j) hn[j] = *(const f32x4*)(hs_ + 256 * j); \
        if (P.Y) { const bf16_t* yr_ = P.Y + (size_t)(row) * DM + l4; _Pragma("unroll") for (int j = 0; j < 4; ++j) yn[j] = *(const u32x2*)(yr_ + 256 * j); } } } while (0)
    RP_LOAD(rbeg);
    for (int row = rbeg; row < rend; ++row) {
        f32x4 h[4]; u32x2 yv[4];
#pragma unroll
        for (int j = 0; j < 4; ++j) { h[j] = hn[j]; yv[j] = yn[j]; }
        if (row + 1 < rend) RP_LOAD(row + 1);
        RP_ADDR(row, isctx, hoff)
        if (isctx && P.skip_ctx) continue;
        float* hd = (isctx ? P.hdst_ctx : P.hdst_lat) + hoff + l4;
        const bool copy_h = ((isctx ? P.hsrc_ctx : P.hsrc_lat) != (isctx ? P.hdst_ctx : P.hdst_lat));
        const int mrow = isctx ? 16 : _b;
        if (mrow != cur_mrow) { cur_mrow = mrow;
            const float* gate = MOD + ((size_t)P.lpost * 17 + mrow) * NMOD + P.gate_idx * DM + l4;
            const float* sh = MOD + ((size_t)P.lpre * 17 + mrow) * NMOD + P.shift_idx * DM + l4;
#pragma unroll
            for (int j = 0; j < 4; ++j) { gat[j] = *(const f32x4*)(gate + 256 * j) * P.coef; shf[j] = *(const f32x4*)(sh + 256 * j); scl[j] = *(const f32x4*)(sh + DM + 256 * j) + 1.f; } }
        if (P.Y) {
            f32x4 y[4]; float ss = 0.f;
#pragma unroll
            for (int j = 0; j < 4; ++j) { y[j] = (f32x4){bflo(yv[j].x), bfhi(yv[j].x), bflo(yv[j].y), bfhi(yv[j].y)};
                ss += (y[j].x * y[j].x + y[j].y * y[j].y) + (y[j].z * y[j].z + y[j].w * y[j].w); }
            const float rstd = 1.f / sqrtf(wave_sum(ss) * (1.f / DM) + NORM_EPS);
#pragma unroll
            for (int j = 0; j < 4; ++j) h[j] = h[j] + gat[j] * ((y[j] * rstd) * gpo[j]);
        }
        if (P.Y || copy_h) {
#pragma unroll
            for (int j = 0; j < 4; ++j) *(f32x4*)(hd + 256 * j) = h[j];
        }
        if (P.gpre) {
            float ss = 0.f;
#pragma unroll
            for (int j = 0; j < 4; ++j) ss += (h[j].x * h[j].x + h[j].y * h[j].y) + (h[j].z * h[j].z + h[j].w * h[j].w);
            const float rstd = 1.f / sqrtf(wave_sum(ss) * (1.f / DM) + NORM_EPS);
            bf16_t* ur = P.U + (size_t)row * P.ldu + l4;
#pragma unroll
            for (int j = 0; j < 4; ++j) { const f32x4 u = ((h[j] * rstd) * gpr[j]) * scl[j] + shf[j];
                *(u32x2*)(ur + 256 * j) = (u32x2){pk2(u.x, u.y), pk2(u.z, u.w)}; }
        }
    }
#undef RP_ADDR
#undef RP_LOAD
}

DI void xx_pass(Frame& F, unsigned char* ws) {
    bf16_t* U = (bf16_t*)(ws + WS_U);
    u32x4 nc[2], np[2], nn[2];
#define XX_LOAD(row_) do { const int t_ = (row_) % LROW; const bool fi_ = (t_ == 0) || (t_ == CTX), la_ = (t_ == CTX - 1) || (t_ == LROW - 1); \
        const bf16_t* ur_ = U + (size_t)(row_) * 2048 + 8 * F.lane; \
        _Pragma("unroll") for (int j = 0; j < 2; ++j) { nc[j] = *(const u32x4*)(ur_ + 512 * j); np[j] = (u32x4){0u, 0u, 0u, 0u}; nn[j] = np[j]; \
            if (!fi_) np[j] = *(const u32x4*)(ur_ - 2048 + 512 * j); if (!la_) nn[j] = *(const u32x4*)(ur_ + 2048 + 512 * j); } } while (0)
    if (F.gw < MROWS) XX_LOAD(F.gw);
    for (int row = F.gw; row < MROWS; row += F.NGW) {
        u32x4 c[2], p[2], n[2];
#pragma unroll
        for (int j = 0; j < 2; ++j) { c[j] = nc[j]; p[j] = np[j]; n[j] = nn[j]; }
        if (row + F.NGW < MROWS) XX_LOAD(row + F.NGW);
        bf16_t* ur = U + (size_t)row * 2048 + 8 * F.lane;
#pragma unroll
        for (int j = 0; j < 2; ++j) {
            u32x4 o;
#pragma unroll
            for (int e = 0; e < 4; ++e) { const float lo = 0.5f * (bflo(p[j][e]) + bflo(n[j][e])) - bflo(c[j][e]); const float hi = 0.5f * (bfhi(p[j][e]) + bfhi(n[j][e])) - bfhi(c[j][e]); o[e] = pk2(lo, hi); }
            *(u32x4*)(ur + 1024 + 512 * j) = o;
        }
    }
#undef XX_LOAD
}

DI f32x16 mfma32(bf16x8 a, bf16x8 b, f32x16 c) { return __builtin_amdgcn_mfma_f32_32x32x16_bf16(a, b, c, 0, 0, 0); }
DI bf16x8 pack8(const f32x16& x, int s) { u32x4 p; p.x = pk2(x[8 * s], x[8 * s + 1]); p.y = pk2(x[8 * s + 2], x[8 * s + 3]); p.z = pk2(x[8 * s + 4], x[8 * s + 5]); p.w = pk2(x[8 * s + 6], x[8 * s + 7]); return __builtin_bit_cast(bf16x8, p); }
typedef short v4i16_t __attribute__((ext_vector_type(4)));
DI s16x4 vtr(LAS const unsigned char* p) { return __builtin_bit_cast(s16x4, __builtin_amdgcn_ds_read_tr16_b64_v4i16((LAS v4i16_t*)p)); }
DI float max3f(float a, float b, float c) { return __builtin_fmaxf(__builtin_fmaxf(a, b), c); }
DI float max16(const f32x16& p) { float a = max3f(p[0], p[1], p[2]), b = max3f(p[3], p[4], p[5]);
    a = max3f(a, p[6], p[7]); b = max3f(b, p[8], p[9]); a = max3f(a, p[10], p[11]); b = max3f(b, p[12], p[13]); a = max3f(a, p[14], p[15]); return __builtin_fmaxf(a, b); }

template <int NDB>
DI void softmax_pv(f32x16& p0, f32x16& p1, f32x16 (&o)[NDB], f32x16& negm, float& m_run, float& l_run, const bool first, LAS float* wsf, LAS const unsigned char* Vb, int KP, int r, int hh, int lane) {
    const int i16 = lane & 15, q4 = i16 >> 2, p4 = i16 & 3, g1 = (lane >> 4) & 1;
    LAS const unsigned char* vl = Vb + (4 * hh + q4) * 64 + 32 * g1 + 8 * p4;
    s16x4 flo[2][NDB], fhi[2][NDB];
#pragma unroll
    for (int d = 0; d < NDB; ++d) { flo[0][d] = vtr(vl + d * 4096); fhi[0][d] = vtr(vl + 8 * 64 + d * 4096); }
    __builtin_amdgcn_sched_barrier(0);
    float mx = __builtin_fmaxf(max16(p0), max16(p1)); mx = __builtin_fmaxf(mx, __shfl_xor(mx, 32));
    if (first || __any(mx > 8.f)) {
        const float delta = first ? mx : __builtin_fmaxf(mx, 0.f);
        m_run += delta;
#pragma unroll
        for (int i = 0; i < 16; ++i) { p0[i] -= delta; p1[i] -= delta; negm[i] = -m_run; }
        if (!first) {
            const float alpha = __builtin_amdgcn_exp2f(-delta);
            l_run *= alpha;
            if (hh == 0) wsf[r] = alpha;
#pragma unroll
            for (int g4 = 0; g4 < 4; ++g4) { const f32x4 a4 = *(const LAS f32x4*)(wsf + 8 * g4 + 4 * hh);
#pragma unroll
                for (int d = 0; d < NDB; ++d)
#pragma unroll
                    for (int e = 0; e < 4; ++e) o[d][4 * g4 + e] *= a4[e]; }
        }
    }
    f32x2 ls2 = {0.f, 0.f};
#pragma unroll
    for (int i = 0; i < 16; i += 2) {
        p0[i] = __builtin_amdgcn_exp2f(p0[i]); p0[i + 1] = __builtin_amdgcn_exp2f(p0[i + 1]); p1[i] = __builtin_amdgcn_exp2f(p1[i]); p1[i + 1] = __builtin_amdgcn_exp2f(p1[i + 1]);
        ls2 += (f32x2){p0[i], p0[i + 1]}; ls2 += (f32x2){p1[i], p1[i + 1]};
    }
    l_run += ls2.x + ls2.y;
    const bf16x8 pa[4] = {pack8(p0, 0), pack8(p0, 1), pack8(p1, 0), pack8(p1, 1)};
#pragma unroll
    for (int k = 0; k < 4; ++k) {
        if (k + 1 < 4) {
            LAS const unsigned char* vk = vl + 16 * (k + 1) * 64;
#pragma unroll
            for (int d = 0; d < NDB; ++d) { flo[(k + 1) & 1][d] = vtr(vk + d * 4096); fhi[(k + 1) & 1][d] = vtr(vk + 8 * 64 + d * 4096); }
        }
        __builtin_amdgcn_sched_barrier(0);
#pragma unroll
        for (int d = 0; d < NDB; ++d) { const bf16x8 vb = __builtin_shufflevector(flo[k & 1][d], fhi[k & 1][d], 0, 1, 2, 3, 4, 5, 6, 7); o[d] = mfma32(pa[k], vb, o[d]); }
        __builtin_amdgcn_sched_barrier(0);
    }
}

DI void da_unit(LAS unsigned char* lds, const int tid, const bf16_t* QKV, bf16_t* O, int q_row0, int kv_row0, int NT, int h, float lam, float one_m_li, const float* subg) {
    const int lane = tid & 63, wid = __builtin_amdgcn_readfirstlane(tid >> 6), r = lane & 31, hh = lane >> 5;
    const int qg = wid >> 1, j = wid & 1;
    constexpr int KP = 272, STG = 2 * 64 * KP;
    LAS float* wsf = (LAS float*)(lds + 2 * STG) + wid * 64;
    const bf16_t* gbase = QKV + (size_t)(kv_row0 + (tid >> 4)) * 3072 + 1024 + h * 128 + (tid & 15) * 8;
    const int lbase = (tid >> 4) * KP + (tid & 15) * 16;
    const int vbase = ((tid & 15) >> 2) * 4096 + (tid >> 4) * 64 + (tid & 3) * 16;
    u32x4 st[4];
#define DA_LOAD(t) do { _Pragma("unroll") for (int i = 0; i < 4; ++i) st[i] = *(const u32x4*)(gbase + (size_t)(t) * 64 * 3072 + (size_t)(i & 1) * 32 * 3072 + (i >> 1) * 1024); } while (0)
#define DA_STORE(buf) do { _Pragma("unroll") for (int i = 0; i < 2; ++i) { *(LAS u32x4*)(lds + (buf) * STG + lbase + i * 32 * KP) = st[i]; *(LAS u32x4*)(lds + (buf) * STG + 64 * KP + vbase + i * 32 * 64) = st[2 + i]; } } while (0)
    const bf16_t* qp = QKV + (size_t)(q_row0 + 32 * qg + r) * 3072 + h * 128 + j * 64 + 8 * hh;
    bf16x8 qr[4];
#pragma unroll
    for (int d0 = 0; d0 < 4; ++d0) qr[d0] = *(const bf16x8*)(qp + 16 * d0);
    f32x16 o[4];
#pragma unroll
    for (int d = 0; d < 4; ++d)
#pragma unroll
        for (int i = 0; i < 16; ++i) o[d][i] = 0.f;
    float m_run = 0.f, l_run = 0.f;
    f32x16 negm;
#pragma unroll
    for (int i = 0; i < 16; ++i) negm[i] = 0.f;
    DA_LOAD(0); DA_STORE(0); __syncthreads();
    for (int t = 0; t < NT; ++t) {
        const int cur = t & 1;
        if (t + 1 < NT) DA_LOAD(t + 1);
        LAS const unsigned char* Kb = lds + cur * STG + j * 128 + r * KP + hh * 16;
        LAS const unsigned char* Vb = lds + cur * STG + 64 * KP;
        f32x16 p0 = negm, p1 = negm;
#pragma unroll
        for (int d0 = 0; d0 < 4; ++d0) { const bf16x8 k0 = *(const LAS bf16x8*)(Kb + d0 * 32), k1 = *(const LAS bf16x8*)(Kb + 32 * KP + d0 * 32);
            p0 = mfma32(k0, qr[d0], p0); p1 = mfma32(k1, qr[d0], p1); }
        softmax_pv<4>(p0, p1, o, negm, m_run, l_run, t == 0, wsf, Vb, KP, r, hh, lane);
        if (t + 1 < NT) DA_STORE(cur ^ 1);
        LDS_BARRIER();
    }
#undef DA_LOAD
#undef DA_STORE
    const float lt = l_run + __shfl_xor(l_run, 32);
    if (hh == 0) wsf[r] = 1.f / lt;
    float rl[16];
#pragma unroll
    for (int g4 = 0; g4 < 4; ++g4) { const f32x4 a4 = *(const LAS f32x4*)(wsf + 8 * g4 + 4 * hh);
#pragma unroll
        for (int e = 0; e < 4; ++e) rl[4 * g4 + e] = a4[e]; }
    LAS float* R = (LAS float*)lds + qg * 32 * 132;
    if (j == 1) {
#pragma unroll
        for (int d = 0; d < 4; ++d)
#pragma unroll
            for (int i = 0; i < 16; ++i) R[((i & 3) + 8 * (i >> 2) + 4 * hh) * 132 + d * 32 + r] = o[d][i] * rl[i] * lam;
    }
    __syncthreads();
    if (j == 0) {
#pragma unroll
        for (int d = 0; d < 4; ++d)
#pragma unroll
            for (int i = 0; i < 16; ++i) { const int idx = ((i & 3) + 8 * (i >> 2) + 4 * hh) * 132 + d * 32 + r; R[idx] = o[d][i] * rl[i] - R[idx]; }
    }
    __syncthreads();
    {
        const int row = tid >> 2, qtr = tid & 3;
        LAS const float* rp = (LAS const float*)lds + (row >> 5) * 32 * 132 + (row & 31) * 132 + qtr * 32;
        f32x4 v[8]; float ss = 0.f;
#pragma unroll
        for (int c = 0; c < 8; ++c) { v[c] = *(const LAS f32x4*)(rp + 4 * c); ss += (v[c].x * v[c].x + v[c].y * v[c].y) + (v[c].z * v[c].z + v[c].w * v[c].w); }
        ss += __shfl_xor(ss, 1); ss += __shfl_xor(ss, 2);
        const float rs = one_m_li / sqrtf(ss * (1.f / 128.f) + NORM_EPS);
        bf16_t* op = O + (size_t)(q_row0 + row) * DM + h * 128 + qtr * 32;
        const float* gp = subg + qtr * 32;
#pragma unroll
        for (int c = 0; c < 4; ++c) { const f32x4 g0 = *(const f32x4*)(gp + 8 * c), g1 = *(const f32x4*)(gp + 8 * c + 4); const f32x4 a = v[2 * c] * rs * g0, b = v[2 * c + 1] * rs * g1;
            *(u32x4*)(op + 8 * c) = (u32x4){pk2(a.x, a.y), pk2(a.z, a.w), pk2(b.x, b.y), pk2(b.z, b.w)}; }
    }
    __syncthreads();
}

DI void da_phase(Frame& F, unsigned char* ws, int l) {
    const bf16_t* QKV = (const bf16_t*)(ws + WS_ACT); bf16_t* O = (bf16_t*)(ws + WS_U);
    const int slot = l / 3; const bool last = (l == 3);
    const float* lamv = (const float*)(ws + WS_LAM); const float lam = lamv[2 * slot], li = lamv[2 * slot + 1];
    const float* subg = F.in[I_DASUB] + slot * 128;
    const int nunits = 2048 + (last ? 0 : 256);
    for (int u = F.vcu; u < nunits; u += F.G) {
        if (u < 2048) { const int bh = u >> 4, qt = u & 15, b = bh >> 3, h = bh & 7;
            da_unit(F.lds, F.tid, QKV, O, b * LROW + CTX + qt * 128, b * LROW, 36, h, lam, 1.f - li, subg); }
        else { const int v = u - 2048, bh = v >> 1, qt = v & 1, b = bh >> 3, h = bh & 7;
            da_unit(F.lds, F.tid, QKV, O, b * LROW + qt * 128, b * LROW, 4, h, lam, 1.f - li, subg); }
    }
}

DI void na_unit(LAS unsigned char* lds, const int tid, const bf16_t* QKV, bf16_t* O, const float* rpb, int b, int h, int R, int ctxq) {
    const int lane = tid & 63, wid = __builtin_amdgcn_readfirstlane(tid >> 6), r = lane & 31, hh = lane >> 5;
    constexpr int KP = 144, STG = 2 * 64 * KP;
    LAS float* wsf = (LAS float*)(lds + 2 * STG) + wid * 64;
    LAS float* rpbL = (LAS float*)(lds + 2 * STG + 2048);
    const int rw = 4 * R + (wid >> 1), cq = 32 * (wid & 1) + r;
    const int rs_w = min(max(rw - 4, 0), 24);
    const int rlo = min(max(4 * R - 4, 0), 24), rhi = min(max(4 * R - 1, 0), 24) + 7;
    const int NT = ctxq ? 4 : 4 + (rhi - rlo + 1);
    const int q_row = ctxq ? b * LROW + 32 * wid + r : b * LROW + CTX + R * 256 + 32 * wid + r;
    if (!ctxq) for (int i = tid; i < 465; i += 512) rpbL[i] = rpb[h * 465 + i] * LOG2E;
    const int srow = tid >> 3, sch = tid & 7;
    const bf16_t* gb = QKV + (size_t)(b * LROW) * 3072 + 1024 + h * 64 + sch * 8;
    const int lbase = srow * KP + sch * 16;
    u32x4 st[2];
#define NA_ROW(t) ((t) < 4 ? 64 * (t) : CTX + (rlo + (t) - 4) * 64)
#define NA_LOAD(t) do { const bf16_t* _g = gb + (size_t)(NA_ROW(t) + srow) * 3072; st[0] = *(const u32x4*)_g; st[1] = *(const u32x4*)(_g + 1024); } while (0)
#define NA_STORE(buf) do { *(LAS u32x4*)(lds + (buf) * STG + lbase) = st[0]; *(LAS u32x4*)(lds + (buf) * STG + 64 * KP + (sch >> 2) * 4096 + srow * 64 + (sch & 3) * 16) = st[1]; } while (0)
    const bf16_t* qp = QKV + (size_t)q_row * 3072 + h * 64 + 8 * hh;
    bf16x8 qr[4];
#pragma unroll
    for (int d0 = 0; d0 < 4; ++d0) qr[d0] = *(const bf16x8*)(qp + 16 * d0);
    f32x16 o[2];
#pragma unroll
    for (int d = 0; d < 2; ++d)
#pragma unroll
        for (int i = 0; i < 16; ++i) o[d][i] = 0.f;
    float m_run = 0.f, l_run = 0.f;
    f32x16 negm;
#pragma unroll
    for (int i = 0; i < 16; ++i) negm[i] = 0.f;
    const int cs = min(max(cq - 8, 0), 48);
    NA_LOAD(0); NA_STORE(0); __syncthreads();
    for (int t = 0; t < NT; ++t) {
        const int cur = t & 1;
        if (t + 1 < NT) NA_LOAD(t + 1);
        const int ri = rlo + t - 4;
        const bool active = (t < 4) || (ri >= rs_w && ri <= rs_w + 7);
        if (active) {
            LAS const unsigned char* Kb = lds + cur * STG + r * KP + hh * 16;
            LAS const unsigned char* Vb = lds + cur * STG + 64 * KP;
            f32x16 p0 = negm, p1 = negm;
#pragma unroll
            for (int d0 = 0; d0 < 4; ++d0) { const bf16x8 k0 = *(const LAS bf16x8*)(Kb + d0 * 32), k1 = *(const LAS bf16x8*)(Kb + 32 * KP + d0 * 32);
                p0 = mfma32(k0, qr[d0], p0); p1 = mfma32(k1, qr[d0], p1); }
            if (t >= 4) {
                LAS const float* bt = rpbL + (ri - rw + 7) * 31 + 15 - cq;
#pragma unroll
                for (int i = 0; i < 16; ++i) { const int ck = (i & 3) + 8 * (i >> 2) + 4 * hh;
                    { const bool in = (ck >= cs) && (ck < cs + 16); const float bv = bt[in ? ck : cq]; p0[i] = in ? p0[i] + bv : -1e30f; }
                    { const int ck2 = ck + 32; const bool in = (ck2 >= cs) && (ck2 < cs + 16); const float bv = bt[in ? ck2 : cq]; p1[i] = in ? p1[i] + bv : -1e30f; } }
            }
            softmax_pv<2>(p0, p1, o, negm, m_run, l_run, t == 0, wsf, Vb, KP, r, hh, lane);
        }
        if (t + 1 < NT) NA_STORE(cur ^ 1);
        LDS_BARRIER();
    }
#undef NA_ROW
#undef NA_LOAD
#undef NA_STORE
    const float lt = l_run + __shfl_xor(l_run, 32);
    if (hh == 0) wsf[r] = 1.f / lt;
    const int orow0 = (ctxq ? b * LROW : b * LROW + CTX + R * 256) + 32 * wid;
#pragma unroll
    for (int g4 = 0; g4 < 4; ++g4) { const f32x4 a4 = *(const LAS f32x4*)(wsf + 8 * g4 + 4 * hh);
#pragma unroll
        for (int e = 0; e < 4; ++e) { const int i = 4 * g4 + e; const int q = 8 * g4 + 4 * hh + e;
            bf16_t* op = O + (size_t)(orow0 + q) * DM + h * 64 + r;
            op[0] = (bf16_t)(pk2(o[0][i] * a4[e], 0.f) & 0xffffu); op[32] = (bf16_t)(pk2(o[1][i] * a4[e], 0.f) & 0xffffu); } }
    __syncthreads();
}

DI void na_phase(Frame& F, unsigned char* ws) {
    const bf16_t* QKV = (const bf16_t*)(ws + WS_ACT); bf16_t* O = (bf16_t*)(ws + WS_U);
    for (int u = F.vcu; u < 2048 + 256; u += F.G) {
        if (u < 2048) { const int bh = u >> 3, R = u & 7; na_unit(F.lds, F.tid, QKV, O, F.in[I_NARPB], bh >> 4, bh & 15, R, 0); }
        else { const int bh = u - 2048; na_unit(F.lds, F.tid, QKV, O, F.in[I_NARPB], bh >> 4, bh & 15, 0, 1); }
    }
}

template <int CTRL> DI float dppf(float x) { return __int_as_float(__builtin_amdgcn_update_dpp(0, __float_as_int(x), CTRL, 0xf, 0xf, false)); }
DI float allred8(float x) {
    float a, b, c;
    asm volatile("s_nop 1\n\tv_add_f32_dpp %0, %1, %1 row_half_mirror row_mask:0xf bank_mask:0xf bound_ctrl:1" : "=v"(a) : "v"(x));
    asm volatile("s_nop 1\n\tv_add_f32_dpp %0, %1, %1 quad_perm:[1,0,3,2] row_mask:0xf bank_mask:0xf bound_ctrl:1" : "=v"(b) : "v"(a));
    asm volatile("s_nop 1\n\tv_add_f32_dpp %0, %1, %1 quad_perm:[2,3,0,1] row_mask:0xf bank_mask:0xf bound_ctrl:1" : "=v"(c) : "v"(b));
    return c;
}
DI float allred8_ref(float x) { x += dppf<0x141>(x); x += dppf<0xB1>(x); x += dppf<0x4E>(x); return x; }
DI float allred16(float x) { x += dppf<0x128>(x); x += dppf<0x124>(x); x += dppf<0x122>(x); x += dppf<0x121>(x); return x; }
DI void rwkv_scan(Frame& F, unsigned char* ws) {
    const bf16_t* X = (const bf16_t*)(ws + WS_ACT);
    bf16_t* Y0 = (bf16_t*)(ws + WS_U) + (size_t)MROWS * DM;
    bf16_t* Y1 = (bf16_t*)(ws + WS_Y);
    float* CD = (float*)(ws + WS_CD);
    const int tid = F.tid, lane = F.lane, g = tid >> 8, gt = tid & 255, gwv = (tid >> 6) & 3;
    LAS float* buf = (LAS float*)(F.lds) + g * 5120;
    LAS float* ybuf0 = (LAS float*)(F.lds + 40960) + g * 2048;
    LAS float* red = (LAS float*)(F.lds + 57344) + g * 128;
    for (int s0 = F.vcu * 2; s0 < 512; s0 += F.G * 2) {
        const int s = s0 + g, dir = s >> 8, b = (s >> 4) & 15, h = s & 15;
        const int ch = 16 * gwv + (lane & 15), chn = h * 64 + ch, rq = lane >> 4;
        bf16x8 bw[2], ba[2];
#pragma unroll
        for (int ks = 0; ks < 2; ++ks) { u32x4 pw, pa;
#pragma unroll
            for (int e = 0; e < 4; ++e) { const int k = 32 * ks + 8 * rq + 2 * e;
                pw[e] = pk2(F.in[I_RWW2][(size_t)(dir * 64 + k) * 1024 + chn], F.in[I_RWW2][(size_t)(dir * 64 + k + 1) * 1024 + chn]);
                pa[e] = pk2(F.in[I_RWA2][(size_t)(dir * 64 + k) * 1024 + chn], F.in[I_RWA2][(size_t)(dir * 64 + k + 1) * 1024 + chn]); }
            bw[ks] = __builtin_bit_cast(bf16x8, pw); ba[ks] = __builtin_bit_cast(bf16x8, pa); }
        const float w0c = F.in[I_RWW0][dir * 1024 + chn], a0c = F.in[I_RWA0][dir * 1024 + chn], kkc = F.in[I_RWKK][chn], kac = F.in[I_RWKA][chn], rkc = F.in[I_RWRK][chn];
        const bf16_t* Xb = X + (size_t)(b * LROW) * 3584;
        bf16_t* Yd = (dir ? Y1 : Y0) + (size_t)(b * LROW) * DM + h * 64;
        float* CDd = CD + ((size_t)dir * MROWS + (size_t)b * LROW) * 16 + h;
        f32x2 S2[8];
#pragma unroll
        for (int i = 0; i < 8; ++i) S2[i] = (f32x2){0.f, 0.f};
        bf16x8 Bs[2];
        Bs[0] = (bf16x8){0, 0, 0, 0, 0, 0, 0, 0}; Bs[1] = Bs[0];
        const int vl = lane & 15, kq = lane >> 4;
        bf16x8 ahw[2], aha[2]; bf16_t rr_[4], kr_[4], vr_[4];
#define SC_RLO(c) (dir ? (((c) < 16 ? 255 - 16 * (c) : 2559 - 16 * (c)) - 15) : 16 * (c))
#define SC_LOAD(c) do { const int _rlo = SC_RLO(c); const bf16_t* _p = Xb + (size_t)(_rlo + (lane & 15)) * 3584 + 3072 + dir * 64 + 8 * rq; \
        ahw[0] = *(const bf16x8*)_p; ahw[1] = *(const bf16x8*)(_p + 32); aha[0] = *(const bf16x8*)(_p + 128); aha[1] = *(const bf16x8*)(_p + 160); \
        _Pragma("unroll") for (int j = 0; j < 4; ++j) { const bf16_t* _q = Xb + (size_t)(_rlo + 4 * rq + j) * 3584 + chn; rr_[j] = _q[0]; kr_[j] = _q[1024]; vr_[j] = _q[2048]; } } while (0)
#define SC_OUT(cc) do { const int rr_o = gt >> 4, c4_o = (gt & 15) * 4, js_o = dir ? 15 - rr_o : rr_o; const int rlo_o = SC_RLO(cc); \
        const f32x4 yv_o = *(const LAS f32x4*)(ybuf0 + ((cc) & 1) * 1024 + js_o * 64 + c4_o); \
        *(u32x2*)(Yd + (size_t)(rlo_o + rr_o) * DM + c4_o) = (u32x2){pk2(yv_o.x, yv_o.y), pk2(yv_o.z, yv_o.w)}; } while (0)
        SC_LOAD(0);
        for (int c = 0; c < 144; ++c) {
            const int rlo = SC_RLO(c);
            LAS float* cb = buf;
            LAS float* ybuf = ybuf0 + (c & 1) * 1024;
            f32x4 accw = {0.f, 0.f, 0.f, 0.f}, acca = {0.f, 0.f, 0.f, 0.f};
#pragma unroll
            for (int ks = 0; ks < 2; ++ks) { accw = __builtin_amdgcn_mfma_f32_16x16x32_bf16(ahw[ks], bw[ks], accw, 0, 0, 0); acca = __builtin_amdgcn_mfma_f32_16x16x32_bf16(aha[ks], ba[ks], acca, 0, 0, 0); }
            float dec[4], av[4], kkv[4], kd[4], rv[4], vv[4];
#pragma unroll
            for (int j = 0; j < 4; ++j) {
                const float z = w0c + accw[j]; dec[j] = fast_exp(-0.6065306597126334f * sigmoidf_(z));
                av[j] = sigmoidf_(a0c + acca[j]);
                const float kx = bf2f(kr_[j]); rv[j] = bf2f(rr_[j]); vv[j] = bf2f(vr_[j]);
                kkv[j] = kx * kkc; kd[j] = kx * (1.f + (av[j] - 1.f) * kac);
                const float nsq = allred16(kkv[j] * kkv[j]), cp = allred16(rv[j] * kd[j] * rkc);
                if ((lane & 15) == 0) { red[(4 * rq + j) * 4 + gwv] = nsq; red[64 + (4 * rq + j) * 4 + gwv] = cp; }
            }
            LDS_BARRIER();
            if (c > 0) SC_OUT(c - 1);
            const bf16_t rr_s[4] = {rr_[0], rr_[1], rr_[2], rr_[3]};
#pragma unroll
            for (int j = 0; j < 4; ++j) {
                const int rr = 4 * rq + j, js = dir ? 15 - rr : rr;
                const f32x4 n4 = *(const LAS f32x4*)(red + rr * 4);
                const float inv = __builtin_amdgcn_rsqf(fmaxf((n4.x + n4.y) + (n4.z + n4.w), 1e-24f));
                const float kkn = kkv[j] * inv;
                LAS float* d = cb + js * 320 + ch;
                d[0] = dec[j]; d[64] = kkn * av[j]; d[128] = kd[j]; d[192] = vv[j];
                LAS bf16_t* db = (LAS bf16_t*)(cb + js * 320 + 256) + ch;
                db[0] = (bf16_t)(pk2(-kkn, 0.f) & 0xffffu); db[64] = rr_s[j];
            }
            if (gt < 16) { const f32x4 c4 = *(const LAS f32x4*)(red + 64 + gt * 4); CDd[(size_t)(rlo + gt) * 16] = (c4.x + c4.y) + (c4.z + c4.w); }
            if (c + 1 < 144) SC_LOAD(c + 1);
            LDS_BARRIER();
            bf16x8 oa[2][2], orr[2][2]; f32x4 ow[2][4]; float ovt[2];
#define SC_OPS(P, js_) do { LAS const float* sb_ = cb + (js_) * 320; LAS const bf16_t* ab_ = (LAS const bf16_t*)(sb_ + 256) + 8 * kq; \
                oa[P][0] = *(const LAS bf16x8*)(ab_); oa[P][1] = *(const LAS bf16x8*)(ab_ + 32); orr[P][0] = *(const LAS bf16x8*)(ab_ + 64); orr[P][1] = *(const LAS bf16x8*)(ab_ + 96); \
                _Pragma("unroll") for (int s_ = 0; s_ < 2; ++s_) { LAS const float* ob2_ = sb_ + 32 * s_ + 8 * kq; ow[P][2 * s_] = *(const LAS f32x4*)(ob2_); ow[P][2 * s_ + 1] = *(const LAS f32x4*)(ob2_ + 4); } \
                ovt[P] = sb_[192 + 16 * gwv + vl]; } while (0)
            SC_OPS(0, 0);
#pragma unroll
            for (int js = 0; js < 16; ++js) {
                const int P = js & 1;
                f32x4 obv[4], odv[4];
                { LAS const float* sb_ = cb + js * 320 + 8 * kq;
#pragma unroll
                  for (int s_ = 0; s_ < 2; ++s_) { obv[2 * s_] = *(const LAS f32x4*)(sb_ + 32 * s_ + 64); obv[2 * s_ + 1] = *(const LAS f32x4*)(sb_ + 32 * s_ + 68); odv[2 * s_] = *(const LAS f32x4*)(sb_ + 32 * s_ + 128); odv[2 * s_ + 1] = *(const LAS f32x4*)(sb_ + 32 * s_ + 132); } }
                __builtin_amdgcn_sched_barrier(0);
                if (js + 1 < 16) SC_OPS(P ^ 1, js + 1);
                __builtin_amdgcn_sched_barrier(0);
                f32x4 acs = {0.f, 0.f, 0.f, 0.f};
                acs = __builtin_amdgcn_mfma_f32_16x16x32_bf16(oa[P][0], Bs[0], acs, 0, 0, 0); acs = __builtin_amdgcn_mfma_f32_16x16x32_bf16(oa[P][1], Bs[1], acs, 0, 0, 0);
                const float vt = ovt[P];
                const float sa = acs[0];
#pragma unroll
                for (int s_ = 0; s_ < 2; ++s_) {
                    const f32x4 w0 = ow[P][2 * s_], w1 = ow[P][2 * s_ + 1], b0 = obv[2 * s_], b1 = obv[2 * s_ + 1], d0 = odv[2 * s_], d1 = odv[2 * s_ + 1];
                    S2[4 * s_ + 0] = S2[4 * s_ + 0] * (f32x2){w0.x, w0.y} + ((f32x2){b0.x, b0.y} * sa + (f32x2){d0.x, d0.y} * vt);
                    S2[4 * s_ + 1] = S2[4 * s_ + 1] * (f32x2){w0.z, w0.w} + ((f32x2){b0.z, b0.w} * sa + (f32x2){d0.z, d0.w} * vt);
                    S2[4 * s_ + 2] = S2[4 * s_ + 2] * (f32x2){w1.x, w1.y} + ((f32x2){b1.x, b1.y} * sa + (f32x2){d1.x, d1.y} * vt);
                    S2[4 * s_ + 3] = S2[4 * s_ + 3] * (f32x2){w1.z, w1.w} + ((f32x2){b1.z, b1.w} * sa + (f32x2){d1.z, d1.w} * vt);
                    u32x4 pk; pk.x = pk2(S2[4 * s_ + 0].x, S2[4 * s_ + 0].y); pk.y = pk2(S2[4 * s_ + 1].x, S2[4 * s_ + 1].y); pk.z = pk2(S2[4 * s_ + 2].x, S2[4 * s_ + 2].y); pk.w = pk2(S2[4 * s_ + 3].x, S2[4 * s_ + 3].y);
                    Bs[s_] = __builtin_bit_cast(bf16x8, pk);
                }
                f32x4 acy = {0.f, 0.f, 0.f, 0.f};
                acy = __builtin_amdgcn_mfma_f32_16x16x32_bf16(orr[P][0], Bs[0], acy, 0, 0, 0); acy = __builtin_amdgcn_mfma_f32_16x16x32_bf16(orr[P][1], Bs[1], acy, 0, 0, 0);
                if (kq == 0) ybuf[js * 64 + 16 * gwv + vl] = acy[0];
                __builtin_amdgcn_sched_barrier(0);
            }
#undef SC_OPS
        }
        LDS_BARRIER();
        SC_OUT(143);
#undef SC_OUT
#undef SC_RLO
#undef SC_LOAD
        __syncthreads();
    }
}

DI void rwkv_readout(Frame& F, unsigned char* ws) {
    const bf16_t* X = (const bf16_t*)(ws + WS_ACT);
    bf16_t* G = (bf16_t*)(ws + WS_U);
    const bf16_t* Y0 = G + (size_t)MROWS * DM; const bf16_t* Y1 = (const bf16_t*)(ws + WS_Y);
    const float* CD = (const float*)(ws + WS_CD);
    const int c0 = 16 * F.lane, hd = F.lane >> 2;
    float lng[16], lnb[16];
#pragma unroll
    for (int i = 0; i < 16; i += 4) { const f32x4 g_ = *(const f32x4*)(F.in[I_RWLNG] + c0 + i), b_ = *(const f32x4*)(F.in[I_RWLNB] + c0 + i);
        lng[i] = g_.x; lng[i + 1] = g_.y; lng[i + 2] = g_.z; lng[i + 3] = g_.w; lnb[i] = b_.x; lnb[i + 1] = b_.y; lnb[i + 2] = b_.z; lnb[i + 3] = b_.w; }
    u32x4 na[2], nb[2], nv[2], ng_[2]; float ncd0 = 0.f, ncd1 = 0.f;
#define RD_LOAD(row_) do { _Pragma("unroll") for (int j = 0; j < 2; ++j) { na[j] = *(const u32x4*)(Y0 + (size_t)(row_) * DM + c0 + 8 * j); nb[j] = *(const u32x4*)(Y1 + (size_t)(row_) * DM + c0 + 8 * j); \
        nv[j] = *(const u32x4*)(X + (size_t)(row_) * 3584 + 2048 + c0 + 8 * j); ng_[j] = *(const u32x4*)(G + (size_t)(row_) * DM + c0 + 8 * j); } \
        ncd0 = CD[(size_t)(row_) * 16 + hd]; ncd1 = CD[((size_t)MROWS + (row_)) * 16 + hd]; } while (0)
    if (F.gw < MROWS) RD_LOAD(F.gw);
    for (int row = F.gw; row < MROWS; row += F.NGW) {
        float y[16], vv[16], gg[16];
        const float cc = ncd0 + ncd1;
#pragma unroll
        for (int j = 0; j < 2; ++j) {
            const u32x4 a = na[j], bq = nb[j], v4 = nv[j], g4 = ng_[j];
#pragma unroll
            for (int e = 0; e < 4; ++e) { y[8 * j + 2 * e] = bflo(a[e]) + bflo(bq[e]); y[8 * j + 2 * e + 1] = bfhi(a[e]) + bfhi(bq[e]);
                vv[8 * j + 2 * e] = bflo(v4[e]); vv[8 * j + 2 * e + 1] = bfhi(v4[e]); gg[8 * j + 2 * e] = bflo(g4[e]); gg[8 * j + 2 * e + 1] = bfhi(g4[e]); }
        }
        if (row + F.NGW < MROWS) RD_LOAD(row + F.NGW);
        float s = 0.f;
#pragma unroll
        for (int i = 0; i < 16; ++i) s += y[i];
        s += __shfl_xor(s, 1); s += __shfl_xor(s, 2);
        const float mean = s * (1.f / 64.f); float q = 0.f;
#pragma unroll
        for (int i = 0; i < 16; ++i) { y[i] -= mean; q += y[i] * y[i]; }
        q += __shfl_xor(q, 1); q += __shfl_xor(q, 2);
        const float rstd = 1.f / sqrtf(q * (1.f / 64.f) + 64e-5f);
        u32x4 o[2];
#pragma unroll
        for (int j = 0; j < 2; ++j)
#pragma unroll
            for (int e = 0; e < 4; ++e) { const int i = 8 * j + 2 * e;
                const float z0 = ((y[i] * rstd) * lng[i] + lnb[i] + cc * vv[i]) * gg[i];
                const float z1 = ((y[i + 1] * rstd) * lng[i + 1] + lnb[i + 1] + cc * vv[i + 1]) * gg[i + 1];
                o[j][e] = pk2(z0, z1); }
        *(u32x4*)(G + (size_t)row * DM + c0) = o[0]; *(u32x4*)(G + (size_t)row * DM + c0 + 8) = o[1];
    }
#undef RD_LOAD
}


#define XB_TMO      128
#define XB_XCNT(j)  (256  + 64 * (j))
#define XB_XSUB(j)  (1280 + 64 * (j))
#define XB_XGEN(j)  (2304 + 64 * (j))
#define XB_TOP      3328
#define XB_TOPGEN   3392
#define XCD_BAR_WORDS 3456
#define XB_SPIN_CAP (1u << 18)
DI unsigned xb_ld(unsigned* p)              { return __hip_atomic_load(p, __ATOMIC_RELAXED, __HIP_MEMORY_SCOPE_AGENT); }
DI unsigned xb_add(unsigned* p, unsigned v) { return __hip_atomic_fetch_add(p, v, __ATOMIC_RELAXED, __HIP_MEMORY_SCOPE_AGENT); }
DI unsigned xb_xcc_id() { return (unsigned)__builtin_amdgcn_s_getreg((3 << 11) | 20) & 0xFu; }
#define XB_SPIN(cond, bar) do { unsigned _sp = 0; while (cond) { __builtin_amdgcn_s_sleep(1); \
    if ((++_sp & 255u) == 0u) { if (xb_ld(&(bar)[XB_TMO])) break; if (_sp > XB_SPIN_CAP) { atomicAdd(&(bar)[XB_TMO], 1u); break; } } } } while (0)
struct XcdBarrier { unsigned* bar; unsigned x; volatile LAS unsigned* st; };
DI XcdBarrier xcd_barrier_post(unsigned* bar, volatile LAS unsigned* st) {
    XcdBarrier b; b.bar = bar; b.x = xb_xcc_id(); b.st = st;
    if (threadIdx.x == 0) (void)xb_add(&bar[XB_XCNT(b.x)], 1u);
    return b;
}
DI void xcd_barrier_complete(unsigned* bar, unsigned x, unsigned& nloc, unsigned& nx) {
    const unsigned G = gridDim.x * gridDim.y * gridDim.z;
    unsigned sum, cnt, mine, sp = 0u;
    for (;;) {
        sum = 0u; cnt = 0u; mine = 0u;
#pragma unroll
        for (unsigned j = 0; j < 16; ++j) { const unsigned c = xb_ld(&bar[XB_XCNT(j)]); sum += c; cnt += (c > 0u) ? 1u : 0u; mine = (j == x) ? c : mine; }
        if (sum == G) break;
        __builtin_amdgcn_s_sleep(1);
        if ((++sp & 255u) == 0u) { if (xb_ld(&bar[XB_TMO])) break; if (sp > XB_SPIN_CAP) { atomicAdd(&bar[XB_TMO], 1u); break; } }
    }
    nloc = mine > 0u ? mine : 1u; nx = cnt > 0u ? cnt : 1u;
}
DI void xcd_barrier(const XcdBarrier& b) {
    asm volatile("s_waitcnt vmcnt(0)" ::: "memory");
    __syncthreads();
    if (threadIdx.x == 0) {
        unsigned* bar = b.bar;
        __builtin_amdgcn_s_waitcnt(0);
        unsigned nloc = b.st[0], nx = b.st[1];
        if (nloc == 0u) { xcd_barrier_complete(bar, b.x, nloc, nx); b.st[0] = nloc; b.st[1] = nx; }
        const unsigned old = xb_add(&bar[XB_XSUB(b.x)], 1u);
        const unsigned gen = old / nloc;
        if (old + 1u == (gen + 1u) * nloc) {
            __builtin_amdgcn_fence(__ATOMIC_RELEASE, "agent");
            asm volatile("s_waitcnt vmcnt(0)" ::: "memory");
            const unsigned og = xb_add(&bar[XB_TOP], 1u);
            const unsigned tg = og / nx;
            if (og + 1u == (tg + 1u) * nx) xb_add(&bar[XB_TOPGEN], 1u);
            else XB_SPIN(xb_ld(&bar[XB_TOPGEN]) == tg, bar);
            __builtin_amdgcn_fence(__ATOMIC_ACQUIRE, "agent");
            xb_add(&bar[XB_XGEN(b.x)], 1u);
            asm volatile("s_waitcnt vmcnt(0)" ::: "memory");
        } else {
            XB_SPIN(xb_ld(&bar[XB_XGEN(b.x)]) == gen, bar);
            __builtin_amdgcn_fence(__ATOMIC_ACQUIRE, "agent");
            asm volatile("s_waitcnt vmcnt(0)" ::: "memory");
        }
    }
    __syncthreads();
}

enum { OP_RP0 = 0, OP_G1, OP_G2, OP_RP1, OP_XX, OP_RKVH, OP_GG, OP_SCAN, OP_RDOUT, OP_QKV, OP_ATT, OP_OPROJ, OP_RP2, OP_G5, OP_G6, OP_RP3, OP_END };
DI int next_op(int kind, int op) {
    switch (op) {
        case OP_RP0: return OP_G1; case OP_G1: return OP_G2; case OP_G2: return OP_RP1;
        case OP_RP1: return kind == 2 ? OP_XX : OP_QKV;
        case OP_XX: return OP_RKVH; case OP_RKVH: return OP_GG; case OP_GG: return OP_SCAN; case OP_SCAN: return OP_RDOUT; case OP_RDOUT: return OP_OPROJ;
        case OP_QKV: return OP_ATT; case OP_ATT: return OP_OPROJ; case OP_OPROJ: return OP_RP2;
        case OP_RP2: return OP_G5; case OP_G5: return OP_G6; case OP_G6: return OP_RP3; default: return OP_END;
    }
}

__global__ void __launch_bounds__(512, 2) mega(const float* i0, const float* i1, const float* i2, const float* i3, const float* i4, const float* i5, const float* i6, const float* i7, const float* i8, const float* i9, const float* i10, const float* i11, const float* i12, const float* i13, const float* i14, const float* i15, const float* i16, const float* i17, const float* i18, const float* i19, const float* i20, const float* i21, const float* i22, const float* i23, const float* i24, const float* i25, const float* i26, const float* i27, const float* i28, const float* i29, const float* i30, const float* i31, float* out, unsigned char* ws0) {
    const float* in_[32] = {i0, i1, i2, i3, i4, i5, i6, i7, i8, i9, i10, i11, i12, i13, i14, i15, i16, i17, i18, i19, i20, i21, i22, i23, i24, i25, i26, i27, i28, i29, i30, i31};
    extern __shared__ __attribute__((aligned(16))) unsigned char lds_raw[];
    cg::grid_group grid = cg::this_grid();
    Frame F;
#define BUILD_FRAME() do { int tid_ = threadIdx.x; asm volatile("" : "+v"(tid_)); int bx_ = blockIdx.x; asm volatile("" : "+s"(bx_)); \
    F.lds = (LAS unsigned char*)lds_raw; F.tid = tid_; F.lane = tid_ & 63; F.wave = __builtin_amdgcn_readfirstlane(tid_ >> 6); \
    F.G = gridDim.x; F.bx = bx_; F.vcu = (F.G % 8 == 0) ? (bx_ % 8) * (F.G / 8) + bx_ / 8 : bx_; \
    F.gw = F.vcu * 8 + F.wave; F.NGW = F.G * 8; F.in = in_; } while (0)
    BUILD_FRAME();
    unsigned char* ws = ws0;

#ifndef NO_P0
    phase0(F, ws);
#endif
    grid.sync();
    volatile LAS unsigned* bst = (volatile LAS unsigned*)(F.lds + LDS_BYTES - 64);
    if (F.tid < 2) bst[F.tid] = 0u;
    __syncthreads();
    const XcdBarrier xbar = xcd_barrier_post((unsigned*)(ws0 + WS_BAR), bst);

    for (int l = 0; l < 4; ++l) {
        const int kind = l % 3; const bool last = (l == 3);
        const float* ng = F.in[I_NORMG] + l * 6 * DM;
        int op = (l == 0) ? OP_RP0 : OP_G1;
        int sub = 0, rp_lo = 0;
        while (op != OP_END) {
            { size_t zoff = 0; asm volatile("" : "+s"(zoff)); ws = ws0 + zoff; }
            BUILD_FRAME();
            float* HC = (float*)(ws + WS_HC); bf16_t* WB = (bf16_t*)(ws + WS_WB); bf16_t* U = (bf16_t*)(ws + WS_U); bf16_t* ACT = (bf16_t*)(ws + WS_ACT); bf16_t* YB = (bf16_t*)(ws + WS_Y);
            const float* cosT = (const float*)(ws + WS_ROPE); const float* sinT = cosT + 1024;
            int rpop = -1, rlo = 0, rhi = MROWS, rwidx = F.gw, rnw = F.NGW; bool fill = false;
            if (op == OP_G1 || op == OP_G2 || op == OP_G5 || op == OP_G6 || op == OP_QKV || op == OP_RKVH || op == OP_GG || op == OP_OPROJ) {
                pg8::Gemm g; pg8::Epi E; E.cosT = cosT; E.sinT = sinT; int skip = 0;
                if (op == OP_G1 || op == OP_G5) { g.A = U; g.lda = 1024; g.Bt = WB + (op == OP_G1 ? WB_IN0 : WB_IN1); g.ldb = 1024; g.N = 5632; g.K = 1024; E.mode = pg8::EPI_SWIGLU; E.O = ACT; E.ldc = FF; skip = (last && op == OP_G5); }
                else if (op == OP_G2 || op == OP_G6) { g.A = ACT; g.lda = FF; g.Bt = WB + (op == OP_G2 ? WB_OUT0 : WB_OUT1); g.ldb = FF; g.N = 1024; g.K = FF; E.mode = pg8::EPI_PLAIN; E.O = YB; E.ldc = 1024; skip = (last && op == OP_G6); }
                else if (op == OP_QKV) { g.A = U; g.lda = 1024; g.Bt = WB + WB_MIXIN; g.ldb = 1024; g.N = 3072; g.K = 1024; E.mode = kind == 0 ? pg8::EPI_QKV_DA : pg8::EPI_QKV_NA; E.O = ACT; E.ldc = 3072; }
                else if (op == OP_RKVH) { g.A = U; g.lda = 2048; g.Bt = WB + WB_MIXIN; g.ldb = 2048; g.N = 3584; g.K = 2048; E.mode = pg8::EPI_RWKV; E.O = ACT; E.ldc = 3584; }
                else if (op == OP_GG) { g.A = ACT + 3328; g.lda = 3584; g.Bt = WB + WB_G2T; g.ldb = 256; g.N = 1024; g.K = 256; E.mode = pg8::EPI_PLAIN; E.O = U; E.ldc = 1024; }
                else { g.A = U; g.lda = 1024; g.Bt = WB + WB_MIXOUT; g.ldb = 1024; g.N = 1024; g.K = 1024; E.mode = pg8::EPI_PLAIN; E.O = YB; E.ldc = 1024; skip = last; }
                g.nM = skip ? 128 : 144; g.skip = skip;
                pg8::StaticOrder S; S.init(g.nM, g.N, F.G, F.bx, skip);
                fill = (op == OP_G2 || op == OP_G6 || op == OP_OPROJ) && !skip && F.G == 256;
                if (fill) { S.pmode = 1; S.r0 = sub ? 2 : 0; S.nr = sub ? 1 : 2;
                    if (sub == 1 && F.bx >= 64) { rpop = (op == OP_G2) ? OP_RP1 : (op == OP_G6 ? OP_RP3 : OP_RP2); rlo = 0; rhi = 128 * 256; rwidx = (F.bx - 64) * 8 + F.wave; rnw = 192 * 8; } }
#ifndef NO_GEMM
                pg8::gemm_phase(F.lds, F.tid, g, S, E);
#endif
            } else if (op == OP_RP0 || op == OP_RP1 || op == OP_RP2 || op == OP_RP3) { rpop = op; rlo = rp_lo; }
            if (rpop >= 0) {
                RowPass P;
                P.hsrc_lat = out; P.hsrc_ctx = HC; P.hdst_lat = out; P.hdst_ctx = HC; P.U = U; P.ldu = 1024; P.skip_ctx = 0; P.lpost = l; P.lpre = l;
                if (rpop == OP_RP0) { P.hsrc_lat = F.in[I_X]; P.hsrc_ctx = F.in[I_CTX]; P.hdst_lat = (float*)F.in[I_X]; P.hdst_ctx = (float*)F.in[I_CTX];   P.Y = nullptr; P.gpost = ng; P.gate_idx = 0; P.coef = 0.f; P.gpre = ng; P.shift_idx = 0; }
                else if (rpop == OP_RP1) { if (l == 0) { P.hsrc_lat = F.in[I_X]; P.hsrc_ctx = F.in[I_CTX]; } P.Y = YB; P.gpost = ng + DM; P.gate_idx = 2; P.coef = 0.5f; P.gpre = ng + 2 * DM; P.shift_idx = 3; P.ldu = (kind == 2) ? 2048 : 1024; }
                else if (rpop == OP_RP2) { P.Y = YB; P.gpost = ng + 3 * DM; P.gate_idx = 5; P.coef = 1.f; P.gpre = ng + 4 * DM; P.shift_idx = 6; P.skip_ctx = last; }
                else { P.Y = YB; P.gpost = ng + 5 * DM; P.gate_idx = 8; P.coef = 0.5f; P.gpre = last ? nullptr : ng + 6 * DM; P.shift_idx = 0; P.lpre = l + 1; P.skip_ctx = last; }
#ifndef NO_RP
                row_pass(F, ws, P, rlo, rhi, rwidx, rnw);
#endif
#ifndef NO_CONV
                if (op == OP_RP3 && !last) { __syncthreads(); convert_layer(F, ws, l + 1); }
#endif
            }
#ifndef NO_XX
            if (op == OP_XX) { xx_pass(F, ws); }
#endif

#ifndef NO_SCAN
            if (op == OP_SCAN) { rwkv_scan(F, ws); }
#endif

#ifndef NO_RDOUT
            if (op == OP_RDOUT) { rwkv_readout(F, ws); }
#endif

#ifndef NO_ATT
            if (op == OP_ATT) {
#ifndef NO_DA
 if (kind == 0) da_phase(F, ws, l);
#endif
#ifndef NO_NA
 if (kind == 1) na_phase(F, ws);
#endif
 }
#endif
            xcd_barrier(xbar);
            if (fill) { if (sub == 0) { sub = 1; continue; } sub = 0; rp_lo = 128 * 256; }
            else if (rpop >= 0) rp_lo = 0;
            op = next_op(kind, op);
        }
    }
}

extern "C" void kernel_launch(void* const* d_in, const int* in_sizes, int n_in, void* d_out, int out_size,
                              void* d_ws, size_t ws_size, hipStream_t stream) {
    static int grid = 0;
    if (grid == 0) {
        if (n_in != 32 || ws_size < WS_END) { fprintf(stderr, "kernel_launch: need 32 inputs and %zu B of workspace; got %d, %zu\n", (size_t)WS_END, n_in, ws_size); grid = -1; return; }
        int dev = 0, cus = 0, per_cu = 0;
        (void)hipGetDevice(&dev);
        (void)hipDeviceGetAttribute(&cus, hipDeviceAttributeMultiprocessorCount, dev);
        (void)hipFuncSetAttribute((const void*)mega, hipFuncAttributeMaxDynamicSharedMemorySize, LDS_BYTES);
        (void)hipOccupancyMaxActiveBlocksPerMultiprocessor(&per_cu, (const void*)mega, 512, LDS_BYTES);
        if (per_cu < 1) per_cu = 1;
        grid = cus * per_cu;
    }
    if (grid < 0) return;
    const float* inp[32]; for (int i = 0; i < 32; ++i) inp[i] = (const float*)d_in[i];
    float* outp = (float*)d_out; unsigned char* wsp = (unsigned char*)d_ws;
    void* kargs[34]; for (int i = 0; i < 32; ++i) kargs[i] = (void*)&inp[i];
    kargs[32] = (void*)&outp; kargs[33] = (void*)&wsp;
    hipError_t e = hipLaunchCooperativeKernel((const void*)mega, dim3(grid), dim3(512), kargs, LDS_BYTES, stream);
    if (e != hipSuccess) fprintf(stderr, "cooperative launch failed: %s (grid %d)\n", hipGetErrorString(e), grid);
}
```

```cpp
#include <hip/hip_runtime.h>
#include <hip/hip_cooperative_groups.h>
#include <cstdio>
#include <cstdint>
namespace cg = cooperative_groups;
#ifndef REP_MASK
#define REP_MASK 0
#endif

#define LAS __attribute__((address_space(3)))
#define DI __device__ __forceinline__
typedef unsigned short bf16_t;
typedef short bf16x8 __attribute__((ext_vector_type(8)));
typedef short s16x4 __attribute__((ext_vector_type(4)));
typedef float f32x2 __attribute__((ext_vector_type(2)));
typedef float f32x4 __attribute__((ext_vector_type(4)));
typedef float f32x16 __attribute__((ext_vector_type(16)));
typedef unsigned u32x4 __attribute__((ext_vector_type(4)));
typedef unsigned u32x2 __attribute__((ext_vector_type(2)));
typedef __bf16 bf2_t __attribute__((ext_vector_type(2)));

constexpr int DM = 1024, NB = 16, SEQ = 2048, CTX = 256, LROW = 2304, MROWS = NB * LROW, FF = 2816, NMOD = 9216;
constexpr float NORM_EPS = 1e-6f;
constexpr float LOG2E = 1.4426950408889634f;
constexpr float QSCALE = 0.125f * LOG2E;

constexpr size_t MiB = 1u << 20;
constexpr size_t WS_MOD = 0, WS_ROPE = 3 * MiB, WS_LAM = 3 * MiB + 16384, WS_BAR = 3 * MiB + 32768, WS_CD = 4 * MiB, WS_HC = 9 * MiB, WS_WB = 25 * MiB,
                 WS_U = 75 * MiB, WS_ACT = 219 * MiB, WS_Y = 471 * MiB, WS_END = 543 * MiB;
constexpr size_t WB_IN0 = 0, WB_OUT0 = 5767168, WB_IN1 = 8650752, WB_OUT1 = 14417920, WB_MIXIN = 17301504, WB_MIXOUT = 24641536, WB_G2T = 25690112;
constexpr int LDS_BYTES = 147456;

DI unsigned pk2(float lo, float hi) { f32x2 v = {lo, hi}; bf2_t b = __builtin_convertvector(v, bf2_t); return __builtin_bit_cast(unsigned, b); }
DI float bf2f(bf16_t h) { return __uint_as_float(((unsigned)h) << 16); }
DI float bflo(unsigned w) { return __uint_as_float(w << 16); }
DI float bfhi(unsigned w) { return __uint_as_float(w & 0xffff0000u); }
DI float wave_sum(float v) {
#pragma unroll
    for (int o = 1; o < 64; o <<= 1) v += __shfl_xor(v, o);
    return v;
}
#define LDS_BARRIER() asm volatile("s_waitcnt lgkmcnt(0)\n\ts_barrier" ::: "memory")
DI float fast_exp(float x) { return __builtin_amdgcn_exp2f(x * LOG2E); }
DI float sigmoidf_(float x) { return __builtin_amdgcn_rcpf(1.f + fast_exp(-x)); }
DI float siluf_(float x) { return x * sigmoidf_(x); }
DI float tanhf_(float x) { return 1.f - 2.f * __builtin_amdgcn_rcpf(1.f + fast_exp(2.f * x)); }

namespace pg8 {
constexpr int BM = 256, BK = 64, HALF = 128, HTB = HALF * BK * 2, NXCD = 8, WGM = 4;
__host__ __device__ __forceinline__ int lds_byte(int r, int c) { const int st = (r >> 4) * 2 + (c >> 5), rr = r & 15, cc = c & 31, ob = rr * 64 + cc * 2; return st * 1024 + (ob ^ (((ob >> 9) & 1) << 5)); }
__host__ __device__ __forceinline__ void stage_rc(int b, int& R, int& C) { const int st = b / 1024, sb = b % 1024, swz = sb ^ (((sb >> 9) & 1) << 5); R = (st >> 1) * 16 + swz / 64; C = (st & 1) * 32 + (swz % 64) / 2; }
__host__ __device__ __forceinline__ int perm32(int rho) { const int n = rho >> 4, i = rho & 15; return 8 * (i >> 2) + 4 * n + (i & 3); }

struct Unit { int pm, pn; };
struct Gemm { const bf16_t* A; const bf16_t* Bt; int lda, ldb, N, K, nM, skip; };

struct StaticOrder {
    int nM, nN, nwg, G, c, skip;
    int pmode, r0, nr;
    DI void init(int nM_, int N, int G_, int c_, int skip_) { nM = nM_; nN = N / BM; nwg = nM * nN; G = G_; c = c_; skip = skip_; pmode = 0; r0 = 0; nr = 0; }
    DI bool next(int i, Unit& u) const {
        if (pmode) {
            if (i >= nr) return false;
            const int round = r0 + i, xcd = c & 7, j = c >> 3, full = nM >> 6; int panel;
            if (round < full) { panel = round * 64 + xcd * 8 + (j & 7); u.pn = j >> 3; }
            else { if (j >= 8) return false; panel = full * 64 + 2 * xcd + (j & 1); u.pn = j >> 1; if (panel >= nM) return false; }
            u.pm = skip ? (panel + panel / 8 + 1) : panel;
            return true;
        }
        const long L = (long)i * G + c; if (L >= nwg) return false;
        int wgid = (int)L; { const int q = nwg / NXCD, r = nwg % NXCD, xcd = wgid % NXCD, off = wgid / NXCD; wgid = (xcd < r ? xcd * (q + 1) : r * (q + 1) + (xcd - r) * q) + off; }
        const int nig = WGM * nN, gid = wgid / nig, fm = gid * WGM, gsz = (nM - fm) < WGM ? (nM - fm) : WGM;
        int pm = fm + ((wgid % nig) % gsz); u.pn = (wgid % nig) / gsz;
        u.pm = skip ? (pm + pm / 8 + 1) : pm;
        return true;
    }
};

enum { EPI_PLAIN = 0, EPI_SWIGLU = 1, EPI_QKV_DA = 2, EPI_QKV_NA = 3, EPI_RWKV = 4 };
struct Epi {
    static constexpr bool PERM = true;
    int mode; bf16_t* O; int ldc; const float* cosT; const float* sinT;
    DI void operator()(const f32x4 (&acc)[2][2][4][2], const Unit& u, int wr, int wc, int fr, int fq) const {
        const int row0 = u.pm * BM + wr * 64 + fr;
        if (mode == EPI_SWIGLU) {
            const int col0 = u.pn * 128 + wc * 32 + 8 * fq;
#pragma unroll
            for (int ai = 0; ai < 2; ++ai)
#pragma unroll
                for (int m = 0; m < 4; ++m) {
                    bf16_t* rowp = O + (size_t)(row0 + ai * HALF + m * 16) * ldc + col0;
                    const f32x4 a0 = acc[ai][0][m][0], a1 = acc[ai][0][m][1], b0 = acc[ai][1][m][0], b1 = acc[ai][1][m][1];
                    u32x4 w;
                    w.x = pk2(siluf_(a0[0]) * b0[0], siluf_(a0[1]) * b0[1]); w.y = pk2(siluf_(a0[2]) * b0[2], siluf_(a0[3]) * b0[3]);
                    w.z = pk2(siluf_(a1[0]) * b1[0], siluf_(a1[1]) * b1[1]); w.w = pk2(siluf_(a1[2]) * b1[2], siluf_(a1[3]) * b1[3]);
                    *(u32x4*)rowp = w;
                }
        } else {
            const int col0 = u.pn * BM + wc * 32 + 8 * fq;
            const int jt = u.pm % 9;
            float sc = 1.f; bool rope = false; int act0 = 0, act1 = 0;
            if (mode == EPI_QKV_DA) { if (u.pn < 4) sc = QSCALE; if (u.pn < 8 && jt != 0) rope = true; }
            else if (mode == EPI_QKV_NA) { if (u.pn < 4) sc = QSCALE; }
            else if (mode == EPI_RWKV) { if (u.pn == 12) act0 = 1; if (u.pn == 13) { act0 = 2; act1 = 2; } }
#pragma unroll
            for (int ai = 0; ai < 2; ++ai)
#pragma unroll
                for (int m = 0; m < 4; ++m) {
                    bf16_t* rowp = O + (size_t)(row0 + ai * HALF + m * 16) * ldc + col0;
                    f32x4 c0 = {1.f, 1.f, 1.f, 1.f}, c1 = c0, s0 = {0.f, 0.f, 0.f, 0.f}, s1 = s0;
                    if (rope) {
                        const int t = (jt - 1) * 256 + ai * HALF + wr * 64 + m * 16 + fr;
                        const int pos = (wc & 1) ? (t & 63) : (t >> 6);
                        const float* cp = cosT + pos * 16 + 8 * (fq & 1); const float* sp = sinT + pos * 16 + 8 * (fq & 1);
                        c0 = *(const f32x4*)cp; c1 = *(const f32x4*)(cp + 4); s0 = *(const f32x4*)sp; s1 = *(const f32x4*)(sp + 4);
                        if (!(fq & 2)) { s0 = -s0; s1 = -s1; }
                    }
#pragma unroll
                    for (int bj = 0; bj < 2; ++bj) {
                        f32x4 v0 = acc[ai][bj][m][0], v1 = acc[ai][bj][m][1];
                        if (rope) {
                            f32x4 p0, p1;
#pragma unroll
                            for (int e = 0; e < 4; ++e) { p0[e] = __shfl_xor(v0[e], 32); p1[e] = __shfl_xor(v1[e], 32); }
                            v0 = v0 * c0 + p0 * s0; v1 = v1 * c1 + p1 * s1;
                        }
                        v0 = v0 * sc; v1 = v1 * sc;
                        const int act = bj ? act1 : act0;
                        if (act == 1) {
#pragma unroll
                            for (int e = 0; e < 4; ++e) { v0[e] = tanhf_(v0[e]); v1[e] = tanhf_(v1[e]); }
                        } else if (act == 2) {
#pragma unroll
                            for (int e = 0; e < 4; ++e) { v0[e] = sigmoidf_(v0[e]); v1[e] = sigmoidf_(v1[e]); }
                        }
                        u32x4 w; w.x = pk2(v0[0], v0[1]); w.y = pk2(v0[2], v0[3]); w.z = pk2(v1[0], v1[1]); w.w = pk2(v1[2], v1[3]);
                        *(u32x4*)(rowp + bj * HALF) = w;
                    }
                }
        }
    }
};

DI void gemm_phase(LAS unsigned char* lds, const int tid, const Gemm g, const StaticOrder& S, const Epi& E) {
    const int wid = __builtin_amdgcn_readfirstlane(tid >> 6), lane = tid & 63, wr = wid >> 2, wc = wid & 3, fr = lane & 15, fq = lane >> 4;
    const int K = g.K, nt = K / BK;
    unsigned voffA[2], voffB[2];
#pragma unroll
    for (int i = 0; i < 2; ++i) { int R, C; stage_rc(tid * 16 + i * 8192, R, C); const int Rb = (R & ~31) + perm32(R & 31);
        voffA[i] = (unsigned)(R * g.lda + C) * 2u; voffB[i] = (unsigned)(Rb * g.ldb + C) * 2u; }
    const size_t kstep = (size_t)(BK * 2);
    const size_t hstepA = (size_t)HALF * g.lda * 2, hstepB = (size_t)HALF * g.ldb * 2;
    const size_t tstepA = 2 * hstepA, tstepB = 2 * hstepB;
    const unsigned ldsw = (unsigned)wid * 1024u;
    const int aoff = lds_byte(wr * 64 + fr, fq * 8), boff = lds_byte(wc * 32 + fr, fq * 8);
#define PG8_SA(b, h) (((b) * 2 + (h)) * HTB)
#define PG8_SB(b, h) ((4 + (b) * 2 + (h)) * HTB)
#define PG8_STAGE(bufoff, gbase, voff) do { _Pragma("unroll") for (int _i = 0; _i < 2; ++_i) \
        __builtin_amdgcn_global_load_lds((const unsigned*)((const char*)(gbase) + (voff)[_i]), (LAS unsigned*)(lds + (bufoff) + ldsw + _i * 8192), 16, 0, 0); } while (0)
#define PG8_LDA(dst, b, h) do { _Pragma("unroll") for (int m = 0; m < 4; ++m) _Pragma("unroll") for (int k = 0; k < 2; ++k) dst[m][k] = *(const LAS bf16x8*)(lds + PG8_SA(b, h) + aoff + m * 2048 + k * 1024); } while (0)
#define PG8_LDB(dst, b, h) do { _Pragma("unroll") for (int n = 0; n < 2; ++n) _Pragma("unroll") for (int k = 0; k < 2; ++k) dst[n][k] = *(const LAS bf16x8*)(lds + PG8_SB(b, h) + boff + n * 2048 + k * 1024); } while (0)
#define PG8_MMA(ai, bj, At, Bt) do { __builtin_amdgcn_s_setprio(1); _Pragma("unroll") for (int m = 0; m < 4; ++m) _Pragma("unroll") for (int n = 0; n < 2; ++n) _Pragma("unroll") for (int k = 0; k < 2; ++k) \
        acc[ai][bj][m][n] = __builtin_amdgcn_mfma_f32_16x16x32_bf16(Bt[n][k], At[m][k], acc[ai][bj][m][n], 0, 0, 0); __builtin_amdgcn_s_setprio(0); } while (0)
#define PG8_WAIT_V(n) asm volatile("s_waitcnt vmcnt(" #n ")" ::: "memory")
#define PG8_WAIT_L(n) asm volatile("s_waitcnt lgkmcnt(" #n ")" ::: "memory")
#define PG8_BAR __builtin_amdgcn_s_barrier()
#define PG8_SCHED __builtin_amdgcn_sched_barrier(0)
    Unit cur, nxt; int ui = 0;
    if (!S.next(0, cur)) return;
    f32x4 acc[2][2][4][2];
#pragma unroll
    for (int a = 0; a < 2; ++a)
#pragma unroll
        for (int b = 0; b < 2; ++b)
#pragma unroll
            for (int m = 0; m < 4; ++m)
#pragma unroll
                for (int n = 0; n < 2; ++n) acc[a][b][m][n] = (f32x4){0.f, 0.f, 0.f, 0.f};
    bf16x8 At[4][2], B0[2][2], B1[2][2];
    const char* cA = (const char*)g.A + (size_t)cur.pm * tstepA; const char* cB = (const char*)g.Bt + (size_t)cur.pn * tstepB;
    PG8_STAGE(PG8_SB(0, 0), cB, voffB); PG8_STAGE(PG8_SB(0, 1), cB + hstepB, voffB); PG8_STAGE(PG8_SA(0, 0), cA, voffA); PG8_STAGE(PG8_SA(0, 1), cA + hstepA, voffA);
    if (wr == 1) PG8_BAR;
    PG8_WAIT_V(2); PG8_BAR;
    PG8_STAGE(PG8_SB(1, 0), cB + kstep, voffB); PG8_STAGE(PG8_SA(1, 0), cA + kstep, voffA); PG8_STAGE(PG8_SB(1, 1), cB + hstepB + kstep, voffB);
    PG8_WAIT_V(6); PG8_BAR;
    for (;;) {
        const bool has_next = S.next(ui + 1, nxt);
        const char* nA = has_next ? (const char*)g.A + (size_t)nxt.pm * tstepA : cA; const char* nB = has_next ? (const char*)g.Bt + (size_t)nxt.pn * tstepB : cB;
        for (int t = 0; t < nt; t += 2) {
            const bool last = (t == nt - 2);
            const char* a1 = cA + (size_t)(t + 1) * kstep;
            const char* a2 = last ? nA : cA + (size_t)(t + 2) * kstep; const char* b2 = last ? nB : cB + (size_t)(t + 2) * kstep;
            const char* a3 = a2 + kstep; const char* b3 = b2 + kstep;
            PG8_LDB(B0, 0, 0); PG8_LDB(B1, 0, 1); PG8_SCHED; PG8_LDA(At, 0, 0); PG8_STAGE(PG8_SA(1, 1), a1 + hstepA, voffA);
            PG8_WAIT_V(8); PG8_WAIT_L(0); PG8_BAR; PG8_MMA(0, 0, At, B0); PG8_MMA(0, 1, At, B1); PG8_BAR; PG8_SCHED;
            PG8_LDA(At, 0, 1); PG8_STAGE(PG8_SB(0, 0), b2, voffB); PG8_STAGE(PG8_SB(0, 1), b2 + hstepB, voffB); PG8_STAGE(PG8_SA(0, 0), a2, voffA);
            PG8_WAIT_V(8); PG8_WAIT_L(0); PG8_BAR; PG8_MMA(1, 0, At, B0); PG8_MMA(1, 1, At, B1); PG8_BAR; PG8_SCHED;
            PG8_LDB(B0, 1, 0); PG8_LDB(B1, 1, 1); PG8_SCHED; PG8_LDA(At, 1, 0); PG8_STAGE(PG8_SA(0, 1), a2 + hstepA, voffA);
            PG8_WAIT_V(8); PG8_WAIT_L(0); PG8_BAR; PG8_MMA(0, 0, At, B0); PG8_MMA(0, 1, At, B1); PG8_BAR; PG8_SCHED;
            PG8_LDA(At, 1, 1); PG8_STAGE(PG8_SB(1, 0), b3, voffB); PG8_STAGE(PG8_SB(1, 1), b3 + hstepB, voffB); PG8_STAGE(PG8_SA(1, 0), a3, voffA);
            PG8_WAIT_V(8); PG8_WAIT_L(0); PG8_BAR; PG8_MMA(1, 0, At, B0); PG8_MMA(1, 1, At, B1); PG8_BAR; PG8_SCHED;
        }
        if (wr == 0) PG8_BAR;
        E(acc, cur, wr, wc, fr, fq);
        if (!has_next) break;
#pragma unroll
        for (int a = 0; a < 2; ++a)
#pragma unroll
            for (int b = 0; b < 2; ++b)
#pragma unroll
                for (int m = 0; m < 4; ++m)
#pragma unroll
                    for (int n = 0; n < 2; ++n) acc[a][b][m][n] = (f32x4){0.f, 0.f, 0.f, 0.f};
        cur = nxt; cA = nA; cB = nB; ++ui;
        if (wr == 1) PG8_BAR;
    }
    PG8_WAIT_V(0);
    PG8_BAR;
#undef PG8_SA
#undef PG8_SB
#undef PG8_STAGE
#undef PG8_LDA
#undef PG8_LDB
#undef PG8_MMA
#undef PG8_WAIT_V
#undef PG8_WAIT_L
#undef PG8_BAR
#undef PG8_SCHED
}
}

struct Args { const float* in[32]; float* out; unsigned char* ws; };

struct Frame {
    LAS unsigned char* lds;
    int tid, lane, wave, vcu, G, gw, NGW, bx;
    const float* const* in;
};
enum { I_X = 0, I_C, I_CTX, I_CCTX, I_ADAW, I_ADAB, I_NORMG, I_FWIN, I_FWOUT, I_DAWIN, I_DAWOUT, I_DALAM, I_DASUB, I_NAWIN, I_NAWOUT, I_NARPB,
       I_RWMU, I_RWWIN, I_RWWOUT, I_RWW0, I_RWW1, I_RWW2, I_RWA0, I_RWA1, I_RWA2, I_RWG1, I_RWG2, I_RWKK, I_RWKA, I_RWRK, I_RWLNG, I_RWLNB };

DI void conv_item(const float* W, int ldw, int k0, int n0, int kmax, const float* mu, bf16_t* dst, int ldd, int dst_row0, int dst_k0, LAS float* scr, int lane) {
    float cv[32];
#pragma unroll
    for (int i = 0; i < 32; ++i) { const int k = k0 + 2 * i + (lane >> 5); cv[i] = (k < kmax) ? W[(size_t)k * ldw + n0 + (lane & 31)] : 0.f; }
    if (mu) {
#pragma unroll
        for (int i = 0; i < 32; ++i) { const int k = k0 + 2 * i + (lane >> 5); cv[i] *= (k < kmax) ? mu[k] : 0.f; }
    }
#pragma unroll
    for (int i = 0; i < 32; ++i) scr[(2 * i + (lane >> 5)) * 33 + (lane & 31)] = cv[i];
    asm volatile("s_waitcnt lgkmcnt(0)" ::: "memory");
    const int c = lane & 7;
#pragma unroll
    for (int j = 0; j < 4; ++j) { const int n = (lane >> 3) + 8 * j; const LAS float* s = scr + (8 * c) * 33 + n;
        u32x4 o; o.x = pk2(s[0 * 33], s[1 * 33]); o.y = pk2(s[2 * 33], s[3 * 33]); o.z = pk2(s[4 * 33], s[5 * 33]); o.w = pk2(s[6 * 33], s[7 * 33]);
        *(u32x4*)(dst + (size_t)(dst_row0 + n) * ldd + dst_k0 + k0 + 8 * c) = o; }
    asm volatile("s_waitcnt lgkmcnt(0)" ::: "memory");
}

DI void convert_layer(Frame& F, unsigned char* ws, int l) {
    bf16_t* WB = (bf16_t*)(ws + WS_WB);
    LAS float* scr = (LAS float*)(F.lds + F.wave * 16384);
    const int kind = l % 3, slot = l / 3;
    constexpr int I_FIN = 16 * 176, I_FOUT = 44 * 32, I_MIN = 16 * 96, I_MOUT = 16 * 32;
    const float* fwin = F.in[I_FWIN] + (size_t)l * 2 * 1024 * 5632;
    const float* fwout = F.in[I_FWOUT] + (size_t)l * 2 * 2816 * 1024;
    int nitems = 2 * I_FIN + 2 * I_FOUT + I_MOUT;
    if (kind == 2) nitems += 2 * I_MIN + 4 * 16 * 2 * 2 + 16 * 5 * 2 + 4 * 32 + 96;
    else nitems += I_MIN;
    for (int it = F.gw; it < nitems; it += F.NGW) {
        int r = it;
        if (r < 2 * I_FIN) { const int s = r / I_FIN; r -= s * I_FIN; const int kb = r / 176, nb = r % 176, n0 = nb * 32;
            const int hf = n0 / 2816, rem = n0 % 2816, p = rem / 128, i = rem % 128;
            conv_item(fwin + (size_t)s * 1024 * 5632, 5632, kb * 64, n0, 1024, nullptr, WB + (s ? WB_IN1 : WB_IN0), 1024, p * 256 + hf * 128 + i, 0, scr, F.lane); continue; }
        r -= 2 * I_FIN;
        if (r < 2 * I_FOUT) { const int s = r / I_FOUT; r -= s * I_FOUT; const int kb = r / 32, nb = r % 32;
            conv_item(fwout + (size_t)s * 2816 * 1024, 1024, kb * 64, nb * 32, 2816, nullptr, WB + (s ? WB_OUT1 : WB_OUT0), 2816, nb * 32, 0, scr, F.lane); continue; }
        r -= 2 * I_FOUT;
        if (r < I_MOUT) { const float* w = kind == 0 ? F.in[I_DAWOUT] + (size_t)slot * 1024 * 1024 : kind == 1 ? F.in[I_NAWOUT] : F.in[I_RWWOUT];
            const int kb = r / 32, nb = r % 32;
            conv_item(w, 1024, kb * 64, nb * 32, 1024, nullptr, WB + WB_MIXOUT, 1024, nb * 32, 0, scr, F.lane); continue; }
        r -= I_MOUT;
        if (kind != 2) { const float* w = kind == 0 ? F.in[I_DAWIN] + (size_t)slot * 1024 * 3072 : F.in[I_NAWIN];
            const int kb = r / 96, nb = r % 96;
            conv_item(w, 3072, kb * 64, nb * 32, 1024, nullptr, WB + WB_MIXIN, 1024, nb * 32, 0, scr, F.lane); continue; }
        const float* mu = F.in[I_RWMU];
        if (r < 2 * I_MIN) { const int var = r / I_MIN; r -= var * I_MIN; const int kb = r / 96, nb = r % 96, n0 = nb * 32;
            const int mj = n0 < 1024 ? 0 : (n0 < 2048 ? 2 : 3);
            conv_item(F.in[I_RWWIN], 3072, kb * 64, n0, 1024, var ? mu + mj * 1024 : nullptr, WB + WB_MIXIN, 2048, n0, var * 1024, scr, F.lane); continue; }
        r -= 2 * I_MIN;
        if (r < 4 * 16 * 2 * 2) { const int var = r & 1; r >>= 1; const int nb = r & 1; r >>= 1; const int kb = r & 15; r >>= 4; const int dir = r & 1, isa = r >> 1;
            const float* w = (isa ? F.in[I_RWA1] : F.in[I_RWW1]) + (size_t)dir * 1024 * 64;
            conv_item(w, 64, kb * 64, nb * 32, 1024, var ? mu + (isa ? 4 : 1) * 1024 : nullptr, WB + WB_MIXIN, 2048, (isa ? 3200 : 3072) + dir * 64 + nb * 32, var * 1024, scr, F.lane); continue; }
        r -= 4 * 16 * 2 * 2;
        if (r < 16 * 5 * 2) { const int var = r & 1; r >>= 1; const int nb = r % 5, kb = r / 5;
            conv_item(F.in[I_RWG1], 160, kb * 64, nb * 32, 1024, var ? mu + 5 * 1024 : nullptr, WB + WB_MIXIN, 2048, 3328 + nb * 32, var * 1024, scr, F.lane); continue; }
        r -= 16 * 5 * 2;
        if (r < 4 * 32) { const int kb = r / 32, nb = r % 32;
            conv_item(F.in[I_RWG2], 1024, kb * 64, nb * 32, 160, nullptr, WB + WB_G2T, 256, nb * 32, 0, scr, F.lane); continue; }
        r -= 4 * 32;
        { bf16_t* z = WB + WB_MIXIN + (size_t)(3488 + r) * 2048;
#pragma unroll
          for (int j = 0; j < 4; ++j) *(u32x4*)(z + (j * 64 + F.lane) * 8) = (u32x4){0u, 0u, 0u, 0u}; }
    }
}

DI void phase0(Frame& F, unsigned char* ws) {
    LAS float* sl = (LAS float*)F.lds;
    LAS float* part = (LAS float*)(F.lds + 69632);
    float* MOD = (float*)(ws + WS_MOD);
    for (int i = F.tid; i < 17 * 1024; i += 512) { const float v = i < 16384 ? F.in[I_C][i] : F.in[I_CCTX][i - 16384]; sl[i] = v / (1.f + expf(-v)); }
    __syncthreads();
    for (int item = F.vcu; item < 4 * 72; item += F.G) {
        const int l = item / 72, n0 = (item % 72) * 128;
        const float* W = F.in[I_ADAW] + (size_t)l * 1024 * NMOD + n0 + 2 * F.lane;
        float acc[17][2];
#pragma unroll
        for (int r = 0; r < 17; ++r) { acc[r][0] = 0.f; acc[r][1] = 0.f; }
        const int kbase = F.wave * 128;
        f32x2 wn[16];
#pragma unroll
        for (int e = 0; e < 16; ++e) wn[e] = *(const f32x2*)(W + (size_t)(kbase + e) * NMOD);
        for (int k16 = 0; k16 < 128; k16 += 16) {
            f32x2 w[16];
#pragma unroll
            for (int e = 0; e < 16; ++e) w[e] = wn[e];
            if (k16 + 16 < 128) {
#pragma unroll
                for (int e = 0; e < 16; ++e) wn[e] = *(const f32x2*)(W + (size_t)(kbase + k16 + 16 + e) * NMOD);
            }
#pragma unroll
            for (int q = 0; q < 4; ++q)
#pragma unroll
                for (int r = 0; r < 17; ++r) { const f32x4 s = *(const LAS f32x4*)(sl + r * 1024 + kbase + k16 + 4 * q);
#pragma unroll
                    for (int e = 0; e < 4; ++e) { acc[r][0] += s[e] * w[4 * q + e].x; acc[r][1] += s[e] * w[4 * q + e].y; } }
        }
#pragma unroll
        for (int r = 0; r < 17; ++r) *(LAS f32x2*)(part + (F.wave * 17 + r) * 128 + 2 * F.lane) = (f32x2){acc[r][0], acc[r][1]};
        __syncthreads();
        for (int idx = F.tid; idx < 17 * 128; idx += 512) { const int r = idx >> 7, cI = idx & 127; float s = 0.f;
#pragma unroll
            for (int w = 0; w < 8; ++w) s += part[(w * 17 + r) * 128 + cI];
            MOD[((size_t)l * 17 + r) * NMOD + n0 + cI] = s + F.in[I_ADAB][(size_t)l * NMOD + n0 + cI]; }
        __syncthreads();
    }
    if (F.bx == 0) {
        for (int i = F.tid; i < 3456; i += 512) ((unsigned*)(ws + WS_BAR))[i] = 0u;
        float* cosT = (float*)(ws + WS_ROPE); float* sinT = cosT + 1024;
        for (int i = F.tid; i < 1024; i += 512) { const int pos = i >> 4, p = i & 15; const float fr = powf(10000.f, -(float)p / 16.f); const float ang = (float)pos * fr; cosT[i] = cosf(ang); sinT[i] = sinf(ang); }
        if (F.tid < 2) { const float* lv = F.in[I_DALAM] + F.tid * 256; float d0 = 0.f, d1 = 0.f;
            for (int i = 0; i < 64; ++i) { d0 += lv[i] * lv[64 + i]; d1 += lv[128 + i] * lv[192 + i]; }
            const float li = 0.8f - 0.6f * expf(-0.3f * (float)(F.tid * 3));
            float* lam = (float*)(ws + WS_LAM); lam[2 * F.tid] = expf(d0) - expf(d1) + li; lam[2 * F.tid + 1] = li; }
    }
    __syncthreads();
    convert_layer(F, ws, 0);
}

struct RowPass {
    const float* hsrc_lat; const float* hsrc_ctx; float* hdst_lat; float* hdst_ctx;
    const bf16_t* Y;
    const float* gpost; int gate_idx; float coef; int lpost;
    const float* gpre; int shift_idx; int lpre;
    bf16_t* U; int ldu; int skip_ctx;
};
DI void row_pass(Frame& F, unsigned char* ws, const RowPass& P, int row_lo, int row_hi, int widx, int nw) {
    const float* MOD = (const float*)(ws + WS_MOD);
    const int rpw = (row_hi - row_lo + nw - 1) / nw;
    const int rbeg = row_lo + widx * rpw, rend = min(rbeg + rpw, row_hi);
    if (rbeg >= rend) return;
    const int l4 = 4 * F.lane;
    f32x4 gpo[4], gpr[4], gat[4], shf[4], scl[4];
#pragma unroll
    for (int j = 0; j < 4; ++j) { gpo[j] = *(const f32x4*)(P.gpost + l4 + 256 * j); gpr[j] = P.gpre ? *(const f32x4*)(P.gpre + l4 + 256 * j) : (f32x4){0.f, 0.f, 0.f, 0.f}; }
    int cur_mrow = -1;
    f32x4 hn[4]; u32x2 yn[4];
#define RP_ADDR(row, isctx, hoff) const int _b = (row) / LROW, _t = (row) % LROW; const bool isctx = _t < CTX; \
        const size_t hoff = isctx ? ((size_t)_b * CTX + _t) * DM : ((size_t)_b * SEQ + (_t - CTX)) * DM;
#define RP_LOAD(row) do { RP_ADDR(row, ic_, ho_) if (!(ic_ && P.skip_ctx)) { const float* hs_ = (ic_ ? P.hsrc_ctx : P.hsrc_lat) + ho_ + l4; \
        _Pragma("unroll") for (int j = 0; j < 4; ++j) hn[j] = *(const f32x4*)(hs_ + 256 * j); \
        if (P.Y) { const bf16_t* yr_ = P.Y + (size_t)(row) * DM + l4; _Pragma("unroll") for (int j = 0; j < 4; ++j) yn[j] = *(const u32x2*)(yr_ + 256 * j); } } } while (0)
    RP_LOAD(rbeg);
    for (int row = rbeg; row < rend; ++row) {
        f32x4 h[4]; u32x2 yv[4];
#pragma unroll
        for (int j = 0; j < 4; ++j) { h[j] = hn[j]; yv[j] = yn[j]; }
        if (row + 1 < rend) RP_LOAD(row + 1);
        RP_ADDR(row, isctx, hoff)
        if (isctx && P.skip_ctx) continue;
        float* hd = (isctx ? P.hdst_ctx : P.hdst_lat) + hoff + l4;
        const bool copy_h = ((isctx ? P.hsrc_ctx : P.hsrc_lat) != (isctx ? P.hdst_ctx : P.hdst_lat));
        const int mrow = isctx ? 16 : _b;
        if (mrow != cur_mrow) { cur_mrow = mrow;
            const float* gate = MOD + ((size_t)P.lpost * 17 + mrow) * NMOD + P.gate_idx * DM + l4;
            const float* sh = MOD + ((size_t)P.lpre * 17 + mrow) * NMOD + P.shift_idx * DM + l4;
#pragma unroll
            for (int j = 0; j < 4; ++j) { gat[j] = *(const f32x4*)(gate + 256 * j) * P.coef; shf[j] = *(const f32x4*)(sh + 256 * j); scl[j] = *(const f32x4*)(sh + DM + 256 * j) + 1.f; } }
        if (P.Y) {
            f32x4 y[4]; float ss = 0.f;
#pragma unroll
            for (int j = 0; j < 4; ++j) { y[j] = (f32x4){bflo(yv[j].x), bfhi(yv[j].x), bflo(yv[j].y), bfhi(yv[j].y)};
                ss += (y[j].x * y[j].x + y[j].y * y[j].y) + (y[j].z * y[j].z + y[j].w * y[j].w); }
            const float rstd = 1.f / sqrtf(wave_sum(ss) * (1.f / DM) + NORM_EPS);
#pragma unroll
            for (int j = 0; j < 4; ++j) h[j] = h[j] + gat[j] * ((y[j] * rstd) * gpo[j]);
        }
        if (P.Y || copy_h) {
#pragma unroll
            for (int j = 0; j < 4; ++j) *(f32x4*)(hd + 256 * j) = h[j];
        }
        if (P.gpre) {
            float ss = 0.f;
#pragma unroll
            for (int j = 0; j < 4; ++j) ss += (h[j].x * h[j].x + h[j].y * h[j].y) + (h[j].z * h[j].z + h[j].w * h[j].w);
            const float rstd = 1.f / sqrtf(wave_sum(ss) * (1.f / DM) + NORM_EPS);
            bf16_t* ur = P.U + (size_t)row * P.ldu + l4;
#pragma unroll
            for (int j = 0; j < 4; ++j) { const f32x4 u = ((h[j] * rstd) * gpr[j]) * scl[j] + shf[j];
                *(u32x2*)(ur + 256 * j) = (u32x2){pk2(u.x, u.y), pk2(u.z, u.w)}; }
        }
    }
#undef RP_ADDR
#undef RP_LOAD
}

DI void xx_pass(Frame& F, unsigned char* ws) {
    bf16_t* U = (bf16_t*)(ws + WS_U);
    u32x4 nc[2], np[2], nn[2];
#define XX_LOAD(row_) do { const int t_ = (row_) % LROW; const bool fi_ = (t_ == 0) || (t_ == CTX), la_ = (t_ == CTX - 1) || (t_ == LROW - 1); \
        const bf16_t* ur_ = U + (size_t)(row_) * 2048 + 8 * F.lane; \
        _Pragma("unroll") for (int j = 0; j < 2; ++j) { nc[j] = *(const u32x4*)(ur_ + 512 * j); np[j] = (u32x4){0u, 0u, 0u, 0u}; nn[j] = np[j]; \
            if (!fi_) np[j] = *(const u32x4*)(ur_ - 2048 + 512 * j); if (!la_) nn[j] = *(const u32x4*)(ur_ + 2048 + 512 * j); } } while (0)
    if (F.gw < MROWS) XX_LOAD(F.gw);
    for (int row = F.gw; row < MROWS; row += F.NGW) {
        u32x4 c[2], p[2], n[2];
#pragma unroll
        for (int j = 0; j < 2; ++j) { c[j] = nc[j]; p[j] = np[j]; n[j] = nn[j]; }
        if (row + F.NGW < MROWS) XX_LOAD(row + F.NGW);
        bf16_t* ur = U + (size_t)row * 2048 + 8 * F.lane;
#pragma unroll
        for (int j = 0; j < 2; ++j) {
            u32x4 o;
#pragma unroll
            for (int e = 0; e < 4; ++e) { const float lo = 0.5f * (bflo(p[j][e]) + bflo(n[j][e])) - bflo(c[j][e]); const float hi = 0.5f * (bfhi(p[j][e]) + bfhi(n[j][e])) - bfhi(c[j][e]); o[e] = pk2(lo, hi); }
            *(u32x4*)(ur + 1024 + 512 * j) = o;
        }
    }
#undef XX_LOAD
}

DI f32x16 mfma32(bf16x8 a, bf16x8 b, f32x16 c) { return __builtin_amdgcn_mfma_f32_32x32x16_bf16(a, b, c, 0, 0, 0); }
DI bf16x8 pack8(const f32x16& x, int s) { u32x4 p; p.x = pk2(x[8 * s], x[8 * s + 1]); p.y = pk2(x[8 * s + 2], x[8 * s + 3]); p.z = pk2(x[8 * s + 4], x[8 * s + 5]); p.w = pk2(x[8 * s + 6], x[8 * s + 7]); return __builtin_bit_cast(bf16x8, p); }
typedef short v4i16_t __attribute__((ext_vector_type(4)));
DI s16x4 vtr(LAS const unsigned char* p) { return __builtin_bit_cast(s16x4, __builtin_amdgcn_ds_read_tr16_b64_v4i16((LAS v4i16_t*)p)); }
DI float max3f(float a, float b, float c) { return __builtin_fmaxf(__builtin_fmaxf(a, b), c); }
DI float max16(const f32x16& p) { float a = max3f(p[0], p[1], p[2]), b = max3f(p[3], p[4], p[5]);
    a = max3f(a, p[6], p[7]); b = max3f(b, p[8], p[9]); a = max3f(a, p[10], p[11]); b = max3f(b, p[12], p[13]); a = max3f(a, p[14], p[15]); return __builtin_fmaxf(a, b); }

template <int NDB>
DI void softmax_pv(f32x16& p0, f32x16& p1, f32x16 (&o)[NDB], f32x16& negm, float& m_run, float& l_run, const bool first, LAS float* wsf, LAS const unsigned char* Vb, int KP, int r, int hh, int lane) {
    const int i16 = lane & 15, q4 = i16 >> 2, p4 = i16 & 3, g1 = (lane >> 4) & 1;
    LAS const unsigned char* vl = Vb + (4 * hh + q4) * 64 + 32 * g1 + 8 * p4;
    s16x4 flo[2][NDB], fhi[2][NDB];
#pragma unroll
    for (int d = 0; d < NDB; ++d) { flo[0][d] = vtr(vl + d * 4096); fhi[0][d] = vtr(vl + 8 * 64 + d * 4096); }
    __builtin_amdgcn_sched_barrier(0);
    float mx = __builtin_fmaxf(max16(p0), max16(p1)); mx = __builtin_fmaxf(mx, __shfl_xor(mx, 32));
    if (first || __any(mx > 8.f)) {
        const float delta = first ? mx : __builtin_fmaxf(mx, 0.f);
        m_run += delta;
#pragma unroll
        for (int i = 0; i < 16; ++i) { p0[i] -= delta; p1[i] -= delta; negm[i] = -m_run; }
        if (!first) {
            const float alpha = __builtin_amdgcn_exp2f(-delta);
            l_run *= alpha;
            if (hh == 0) wsf[r] = alpha;
#pragma unroll
            for (int g4 = 0; g4 < 4; ++g4) { const f32x4 a4 = *(const LAS f32x4*)(wsf + 8 * g4 + 4 * hh);
#pragma unroll
                for (int d = 0; d < NDB; ++d)
#pragma unroll
                    for (int e = 0; e < 4; ++e) o[d][4 * g4 + e] *= a4[e]; }
        }
    }
    f32x2 ls2 = {0.f, 0.f};
#pragma unroll
    for (int i = 0; i < 16; i += 2) {
        p0[i] = __builtin_amdgcn_exp2f(p0[i]); p0[i + 1] = __builtin_amdgcn_exp2f(p0[i + 1]); p1[i] = __builtin_amdgcn_exp2f(p1[i]); p1[i + 1] = __builtin_amdgcn_exp2f(p1[i + 1]);
        ls2 += (f32x2){p0[i], p0[i + 1]}; ls2 += (f32x2){p1[i], p1[i + 1]};
    }
    l_run += ls2.x + ls2.y;
    const bf16x8 pa[4] = {pack8(p0, 0), pack8(p0, 1), pack8(p1, 0), pack8(p1, 1)};
#pragma unroll
    for (int k = 0; k < 4; ++k) {
        if (k + 1 < 4) {
            LAS const unsigned char* vk = vl + 16 * (k + 1) * 64;
#pragma unroll
            for (int d = 0; d < NDB; ++d) { flo[(k + 1) & 1][d] = vtr(vk + d * 4096); fhi[(k + 1) & 1][d] = vtr(vk + 8 * 64 + d * 4096); }
        }
        __builtin_amdgcn_sched_barrier(0);
#pragma unroll
        for (int d = 0; d < NDB; ++d) { const bf16x8 vb = __builtin_shufflevector(flo[k & 1][d], fhi[k & 1][d], 0, 1, 2, 3, 4, 5, 6, 7); o[d] = mfma32(pa[k], vb, o[d]); }
        __builtin_amdgcn_sched_barrier(0);
    }
}

DI void da_pv_plain(const bf16x8 (&pa)[4], f32x16 (&o)[4], LAS const unsigned char* Vb, int hh, int lane) {
    const int i16 = lane & 15, q4 = i16 >> 2, p4 = i16 & 3, g1 = (lane >> 4) & 1;
    LAS const unsigned char* vl = Vb + (4 * hh + q4) * 64 + 32 * g1 + 8 * p4;
#pragma unroll
    for (int k = 0; k < 4; ++k) {
        s16x4 lo[4], hi[4];
#pragma unroll
        for (int d = 0; d < 4; ++d) { lo[d] = vtr(vl + 16 * k * 64 + d * 4096); hi[d] = vtr(vl + 16 * k * 64 + 8 * 64 + d * 4096); }
#pragma unroll
        for (int d = 0; d < 4; ++d) { const bf16x8 vb = __builtin_shufflevector(lo[d], hi[d], 0, 1, 2, 3, 4, 5, 6, 7); o[d] = mfma32(pa[k], vb, o[d]); }
    }
}
DI void da_step(f32x16& p0, f32x16& p1, f32x16 (&o)[4], float& m_run, float& l_run, bf16x8 (&pa)[4], const bool first, LAS float* wsf, LAS const unsigned char* Vprev, int r, int hh, int lane) {
    float mx = __builtin_fmaxf(max16(p0), max16(p1)); mx = __builtin_fmaxf(mx, __shfl_xor(mx, 32));
    const bool need = first || __any(mx > 8.f);
    float delta = 0.f;
    if (need) { delta = first ? mx : __builtin_fmaxf(mx, 0.f); m_run += delta;
#pragma unroll
        for (int i = 0; i < 16; ++i) { p0[i] -= delta; p1[i] -= delta; } }
    const int i16 = lane & 15, q4 = i16 >> 2, p4 = i16 & 3, g1 = (lane >> 4) & 1;
    LAS const unsigned char* vl = Vprev + (4 * hh + q4) * 64 + 32 * g1 + 8 * p4;
    s16x4 flo[2][4], fhi[2][4];
#pragma unroll
    for (int d = 0; d < 4; ++d) { flo[0][d] = vtr(vl + d * 4096); fhi[0][d] = vtr(vl + 8 * 64 + d * 4096); }
    u32x4 pn[4]; f32x2 ls2 = {0.f, 0.f};
#pragma unroll
    for (int k = 0; k < 4; ++k) {
#pragma unroll
        for (int d = 0; d < 4; ++d) {
            __builtin_amdgcn_sched_barrier(0);
            { const bf16x8 vb = __builtin_shufflevector(flo[k & 1][d], fhi[k & 1][d], 0, 1, 2, 3, 4, 5, 6, 7); o[d] = mfma32(pa[k], vb, o[d]); }
            if (k + 1 < 4) { flo[(k + 1) & 1][d] = vtr(vl + 16 * (k + 1) * 64 + d * 4096); fhi[(k + 1) & 1][d] = vtr(vl + 16 * (k + 1) * 64 + 8 * 64 + d * 4096); }
            const int i = 8 * (k & 1) + 2 * d;
            if (k < 2) { p0[i] = __builtin_amdgcn_exp2f(p0[i]); p0[i + 1] = __builtin_amdgcn_exp2f(p0[i + 1]); ls2 += (f32x2){p0[i], p0[i + 1]}; pn[k][d] = pk2(p0[i], p0[i + 1]); }
            else       { p1[i] = __builtin_amdgcn_exp2f(p1[i]); p1[i + 1] = __builtin_amdgcn_exp2f(p1[i + 1]); ls2 += (f32x2){p1[i], p1[i + 1]}; pn[k][d] = pk2(p1[i], p1[i + 1]); }
        }
    }
    __builtin_amdgcn_sched_barrier(0);
#pragma unroll
    for (int k = 0; k < 4; ++k) pa[k] = __builtin_bit_cast(bf16x8, pn[k]);
    if (need && !first) {
        const float alpha = __builtin_amdgcn_exp2f(-delta);
        l_run *= alpha;
        if (hh == 0) wsf[r] = alpha;
#pragma unroll
        for (int g4 = 0; g4 < 4; ++g4) { const f32x4 a4 = *(const LAS f32x4*)(wsf + 8 * g4 + 4 * hh);
#pragma unroll
            for (int d = 0; d < 4; ++d)
#pragma unroll
                for (int e = 0; e < 4; ++e) o[d][4 * g4 + e] *= a4[e]; }
    }
    l_run += ls2.x + ls2.y;
}

DI void da_unit(LAS unsigned char* lds, const int tid, const bf16_t* QKV, bf16_t* O, int q_row0, int kv_row0, int NT, int h, float lam, float one_m_li, const float* subg) {
    const int lane = tid & 63, wid = __builtin_amdgcn_readfirstlane(tid >> 6), r = lane & 31, hh = lane >> 5;
    const int qg = wid >> 1, j = wid & 1;
    constexpr int KP = 272, STG = 2 * 64 * KP;
    LAS float* wsf = (LAS float*)(lds + 3 * STG) + wid * 64;
    const bf16_t* gbase = QKV + (size_t)(kv_row0 + (tid >> 4)) * 3072 + 1024 + h * 128 + (tid & 15) * 8;
    const int lbase = (tid >> 4) * KP + (tid & 15) * 16;
    const int vbase = 64 * KP + ((tid & 15) >> 2) * 4096 + (tid >> 4) * 64 + (tid & 3) * 16;
    u32x4 st[4];
#define DA_LOAD(t) do { _Pragma("unroll") for (int i = 0; i < 4; ++i) st[i] = *(const u32x4*)(gbase + (size_t)(t) * 64 * 3072 + (size_t)(i & 1) * 32 * 3072 + (i >> 1) * 1024); } while (0)
#define DA_STORE(boff) do { _Pragma("unroll") for (int i = 0; i < 2; ++i) { *(LAS u32x4*)(lds + (boff) + lbase + i * 32 * KP) = st[i]; *(LAS u32x4*)(lds + (boff) + vbase + i * 32 * 64) = st[2 + i]; } } while (0)
    const bf16_t* qp = QKV + (size_t)(q_row0 + 32 * qg + r) * 3072 + h * 128 + j * 64 + 8 * hh;
    bf16x8 qr[4];
#pragma unroll
    for (int d0 = 0; d0 < 4; ++d0) qr[d0] = *(const bf16x8*)(qp + 16 * d0);
    f32x16 o[4];
#pragma unroll
    for (int d = 0; d < 4; ++d)
#pragma unroll
        for (int i = 0; i < 16; ++i) o[d][i] = 0.f;
    float m_run = 0.f, l_run = 0.f;
    bf16x8 pa[4];
#pragma unroll
    for (int k = 0; k < 4; ++k) pa[k] = (bf16x8){0, 0, 0, 0, 0, 0, 0, 0};
    DA_LOAD(0); DA_STORE(0);
    { LAS u32x4* z = (LAS u32x4*)(lds + 2 * STG + 64 * KP) + tid; z[0] = (u32x4){0u, 0u, 0u, 0u}; z[512] = (u32x4){0u, 0u, 0u, 0u}; }
    __syncthreads();
    int b_prv = 2 * STG, b_cur = 0, b_nxt = STG;
    for (int t = 0; t < NT; ++t) {
        if (t + 1 < NT) DA_LOAD(t + 1);
        LAS const unsigned char* Kb = lds + b_cur + j * 128 + r * KP + hh * 16;
        f32x16 p0, p1;
        { const float nm = -m_run;
#pragma unroll
          for (int i = 0; i < 16; ++i) { p0[i] = nm; p1[i] = nm; } }
#pragma unroll
        for (int d0 = 0; d0 < 4; ++d0) { const bf16x8 k0 = *(const LAS bf16x8*)(Kb + d0 * 32), k1 = *(const LAS bf16x8*)(Kb + 32 * KP + d0 * 32);
            p0 = mfma32(k0, qr[d0], p0); p1 = mfma32(k1, qr[d0], p1); }
        da_step(p0, p1, o, m_run, l_run, pa, t == 0, wsf, lds + b_prv + 64 * KP, r, hh, lane);
        if (t + 1 < NT) DA_STORE(b_nxt);
        LDS_BARRIER();
        { const int tmp_ = b_prv; b_prv = b_cur; b_cur = b_nxt; b_nxt = tmp_; }
    }
    da_pv_plain(pa, o, lds + b_prv + 64 * KP, hh, lane);
    LDS_BARRIER();
#undef DA_LOAD
#undef DA_STORE
    const float lt = l_run + __shfl_xor(l_run, 32);
    if (hh == 0) wsf[r] = 1.f / lt;
    float rl[16];
#pragma unroll
    for (int g4 = 0; g4 < 4; ++g4) { const f32x4 a4 = *(const LAS f32x4*)(wsf + 8 * g4 + 4 * hh);
#pragma unroll
        for (int e = 0; e < 4; ++e) rl[4 * g4 + e] = a4[e]; }
    LAS float* R = (LAS float*)lds + qg * 32 * 132;
    if (j == 1) {
#pragma unroll
        for (int d = 0; d < 4; ++d)
#pragma unroll
            for (int i = 0; i < 16; ++i) R[((i & 3) + 8 * (i >> 2) + 4 * hh) * 132 + d * 32 + r] = o[d][i] * rl[i] * lam;
    }
    __syncthreads();
    if (j == 0) {
#pragma unroll
        for (int d = 0; d < 4; ++d)
#pragma unroll
            for (int i = 0; i < 16; ++i) { const int idx = ((i & 3) + 8 * (i >> 2) + 4 * hh) * 132 + d * 32 + r; R[idx] = o[d][i] * rl[i] - R[idx]; }
    }
    __syncthreads();
    {
        const int row = tid >> 2, qtr = tid & 3;
        LAS const float* rp = (LAS const float*)lds + (row >> 5) * 32 * 132 + (row & 31) * 132 + qtr * 32;
        f32x4 v[8]; float ss = 0.f;
#pragma unroll
        for (int c = 0; c < 8; ++c) { v[c] = *(const LAS f32x4*)(rp + 4 * c); ss += (v[c].x * v[c].x + v[c].y * v[c].y) + (v[c].z * v[c].z + v[c].w * v[c].w); }
        ss += __shfl_xor(ss, 1); ss += __shfl_xor(ss, 2);
        const float rs = one_m_li / sqrtf(ss * (1.f / 128.f) + NORM_EPS);
        bf16_t* op = O + (size_t)(q_row0 + row) * DM + h * 128 + qtr * 32;
        const float* gp = subg + qtr * 32;
#pragma unroll
        for (int c = 0; c < 4; ++c) { const f32x4 g0 = *(const f32x4*)(gp + 8 * c), g1 = *(const f32x4*)(gp + 8 * c + 4); const f32x4 a = v[2 * c] * rs * g0, b = v[2 * c + 1] * rs * g1;
            *(u32x4*)(op + 8 * c) = (u32x4){pk2(a.x, a.y), pk2(a.z, a.w), pk2(b.x, b.y), pk2(b.z, b.w)}; }
    }
    __syncthreads();
}

DI void da_phase(Frame& F, unsigned char* ws, int l) {
    const bf16_t* QKV = (const bf16_t*)(ws + WS_ACT); bf16_t* O = (bf16_t*)(ws + WS_U);
    const int slot = l / 3; const bool last = (l == 3);
    const float* lamv = (const float*)(ws + WS_LAM); const float lam = lamv[2 * slot], li = lamv[2 * slot + 1];
    const float* subg = F.in[I_DASUB] + slot * 128;
    const int nunits = 2048 + (last ? 0 : 256);
    for (int u = F.vcu; u < nunits; u += F.G) {
        if (u < 2048) { const int bh = u >> 4, qt = u & 15, b = bh >> 3, h = bh & 7;
            da_unit(F.lds, F.tid, QKV, O, b * LROW + CTX + qt * 128, b * LROW, 36, h, lam, 1.f - li, subg); }
        else { const int v = u - 2048, bh = v >> 1, qt = v & 1, b = bh >> 3, h = bh & 7;
            da_unit(F.lds, F.tid, QKV, O, b * LROW + qt * 128, b * LROW, 4, h, lam, 1.f - li, subg); }
    }
}

DI void na_unit(LAS unsigned char* lds, const int tid, const bf16_t* QKV, bf16_t* O, const float* rpb, int b, int h, int R, int ctxq) {
    const int lane = tid & 63, wid = __builtin_amdgcn_readfirstlane(tid >> 6), r = lane & 31, hh = lane >> 5;
    constexpr int KP = 144, STG = 2 * 64 * KP;
    LAS float* wsf = (LAS float*)(lds + 2 * STG) + wid * 64;
    LAS float* rpbL = (LAS float*)(lds + 2 * STG + 2048);
    const int rw = 4 * R + (wid >> 1), cq = 32 * (wid & 1) + r;
    const int rs_w = min(max(rw - 4, 0), 24);
    const int rlo = min(max(4 * R - 4, 0), 24), rhi = min(max(4 * R - 1, 0), 24) + 7;
    const int NT = ctxq ? 4 : 4 + (rhi - rlo + 1);
    const int q_row = ctxq ? b * LROW + 32 * wid + r : b * LROW + CTX + R * 256 + 32 * wid + r;
    if (!ctxq) for (int i = tid; i < 465; i += 512) rpbL[i] = rpb[h * 465 + i] * LOG2E;
    const int srow = tid >> 3, sch = tid & 7;
    const bf16_t* gb = QKV + (size_t)(b * LROW) * 3072 + 1024 + h * 64 + sch * 8;
    const int lbase = srow * KP + sch * 16;
    u32x4 st[2];
#define NA_ROW(t) ((t) < 4 ? 64 * (t) : CTX + (rlo + (t) - 4) * 64)
#define NA_LOAD(t) do { const bf16_t* _g = gb + (size_t)(NA_ROW(t) + srow) * 3072; st[0] = *(const u32x4*)_g; st[1] = *(const u32x4*)(_g + 1024); } while (0)
#define NA_STORE(buf) do { *(LAS u32x4*)(lds + (buf) * STG + lbase) = st[0]; *(LAS u32x4*)(lds + (buf) * STG + 64 * KP + (sch >> 2) * 4096 + srow * 64 + (sch & 3) * 16) = st[1]; } while (0)
    const bf16_t* qp = QKV + (size_t)q_row * 3072 + h * 64 + 8 * hh;
    bf16x8 qr[4];
#pragma unroll
    for (int d0 = 0; d0 < 4; ++d0) qr[d0] = *(const bf16x8*)(qp + 16 * d0);
    f32x16 o[2];
#pragma unroll
    for (int d = 0; d < 2; ++d)
#pragma unroll
        for (int i = 0; i < 16; ++i) o[d][i] = 0.f;
    float m_run = 0.f, l_run = 0.f;
    f32x16 negm;
#pragma unroll
    for (int i = 0; i < 16; ++i) negm[i] = 0.f;
    const int cs = min(max(cq - 8, 0), 48);
    NA_LOAD(0); NA_STORE(0); __syncthreads();
    for (int t = 0; t < NT; ++t) {
        const int cur = t & 1;
        if (t + 1 < NT) NA_LOAD(t + 1);
        const int ri = rlo + t - 4;
        const bool active = (t < 4) || (ri >= rs_w && ri <= rs_w + 7);
        if (active) {
            LAS const unsigned char* Kb = lds + cur * STG + r * KP + hh * 16;
            LAS const unsigned char* Vb = lds + cur * STG + 64 * KP;
            f32x16 p0 = negm, p1 = negm;
#pragma unroll
            for (int d0 = 0; d0 < 4; ++d0) { const bf16x8 k0 = *(const LAS bf16x8*)(Kb + d0 * 32), k1 = *(const LAS bf16x8*)(Kb + 32 * KP + d0 * 32);
                p0 = mfma32(k0, qr[d0], p0); p1 = mfma32(k1, qr[d0], p1); }
            if (t >= 4) {
                LAS const float* bt = rpbL + (ri - rw + 7) * 31 + 15 - cq;
#pragma unroll
                for (int i = 0; i < 16; ++i) { const int ck = (i & 3) + 8 * (i >> 2) + 4 * hh;
                    { const bool in = (ck >= cs) && (ck < cs + 16); const float bv = bt[in ? ck : cq]; p0[i] = in ? p0[i] + bv : -1e30f; }
                    { const int ck2 = ck + 32; const bool in = (ck2 >= cs) && (ck2 < cs + 16); const float bv = bt[in ? ck2 : cq]; p1[i] = in ? p1[i] + bv : -1e30f; } }
            }
            softmax_pv<2>(p0, p1, o, negm, m_run, l_run, t == 0, wsf, Vb, KP, r, hh, lane);
        }
        if (t + 1 < NT) NA_STORE(cur ^ 1);
        LDS_BARRIER();
    }
#undef NA_ROW
#undef NA_LOAD
#undef NA_STORE
    const float lt = l_run + __shfl_xor(l_run, 32);
    if (hh == 0) wsf[r] = 1.f / lt;
    const int orow0 = (ctxq ? b * LROW : b * LROW + CTX + R * 256) + 32 * wid;
#pragma unroll
    for (int g4 = 0; g4 < 4; ++g4) { const f32x4 a4 = *(const LAS f32x4*)(wsf + 8 * g4 + 4 * hh);
#pragma unroll
        for (int e = 0; e < 4; ++e) { const int i = 4 * g4 + e; const int q = 8 * g4 + 4 * hh + e;
            bf16_t* op = O + (size_t)(orow0 + q) * DM + h * 64 + r;
            op[0] = (bf16_t)(pk2(o[0][i] * a4[e], 0.f) & 0xffffu); op[32] = (bf16_t)(pk2(o[1][i] * a4[e], 0.f) & 0xffffu); } }
    __syncthreads();
}

DI void na_phase(Frame& F, unsigned char* ws) {
    const bf16_t* QKV = (const bf16_t*)(ws + WS_ACT); bf16_t* O = (bf16_t*)(ws + WS_U);
    for (int u = F.vcu; u < 2048 + 256; u += F.G) {
        if (u < 2048) { const int bh = u >> 3, R = u & 7; na_unit(F.lds, F.tid, QKV, O, F.in[I_NARPB], bh >> 4, bh & 15, R, 0); }
        else { const int bh = u - 2048; na_unit(F.lds, F.tid, QKV, O, F.in[I_NARPB], bh >> 4, bh & 15, 0, 1); }
    }
}

template <int CTRL> DI float dppf(float x) { return __int_as_float(__builtin_amdgcn_update_dpp(0, __float_as_int(x), CTRL, 0xf, 0xf, false)); }
DI float allred8(float x) {
    float a, b, c;
    asm volatile("s_nop 1\n\tv_add_f32_dpp %0, %1, %1 row_half_mirror row_mask:0xf bank_mask:0xf bound_ctrl:1" : "=v"(a) : "v"(x));
    asm volatile("s_nop 1\n\tv_add_f32_dpp %0, %1, %1 quad_perm:[1,0,3,2] row_mask:0xf bank_mask:0xf bound_ctrl:1" : "=v"(b) : "v"(a));
    asm volatile("s_nop 1\n\tv_add_f32_dpp %0, %1, %1 quad_perm:[2,3,0,1] row_mask:0xf bank_mask:0xf bound_ctrl:1" : "=v"(c) : "v"(b));
    return c;
}
DI float allred8_ref(float x) { x += dppf<0x141>(x); x += dppf<0xB1>(x); x += dppf<0x4E>(x); return x; }
DI float allred16(float x) { x += dppf<0x128>(x); x += dppf<0x124>(x); x += dppf<0x122>(x); x += dppf<0x121>(x); return x; }
DI void rwkv_scan(Frame& F, unsigned char* ws) {
    const bf16_t* X = (const bf16_t*)(ws + WS_ACT);
    bf16_t* Y0 = (bf16_t*)(ws + WS_U) + (size_t)MROWS * DM;
    bf16_t* Y1 = (bf16_t*)(ws + WS_Y);
    float* CD = (float*)(ws + WS_CD);
    const int tid = F.tid, lane = F.lane, g = tid >> 8, gt = tid & 255, gwv = (tid >> 6) & 3;
    LAS float* buf = (LAS float*)(F.lds) + g * 5120;
    LAS float* ybuf0 = (LAS float*)(F.lds + 40960) + g * 2048;
    LAS float* red = (LAS float*)(F.lds + 57344) + g * 128;
    for (int s0 = F.vcu * 2; s0 < 512; s0 += F.G * 2) {
        const int s = s0 + g, dir = s >> 8, b = (s >> 4) & 15, h = s & 15;
        const int ch = 16 * gwv + (lane & 15), chn = h * 64 + ch, rq = lane >> 4;
        bf16x8 bw[2], ba[2];
#pragma unroll
        for (int ks = 0; ks < 2; ++ks) { u32x4 pw, pa;
#pragma unroll
            for (int e = 0; e < 4; ++e) { const int k = 32 * ks + 8 * rq + 2 * e;
                pw[e] = pk2(F.in[I_RWW2][(size_t)(dir * 64 + k) * 1024 + chn], F.in[I_RWW2][(size_t)(dir * 64 + k + 1) * 1024 + chn]);
                pa[e] = pk2(F.in[I_RWA2][(size_t)(dir * 64 + k) * 1024 + chn], F.in[I_RWA2][(size_t)(dir * 64 + k + 1) * 1024 + chn]); }
            bw[ks] = __builtin_bit_cast(bf16x8, pw); ba[ks] = __builtin_bit_cast(bf16x8, pa); }
        const float w0c = F.in[I_RWW0][dir * 1024 + chn], a0c = F.in[I_RWA0][dir * 1024 + chn], kkc = F.in[I_RWKK][chn], kac = F.in[I_RWKA][chn], rkc = F.in[I_RWRK][chn];
        const bf16_t* Xb = X + (size_t)(b * LROW) * 3584;
        bf16_t* Yd = (dir ? Y1 : Y0) + (size_t)(b * LROW) * DM + h * 64;
        float* CDd = CD + ((size_t)dir * MROWS + (size_t)b * LROW) * 16 + h;
        f32x2 S2[8];
#pragma unroll
        for (int i = 0; i < 8; ++i) S2[i] = (f32x2){0.f, 0.f};
        bf16x8 Bs[2];
        Bs[0] = (bf16x8){0, 0, 0, 0, 0, 0, 0, 0}; Bs[1] = Bs[0];
        const int vl = lane & 15, kq = lane >> 4;
        bf16x8 ahw[2], aha[2]; bf16_t rr_[4], kr_[4], vr_[4];
#define SC_RLO(c) (dir ? (((c) < 16 ? 255 - 16 * (c) : 2559 - 16 * (c)) - 15) : 16 * (c))
#define SC_LOAD(c) do { const int _rlo = SC_RLO(c); const bf16_t* _p = Xb + (size_t)(_rlo + (lane & 15)) * 3584 + 3072 + dir * 64 + 8 * rq; \
        ahw[0] = *(const bf16x8*)_p; ahw[1] = *(const bf16x8*)(_p + 32); aha[0] = *(const bf16x8*)(_p + 128); aha[1] = *(const bf16x8*)(_p + 160); \
        _Pragma("unroll") for (int j = 0; j < 4; ++j) { const bf16_t* _q = Xb + (size_t)(_rlo + 4 * rq + j) * 3584 + chn; rr_[j] = _q[0]; kr_[j] = _q[1024]; vr_[j] = _q[2048]; } } while (0)
#define SC_OUT(cc) do { const int rr_o = gt >> 4, c4_o = (gt & 15) * 4, js_o = dir ? 15 - rr_o : rr_o; const int rlo_o = SC_RLO(cc); \
        const f32x4 yv_o = *(const LAS f32x4*)(ybuf0 + ((cc) & 1) * 1024 + js_o * 64 + c4_o); \
        *(u32x2*)(Yd + (size_t)(rlo_o + rr_o) * DM + c4_o) = (u32x2){pk2(yv_o.x, yv_o.y), pk2(yv_o.z, yv_o.w)}; } while (0)
        SC_LOAD(0);
        for (int c = 0; c < 144; ++c) {
            const int rlo = SC_RLO(c);
            LAS float* cb = buf;
            LAS float* ybuf = ybuf0 + (c & 1) * 1024;
            f32x4 accw = {0.f, 0.f, 0.f, 0.f}, acca = {0.f, 0.f, 0.f, 0.f};
#pragma unroll
            for (int ks = 0; ks < 2; ++ks) { accw = __builtin_amdgcn_mfma_f32_16x16x32_bf16(ahw[ks], bw[ks], accw, 0, 0, 0); acca = __builtin_amdgcn_mfma_f32_16x16x32_bf16(aha[ks], ba[ks], acca, 0, 0, 0); }
            float dec[4], av[4], kkv[4], kd[4], rv[4], vv[4];
#pragma unroll
            for (int j = 0; j < 4; ++j) {
                const float z = w0c + accw[j]; dec[j] = fast_exp(-0.6065306597126334f * sigmoidf_(z));
                av[j] = sigmoidf_(a0c + acca[j]);
                const float kx = bf2f(kr_[j]); rv[j] = bf2f(rr_[j]); vv[j] = bf2f(vr_[j]);
                kkv[j] = kx * kkc; kd[j] = kx * (1.f + (av[j] - 1.f) * kac);
                const float nsq = allred16(kkv[j] * kkv[j]), cp = allred16(rv[j] * kd[j] * rkc);
                if ((lane & 15) == 0) { red[(4 * rq + j) * 4 + gwv] = nsq; red[64 + (4 * rq + j) * 4 + gwv] = cp; }
            }
            LDS_BARRIER();
            if (c > 0) SC_OUT(c - 1);
            const bf16_t rr_s[4] = {rr_[0], rr_[1], rr_[2], rr_[3]};
#pragma unroll
            for (int j = 0; j < 4; ++j) {
                const int rr = 4 * rq + j, js = dir ? 15 - rr : rr;
                const f32x4 n4 = *(const LAS f32x4*)(red + rr * 4);
                const float inv = __builtin_amdgcn_rsqf(fmaxf((n4.x + n4.y) + (n4.z + n4.w), 1e-24f));
                const float kkn = kkv[j] * inv;
                LAS float* d = cb + js * 320 + ch;
                d[0] = dec[j]; d[64] = kkn * av[j]; d[128] = kd[j]; d[192] = vv[j];
                LAS bf16_t* db = (LAS bf16_t*)(cb + js * 320 + 256) + ch;
                db[0] = (bf16_t)(pk2(-kkn, 0.f) & 0xffffu); db[64] = rr_s[j];
            }
            if (gt < 16) { const f32x4 c4 = *(const LAS f32x4*)(red + 64 + gt * 4); CDd[(size_t)(rlo + gt) * 16] = (c4.x + c4.y) + (c4.z + c4.w); }
            if (c + 1 < 144) SC_LOAD(c + 1);
            LDS_BARRIER();
            bf16x8 oa[2][2], orr[2][2]; f32x4 ow[2][4]; float ovt[2];
#define SC_OPS(P, js_) do { LAS const float* sb_ = cb + (js_) * 320; LAS const bf16_t* ab_ = (LAS const bf16_t*)(sb_ + 256) + 8 * kq; \
                oa[P][0] = *(const LAS bf16x8*)(ab_); oa[P][1] = *(const LAS bf16x8*)(ab_ + 32); orr[P][0] = *(const LAS bf16x8*)(ab_ + 64); orr[P][1] = *(const LAS bf16x8*)(ab_ + 96); \
                _Pragma("unroll") for (int s_ = 0; s_ < 2; ++s_) { LAS const float* ob2_ = sb_ + 32 * s_ + 8 * kq; ow[P][2 * s_] = *(const LAS f32x4*)(ob2_); ow[P][2 * s_ + 1] = *(const LAS f32x4*)(ob2_ + 4); } \
                ovt[P] = sb_[192 + 16 * gwv + vl]; } while (0)
            SC_OPS(0, 0);
#pragma unroll
            for (int js = 0; js < 16; ++js) {
                const int P = js & 1;
                f32x4 obv[4], odv[4];
                { LAS const float* sb_ = cb + js * 320 + 8 * kq;
#pragma unroll
                  for (int s_ = 0; s_ < 2; ++s_) { obv[2 * s_] = *(const LAS f32x4*)(sb_ + 32 * s_ + 64); obv[2 * s_ + 1] = *(const LAS f32x4*)(sb_ + 32 * s_ + 68); odv[2 * s_] = *(const LAS f32x4*)(sb_ + 32 * s_ + 128); odv[2 * s_ + 1] = *(const LAS f32x4*)(sb_ + 32 * s_ + 132); } }
                __builtin_amdgcn_sched_barrier(0);
                if (js + 1 < 16) SC_OPS(P ^ 1, js + 1);
                __builtin_amdgcn_sched_barrier(0);
                f32x4 acs = {0.f, 0.f, 0.f, 0.f};
                acs = __builtin_amdgcn_mfma_f32_16x16x32_bf16(oa[P][0], Bs[0], acs, 0, 0, 0); acs = __builtin_amdgcn_mfma_f32_16x16x32_bf16(oa[P][1], Bs[1], acs, 0, 0, 0);
                const float vt = ovt[P];
                const float sa = acs[0];
#pragma unroll
                for (int s_ = 0; s_ < 2; ++s_) {
                    const f32x4 w0 = ow[P][2 * s_], w1 = ow[P][2 * s_ + 1], b0 = obv[2 * s_], b1 = obv[2 * s_ + 1], d0 = odv[2 * s_], d1 = odv[2 * s_ + 1];
                    S2[4 * s_ + 0] = S2[4 * s_ + 0] * (f32x2){w0.x, w0.y} + ((f32x2){b0.x, b0.y} * sa + (f32x2){d0.x, d0.y} * vt);
                    S2[4 * s_ + 1] = S2[4 * s_ + 1] * (f32x2){w0.z, w0.w} + ((f32x2){b0.z, b0.w} * sa + (f32x2){d0.z, d0.w} * vt);
                    S2[4 * s_ + 2] = S2[4 * s_ + 2] * (f32x2){w1.x, w1.y} + ((f32x2){b1.x, b1.y} * sa + (f32x2){d1.x, d1.y} * vt);
                    S2[4 * s_ + 3] = S2[4 * s_ + 3] * (f32x2){w1.z, w1.w} + ((f32x2){b1.z, b1.w} * sa + (f32x2){d1.z, d1.w} * vt);
                    u32x4 pk; pk.x = pk2(S2[4 * s_ + 0].x, S2[4 * s_ + 0].y); pk.y = pk2(S2[4 * s_ + 1].x, S2[4 * s_ + 1].y); pk.z = pk2(S2[4 * s_ + 2].x, S2[4 * s_ + 2].y); pk.w = pk2(S2[4 * s_ + 3].x, S2[4 * s_ + 3].y);
                    Bs[s_] = __builtin_bit_cast(bf16x8, pk);
                }
                f32x4 acy = {0.f, 0.f, 0.f, 0.f};
                acy = __builtin_amdgcn_mfma_f32_16x16x32_bf16(orr[P][0], Bs[0], acy, 0, 0, 0); acy = __builtin_amdgcn_mfma_f32_16x16x32_bf16(orr[P][1], Bs[1], acy, 0, 0, 0);
                if (kq == 0) ybuf[js * 64 + 16 * gwv + vl] = acy[0];
                __builtin_amdgcn_sched_barrier(0);
            }
#undef SC_OPS
        }
        LDS_BARRIER();
        SC_OUT(143);
#undef SC_OUT
#undef SC_RLO
#undef SC_LOAD
        __syncthreads();
    }
}

DI void rwkv_readout(Frame& F, unsigned char* ws) {
    const bf16_t* X = (const bf16_t*)(ws + WS_ACT);
    bf16_t* G = (bf16_t*)(ws + WS_U);
    const bf16_t* Y0 = G + (size_t)MROWS * DM; const bf16_t* Y1 = (const bf16_t*)(ws + WS_Y);
    const float* CD = (const float*)(ws + WS_CD);
    const int c0 = 16 * F.lane, hd = F.lane >> 2;
    float lng[16], lnb[16];
#pragma unroll
    for (int i = 0; i < 16; i += 4) { const f32x4 g_ = *(const f32x4*)(F.in[I_RWLNG] + c0 + i), b_ = *(const f32x4*)(F.in[I_RWLNB] + c0 + i);
        lng[i] = g_.x; lng[i + 1] = g_.y; lng[i + 2] = g_.z; lng[i + 3] = g_.w; lnb[i] = b_.x; lnb[i + 1] = b_.y; lnb[i + 2] = b_.z; lnb[i + 3] = b_.w; }
    u32x4 na[2], nb[2], nv[2], ng_[2]; float ncd0 = 0.f, ncd1 = 0.f;
#define RD_LOAD(row_) do { _Pragma("unroll") for (int j = 0; j < 2; ++j) { na[j] = *(const u32x4*)(Y0 + (size_t)(row_) * DM + c0 + 8 * j); nb[j] = *(const u32x4*)(Y1 + (size_t)(row_) * DM + c0 + 8 * j); \
        nv[j] = *(const u32x4*)(X + (size_t)(row_) * 3584 + 2048 + c0 + 8 * j); ng_[j] = *(const u32x4*)(G + (size_t)(row_) * DM + c0 + 8 * j); } \
        ncd0 = CD[(size_t)(row_) * 16 + hd]; ncd1 = CD[((size_t)MROWS + (row_)) * 16 + hd]; } while (0)
    if (F.gw < MROWS) RD_LOAD(F.gw);
    for (int row = F.gw; row < MROWS; row += F.NGW) {
        float y[16], vv[16], gg[16];
        const float cc = ncd0 + ncd1;
#pragma unroll
        for (int j = 0; j < 2; ++j) {
            const u32x4 a = na[j], bq = nb[j], v4 = nv[j], g4 = ng_[j];
#pragma unroll
            for (int e = 0; e < 4; ++e) { y[8 * j + 2 * e] = bflo(a[e]) + bflo(bq[e]); y[8 * j + 2 * e + 1] = bfhi(a[e]) + bfhi(bq[e]);
                vv[8 * j + 2 * e] = bflo(v4[e]); vv[8 * j + 2 * e + 1] = bfhi(v4[e]); gg[8 * j + 2 * e] = bflo(g4[e]); gg[8 * j + 2 * e + 1] = bfhi(g4[e]); }
        }
        if (row + F.NGW < MROWS) RD_LOAD(row + F.NGW);
        float s = 0.f;
#pragma unroll
        for (int i = 0; i < 16; ++i) s += y[i];
        s += __shfl_xor(s, 1); s += __shfl_xor(s, 2);
        const float mean = s * (1.f / 64.f); float q = 0.f;
#pragma unroll
        for (int i = 0; i < 16; ++i) { y[i] -= mean; q += y[i] * y[i]; }
        q += __shfl_xor(q, 1); q += __shfl_xor(q, 2);
        const float rstd = 1.f / sqrtf(q * (1.f / 64.f) + 64e-5f);
        u32x4 o[2];
#pragma unroll
        for (int j = 0; j < 2; ++j)
#pragma unroll
            for (int e = 0; e < 4; ++e) { const int i = 8 * j + 2 * e;
                const float z0 = ((y[i] * rstd) * lng[i] + lnb[i] + cc * vv[i]) * gg[i];
                const float z1 = ((y[i + 1] * rstd) * lng[i + 1] + lnb[i + 1] + cc * vv[i + 1]) * gg[i + 1];
                o[j][e] = pk2(z0, z1); }
        *(u32x4*)(G + (size_t)row * DM + c0) = o[0]; *(u32x4*)(G + (size_t)row * DM + c0 + 8) = o[1];
    }
#undef RD_LOAD
}


#define XB_TMO      128
#define XB_XCNT(j)  (256  + 64 * (j))
#define XB_XSUB(j)  (1280 + 64 * (j))
#define XB_XGEN(j)  (2304 + 64 * (j))
#define XB_TOP      3328
#define XB_TOPGEN   3392
#define XCD_BAR_WORDS 3456
#define XB_SPIN_CAP (1u << 18)
DI unsigned xb_ld(unsigned* p)              { return __hip_atomic_load(p, __ATOMIC_RELAXED, __HIP_MEMORY_SCOPE_AGENT); }
DI unsigned xb_add(unsigned* p, unsigned v) { return __hip_atomic_fetch_add(p, v, __ATOMIC_RELAXED, __HIP_MEMORY_SCOPE_AGENT); }
DI unsigned xb_xcc_id() { return (unsigned)__builtin_amdgcn_s_getreg((3 << 11) | 20) & 0xFu; }
#define XB_SPIN(cond, bar) do { unsigned _sp = 0; while (cond) { __builtin_amdgcn_s_sleep(1); \
    if ((++_sp & 255u) == 0u) { if (xb_ld(&(bar)[XB_TMO])) break; if (_sp > XB_SPIN_CAP) { atomicAdd(&(bar)[XB_TMO], 1u); break; } } } } while (0)
struct XcdBarrier { unsigned* bar; unsigned x; volatile LAS unsigned* st; };
DI XcdBarrier xcd_barrier_post(unsigned* bar, volatile LAS unsigned* st) {
    XcdBarrier b; b.bar = bar; b.x = xb_xcc_id(); b.st = st;
    if (threadIdx.x == 0) (void)xb_add(&bar[XB_XCNT(b.x)], 1u);
    return b;
}
DI void xcd_barrier_complete(unsigned* bar, unsigned x, unsigned& nloc, unsigned& nx) {
    const unsigned G = gridDim.x * gridDim.y * gridDim.z;
    unsigned sum, cnt, mine, sp = 0u;
    for (;;) {
        sum = 0u; cnt = 0u; mine = 0u;
#pragma unroll
        for (unsigned j = 0; j < 16; ++j) { const unsigned c = xb_ld(&bar[XB_XCNT(j)]); sum += c; cnt += (c > 0u) ? 1u : 0u; mine = (j == x) ? c : mine; }
        if (sum == G) break;
        __builtin_amdgcn_s_sleep(1);
        if ((++sp & 255u) == 0u) { if (xb_ld(&bar[XB_TMO])) break; if (sp > XB_SPIN_CAP) { atomicAdd(&bar[XB_TMO], 1u); break; } }
    }
    nloc = mine > 0u ? mine : 1u; nx = cnt > 0u ? cnt : 1u;
}
DI void xcd_barrier(const XcdBarrier& b) {
    asm volatile("s_waitcnt vmcnt(0)" ::: "memory");
    __syncthreads();
    if (threadIdx.x == 0) {
        unsigned* bar = b.bar;
        __builtin_amdgcn_s_waitcnt(0);
        unsigned nloc = b.st[0], nx = b.st[1];
        if (nloc == 0u) { xcd_barrier_complete(bar, b.x, nloc, nx); b.st[0] = nloc; b.st[1] = nx; }
        const unsigned old = xb_add(&bar[XB_XSUB(b.x)], 1u);
        const unsigned gen = old / nloc;
        if (old + 1u == (gen + 1u) * nloc) {
            __builtin_amdgcn_fence(__ATOMIC_RELEASE, "agent");
            asm volatile("s_waitcnt vmcnt(0)" ::: "memory");
            const unsigned og = xb_add(&bar[XB_TOP], 1u);
            const unsigned tg = og / nx;
            if (og + 1u == (tg + 1u) * nx) xb_add(&bar[XB_TOPGEN], 1u);
            else XB_SPIN(xb_ld(&bar[XB_TOPGEN]) == tg, bar);
            __builtin_amdgcn_fence(__ATOMIC_ACQUIRE, "agent");
            xb_add(&bar[XB_XGEN(b.x)], 1u);
            asm volatile("s_waitcnt vmcnt(0)" ::: "memory");
        } else {
            XB_SPIN(xb_ld(&bar[XB_XGEN(b.x)]) == gen, bar);
            __builtin_amdgcn_fence(__ATOMIC_ACQUIRE, "agent");
            asm volatile("s_waitcnt vmcnt(0)" ::: "memory");
        }
    }
    __syncthreads();
}

enum { OP_RP0 = 0, OP_G1, OP_G2, OP_RP1, OP_XX, OP_RKVH, OP_GG, OP_SCAN, OP_RDOUT, OP_QKV, OP_ATT, OP_OPROJ, OP_RP2, OP_G5, OP_G6, OP_RP3, OP_END };
DI int next_op(int kind, int op) {
    switch (op) {
        case OP_RP0: return OP_G1; case OP_G1: return OP_G2; case OP_G2: return OP_RP1;
        case OP_RP1: return kind == 2 ? OP_XX : OP_QKV;
        case OP_XX: return OP_RKVH; case OP_RKVH: return OP_GG; case OP_GG: return OP_SCAN; case OP_SCAN: return OP_RDOUT; case OP_RDOUT: return OP_OPROJ;
        case OP_QKV: return OP_ATT; case OP_ATT: return OP_OPROJ; case OP_OPROJ: return OP_RP2;
        case OP_RP2: return OP_G5; case OP_G5: return OP_G6; case OP_G6: return OP_RP3; default: return OP_END;
    }
}

__global__ void __launch_bounds__(512, 2) mega(const float* i0, const float* i1, const float* i2, const float* i3, const float* i4, const float* i5, const float* i6, const float* i7, const float* i8, const float* i9, const float* i10, const float* i11, const float* i12, const float* i13, const float* i14, const float* i15, const float* i16, const float* i17, const float* i18, const float* i19, const float* i20, const float* i21, const float* i22, const float* i23, const float* i24, const float* i25, const float* i26, const float* i27, const float* i28, const float* i29, const float* i30, const float* i31, float* out, unsigned char* ws0) {
    const float* in_[32] = {i0, i1, i2, i3, i4, i5, i6, i7, i8, i9, i10, i11, i12, i13, i14, i15, i16, i17, i18, i19, i20, i21, i22, i23, i24, i25, i26, i27, i28, i29, i30, i31};
    extern __shared__ __attribute__((aligned(16))) unsigned char lds_raw[];
    cg::grid_group grid = cg::this_grid();
    Frame F;
#define BUILD_FRAME() do { int tid_ = threadIdx.x; asm volatile("" : "+v"(tid_)); int bx_ = blockIdx.x; asm volatile("" : "+s"(bx_)); \
    F.lds = (LAS unsigned char*)lds_raw; F.tid = tid_; F.lane = tid_ & 63; F.wave = __builtin_amdgcn_readfirstlane(tid_ >> 6); \
    F.G = gridDim.x; F.bx = bx_; F.vcu = (F.G % 8 == 0) ? (bx_ % 8) * (F.G / 8) + bx_ / 8 : bx_; \
    F.gw = F.vcu * 8 + F.wave; F.NGW = F.G * 8; F.in = in_; } while (0)
    BUILD_FRAME();
    unsigned char* ws = ws0;

#ifndef NO_P0
    phase0(F, ws);
#endif
    grid.sync();
    volatile LAS unsigned* bst = (volatile LAS unsigned*)(F.lds + LDS_BYTES - 64);
    if (F.tid < 2) bst[F.tid] = 0u;
    __syncthreads();
    const XcdBarrier xbar = xcd_barrier_post((unsigned*)(ws0 + WS_BAR), bst);

    for (int l = 0; l < 4; ++l) {
        const int kind = l % 3; const bool last = (l == 3);
        const float* ng = F.in[I_NORMG] + l * 6 * DM;
        int op = (l == 0) ? OP_RP0 : OP_G1;
        int sub = 0, rp_lo = 0;
        while (op != OP_END) {
            { size_t zoff = 0; asm volatile("" : "+s"(zoff)); ws = ws0 + zoff; }
            BUILD_FRAME();
            float* HC = (float*)(ws + WS_HC); bf16_t* WB = (bf16_t*)(ws + WS_WB); bf16_t* U = (bf16_t*)(ws + WS_U); bf16_t* ACT = (bf16_t*)(ws + WS_ACT); bf16_t* YB = (bf16_t*)(ws + WS_Y);
            const float* cosT = (const float*)(ws + WS_ROPE); const float* sinT = cosT + 1024;
            int rpop = -1, rlo = 0, rhi = MROWS, rwidx = F.gw, rnw = F.NGW; bool fill = false;
            if (op == OP_G1 || op == OP_G2 || op == OP_G5 || op == OP_G6 || op == OP_QKV || op == OP_RKVH || op == OP_GG || op == OP_OPROJ) {
                pg8::Gemm g; pg8::Epi E; E.cosT = cosT; E.sinT = sinT; int skip = 0;
                if (op == OP_G1 || op == OP_G5) { g.A = U; g.lda = 1024; g.Bt = WB + (op == OP_G1 ? WB_IN0 : WB_IN1); g.ldb = 1024; g.N = 5632; g.K = 1024; E.mode = pg8::EPI_SWIGLU; E.O = ACT; E.ldc = FF; skip = (last && op == OP_G5); }
                else if (op == OP_G2 || op == OP_G6) { g.A = ACT; g.lda = FF; g.Bt = WB + (op == OP_G2 ? WB_OUT0 : WB_OUT1); g.ldb = FF; g.N = 1024; g.K = FF; E.mode = pg8::EPI_PLAIN; E.O = YB; E.ldc = 1024; skip = (last && op == OP_G6); }
                else if (op == OP_QKV) { g.A = U; g.lda = 1024; g.Bt = WB + WB_MIXIN; g.ldb = 1024; g.N = 3072; g.K = 1024; E.mode = kind == 0 ? pg8::EPI_QKV_DA : pg8::EPI_QKV_NA; E.O = ACT; E.ldc = 3072; }
                else if (op == OP_RKVH) { g.A = U; g.lda = 2048; g.Bt = WB + WB_MIXIN; g.ldb = 2048; g.N = 3584; g.K = 2048; E.mode = pg8::EPI_RWKV; E.O = ACT; E.ldc = 3584; }
                else if (op == OP_GG) { g.A = ACT + 3328; g.lda = 3584; g.Bt = WB + WB_G2T; g.ldb = 256; g.N = 1024; g.K = 256; E.mode = pg8::EPI_PLAIN; E.O = U; E.ldc = 1024; }
                else { g.A = U; g.lda = 1024; g.Bt = WB + WB_MIXOUT; g.ldb = 1024; g.N = 1024; g.K = 1024; E.mode = pg8::EPI_PLAIN; E.O = YB; E.ldc = 1024; skip = last; }
                g.nM = skip ? 128 : 144; g.skip = skip;
                pg8::StaticOrder S; S.init(g.nM, g.N, F.G, F.bx, skip);
                fill = (op == OP_G2 || op == OP_G6 || op == OP_OPROJ) && !skip && F.G == 256;
                if (fill) { S.pmode = 1; S.r0 = sub ? 2 : 0; S.nr = sub ? 1 : 2;
                    if (sub == 1 && F.bx >= 64) { rpop = (op == OP_G2) ? OP_RP1 : (op == OP_G6 ? OP_RP3 : OP_RP2); rlo = 0; rhi = 128 * 256; rwidx = (F.bx - 64) * 8 + F.wave; rnw = 192 * 8; } }
#ifndef NO_GEMM
                pg8::gemm_phase(F.lds, F.tid, g, S, E);
#endif
            } else if (op == OP_RP0 || op == OP_RP1 || op == OP_RP2 || op == OP_RP3) { rpop = op; rlo = rp_lo; }
            if (rpop >= 0) {
                RowPass P;
                P.hsrc_lat = out; P.hsrc_ctx = HC; P.hdst_lat = out; P.hdst_ctx = HC; P.U = U; P.ldu = 1024; P.skip_ctx = 0; P.lpost = l; P.lpre = l;
                if (rpop == OP_RP0) { P.hsrc_lat = F.in[I_X]; P.hsrc_ctx = F.in[I_CTX]; P.hdst_lat = (float*)F.in[I_X]; P.hdst_ctx = (float*)F.in[I_CTX];   P.Y = nullptr; P.gpost = ng; P.gate_idx = 0; P.coef = 0.f; P.gpre = ng; P.shift_idx = 0; }
                else if (rpop == OP_RP1) { if (l == 0) { P.hsrc_lat = F.in[I_X]; P.hsrc_ctx = F.in[I_CTX]; } P.Y = YB; P.gpost = ng + DM; P.gate_idx = 2; P.coef = 0.5f; P.gpre = ng + 2 * DM; P.shift_idx = 3; P.ldu = (kind == 2) ? 2048 : 1024; }
                else if (rpop == OP_RP2) { P.Y = YB; P.gpost = ng + 3 * DM; P.gate_idx = 5; P.coef = 1.f; P.gpre = ng + 4 * DM; P.shift_idx = 6; P.skip_ctx = last; }
                else { P.Y = YB; P.gpost = ng + 5 * DM; P.gate_idx = 8; P.coef = 0.5f; P.gpre = last ? nullptr : ng + 6 * DM; P.shift_idx = 0; P.lpre = l + 1; P.skip_ctx = last; }
#ifndef NO_RP
                row_pass(F, ws, P, rlo, rhi, rwidx, rnw);
#endif
#ifndef NO_CONV
                if (op == OP_RP3 && !last) { __syncthreads(); convert_layer(F, ws, l + 1); }
#endif
            }
#ifndef NO_XX
            if (op == OP_XX) { xx_pass(F, ws); }
#endif

#ifndef NO_SCAN
            if (op == OP_SCAN) { rwkv_scan(F, ws); }
#endif

#ifndef NO_RDOUT
            if (op == OP_RDOUT) { rwkv_readout(F, ws); }
#endif

#ifndef NO_ATT
            if (op == OP_ATT) {
#ifndef NO_DA
 if (kind == 0) da_phase(F, ws, l);
#endif
#ifndef NO_NA
 if (kind == 1) na_phase(F, ws);
#endif
 }
#endif
            xcd_barrier(xbar);
            if (fill) { if (sub == 0) { sub = 1; continue; } sub = 0; rp_lo = 128 * 256; }
            else if (rpop >= 0) rp_lo = 0;
            op = next_op(kind, op);
        }
    }
}

extern "C" void kernel_launch(void* const* d_in, const int* in_sizes, int n_in, void* d_out, int out_size,
                              void* d_ws, size_t ws_size, hipStream_t stream) {
    static int grid = 0;
    if (grid == 0) {
        if (n_in != 32 || ws_size < WS_END) { fprintf(stderr, "kernel_launch: need 32 inputs and %zu B of workspace; got %d, %zu\n", (size_t)WS_END, n_in, ws_size); grid = -1; return; }
        int dev = 0, cus = 0, per_cu = 0;
        (void)hipGetDevice(&dev);
        (void)hipDeviceGetAttribute(&cus, hipDeviceAttributeMultiprocessorCount, dev);
        (void)hipFuncSetAttribute((const void*)mega, hipFuncAttributeMaxDynamicSharedMemorySize, LDS_BYTES);
        (void)hipOccupancyMaxActiveBlocksPerMultiprocessor(&per_cu, (const void*)mega, 512, LDS_BYTES);
        if (per_cu < 1) per_cu = 1;
        grid = cus * per_cu;
    }
    if (grid < 0) return;
    const float* inp[32]; for (int i = 0; i < 32; ++i) inp[i] = (const float*)d_in[i];
    float* outp = (float*)d_out; unsigned char* wsp = (unsigned char*)d_ws;
    void* kargs[34]; for (int i = 0; i < 32; ++i) kargs[i] = (void*)&inp[i];
    kargs[32] = (void*)&outp; kargs[33] = (void*)&wsp;
    hipError_t e = hipLaunchCooperativeKernel((const void*)mega, dim3(grid), dim3(512), kargs, LDS_BYTES, stream);
    if (e != hipSuccess) fprintf(stderr, "cooperative launch failed: %s (grid %d)\n", hipGetErrorString(e), grid);
}
```

```cpp
#include <hip/hip_runtime.h>
#include <hip/hip_cooperative_groups.h>
#include <cstdio>
#include <cstdint>
namespace cg = cooperative_groups;
#ifndef REP_MASK
#define REP_MASK 0
#endif

#define LAS __attribute__((address_space(3)))
#define DI __device__ __forceinline__
typedef unsigned short bf16_t;
typedef short bf16x8 __attribute__((ext_vector_type(8)));
typedef short s16x4 __attribute__((ext_vector_type(4)));
typedef float f32x2 __attribute__((ext_vector_type(2)));
typedef float f32x4 __attribute__((ext_vector_type(4)));
typedef float f32x16 __attribute__((ext_vector_type(16)));
typedef unsigned u32x4 __attribute__((ext_vector_type(4)));
typedef unsigned u32x2 __attribute__((ext_vector_type(2)));
typedef __bf16 bf2_t __attribute__((ext_vector_type(2)));

constexpr int DM = 1024, NB = 16, SEQ = 2048, CTX = 256, LROW = 2304, MROWS = NB * LROW, FF = 2816, NMOD = 9216;
constexpr float NORM_EPS = 1e-6f;
constexpr float LOG2E = 1.4426950408889634f;
constexpr float QSCALE = 0.125f * LOG2E;

constexpr size_t MiB = 1u << 20;
constexpr size_t WS_MOD = 0, WS_ROPE = 3 * MiB, WS_LAM = 3 * MiB + 16384, WS_BAR = 3 * MiB + 32768, WS_CD = 4 * MiB, WS_HC = 9 * MiB, WS_WB = 25 * MiB,
                 WS_U = 75 * MiB, WS_ACT = 219 * MiB, WS_Y = 471 * MiB, WS_END = 543 * MiB;
constexpr size_t WB_IN0 = 0, WB_OUT0 = 5767168, WB_IN1 = 8650752, WB_OUT1 = 14417920, WB_MIXIN = 17301504, WB_MIXOUT = 24641536, WB_G2T = 25690112;
constexpr int LDS_BYTES = 147456;

DI unsigned pk2(float lo, float hi) { f32x2 v = {lo, hi}; bf2_t b = __builtin_convertvector(v, bf2_t); return __builtin_bit_cast(unsigned, b); }
DI float bf2f(bf16_t h) { return __uint_as_float(((unsigned)h) << 16); }
DI float bflo(unsigned w) { return __uint_as_float(w << 16); }
DI float bfhi(unsigned w) { return __uint_as_float(w & 0xffff0000u); }
DI float wave_sum(float v) {
#pragma unroll
    for (int o = 1; o < 64; o <<= 1) v += __shfl_xor(v, o);
    return v;
}
#define LDS_BARRIER() asm volatile("s_waitcnt lgkmcnt(0)\n\ts_barrier" ::: "memory")
DI float fast_exp(float x) { return __builtin_amdgcn_exp2f(x * LOG2E); }
DI float sigmoidf_(float x) { return __builtin_amdgcn_rcpf(1.f + fast_exp(-x)); }
DI float siluf_(float x) { return x * sigmoidf_(x); }
DI float tanhf_(float x) { return 1.f - 2.f * __builtin_amdgcn_rcpf(1.f + fast_exp(2.f * x)); }

namespace pg8 {
constexpr int BM = 256, BK = 64, HALF = 128, HTB = HALF * BK * 2, NXCD = 8, WGM = 4;
__host__ __device__ __forceinline__ int lds_byte(int r, int c) { const int st = (r >> 4) * 2 + (c >> 5), rr = r & 15, cc = c & 31, ob = rr * 64 + cc * 2; return st * 1024 + (ob ^ (((ob >> 9) & 1) << 5)); }
__host__ __device__ __forceinline__ void stage_rc(int b, int& R, int& C) { const int st = b / 1024, sb = b % 1024, swz = sb ^ (((sb >> 9) & 1) << 5); R = (st >> 1) * 16 + swz / 64; C = (st & 1) * 32 + (swz % 64) / 2; }
__host__ __device__ __forceinline__ int perm32(int rho) { const int n = rho >> 4, i = rho & 15; return 8 * (i >> 2) + 4 * n + (i & 3); }

struct Unit { int pm, pn; };
struct Gemm { const bf16_t* A; const bf16_t* Bt; int lda, ldb, N, K, nM, skip; };

struct StaticOrder {
    int nM, nN, nwg, G, c, skip;
    int pmode, r0, nr;
    DI void init(int nM_, int N, int G_, int c_, int skip_) { nM = nM_; nN = N / BM; nwg = nM * nN; G = G_; c = c_; skip = skip_; pmode = 0; r0 = 0; nr = 0; }
    DI bool next(int i, Unit& u) const {
        if (pmode) {
            if (i >= nr) return false;
            const int round = r0 + i, xcd = c & 7, j = c >> 3, full = nM >> 6; int panel;
            if (round < full) { panel = round * 64 + xcd * 8 + (j & 7); u.pn = j >> 3; }
            else { if (j >= 8) return false; panel = full * 64 + 2 * xcd + (j & 1); u.pn = j >> 1; if (panel >= nM) return false; }
            u.pm = skip ? (panel + panel / 8 + 1) : panel;
            return true;
        }
        const long L = (long)i * G + c; if (L >= nwg) return false;
        int wgid = (int)L; { const int q = nwg / NXCD, r = nwg % NXCD, xcd = wgid % NXCD, off = wgid / NXCD; wgid = (xcd < r ? xcd * (q + 1) : r * (q + 1) + (xcd - r) * q) + off; }
        const int nig = WGM * nN, gid = wgid / nig, fm = gid * WGM, gsz = (nM - fm) < WGM ? (nM - fm) : WGM;
        int pm = fm + ((wgid % nig) % gsz); u.pn = (wgid % nig) / gsz;
        u.pm = skip ? (pm + pm / 8 + 1) : pm;
        return true;
    }
};

enum { EPI_PLAIN = 0, EPI_SWIGLU = 1, EPI_QKV_DA = 2, EPI_QKV_NA = 3, EPI_RWKV = 4 };
struct Epi {
    static constexpr bool PERM = true;
    int mode; bf16_t* O; int ldc; const float* cosT; const float* sinT;
    DI void operator()(const f32x4 (&acc)[2][2][4][2], const Unit& u, int wr, int wc, int fr, int fq) const {
        const int row0 = u.pm * BM + wr * 64 + fr;
        if (mode == EPI_SWIGLU) {
            const int col0 = u.pn * 128 + wc * 32 + 8 * fq;
#pragma unroll
            for (int ai = 0; ai < 2; ++ai)
#pragma unroll
                for (int m = 0; m < 4; ++m) {
                    bf16_t* rowp = O + (size_t)(row0 + ai * HALF + m * 16) * ldc + col0;
                    const f32x4 a0 = acc[ai][0][m][0], a1 = acc[ai][0][m][1], b0 = acc[ai][1][m][0], b1 = acc[ai][1][m][1];
                    u32x4 w;
                    w.x = pk2(siluf_(a0[0]) * b0[0], siluf_(a0[1]) * b0[1]); w.y = pk2(siluf_(a0[2]) * b0[2], siluf_(a0[3]) * b0[3]);
                    w.z = pk2(siluf_(a1[0]) * b1[0], siluf_(a1[1]) * b1[1]); w.w = pk2(siluf_(a1[2]) * b1[2], siluf_(a1[3]) * b1[3]);
                    *(u32x4*)rowp = w;
                }
        } else {
            const int col0 = u.pn * BM + wc * 32 + 8 * fq;
            const int jt = u.pm % 9;
            float sc = 1.f; bool rope = false; int act0 = 0, act1 = 0;
            if (mode == EPI_QKV_DA) { if (u.pn < 4) sc = QSCALE; if (u.pn < 8 && jt != 0) rope = true; }
            else if (mode == EPI_QKV_NA) { if (u.pn < 4) sc = QSCALE; }
            else if (mode == EPI_RWKV) { if (u.pn == 12) act0 = 1; if (u.pn == 13) { act0 = 2; act1 = 2; } }
#pragma unroll
            for (int ai = 0; ai < 2; ++ai)
#pragma unroll
                for (int m = 0; m < 4; ++m) {
                    bf16_t* rowp = O + (size_t)(row0 + ai * HALF + m * 16) * ldc + col0;
                    f32x4 c0 = {1.f, 1.f, 1.f, 1.f}, c1 = c0, s0 = {0.f, 0.f, 0.f, 0.f}, s1 = s0;
                    if (rope) {
                        const int t = (jt - 1) * 256 + ai * HALF + wr * 64 + m * 16 + fr;
                        const int pos = (wc & 1) ? (t & 63) : (t >> 6);
                        const float* cp = cosT + pos * 16 + 8 * (fq & 1); const float* sp = sinT + pos * 16 + 8 * (fq & 1);
                        c0 = *(const f32x4*)cp; c1 = *(const f32x4*)(cp + 4); s0 = *(const f32x4*)sp; s1 = *(const f32x4*)(sp + 4);
                        if (!(fq & 2)) { s0 = -s0; s1 = -s1; }
                    }
#pragma unroll
                    for (int bj = 0; bj < 2; ++bj) {
                        f32x4 v0 = acc[ai][bj][m][0], v1 = acc[ai][bj][m][1];
                        if (rope) {
                            f32x4 p0, p1;
#pragma unroll
                            for (int e = 0; e < 4; ++e) { p0[e] = __shfl_xor(v0[e], 32); p1[e] = __shfl_xor(v1[e], 32); }
                            v0 = v0 * c0 + p0 * s0; v1 = v1 * c1 + p1 * s1;
                        }
                        v0 = v0 * sc; v1 = v1 * sc;
                        const int act = bj ? act1 : act0;
                        if (act == 1) {
#pragma unroll
                            for (int e = 0; e < 4; ++e) { v0[e] = tanhf_(v0[e]); v1[e] = tanhf_(v1[e]); }
                        } else if (act == 2) {
#pragma unroll
                            for (int e = 0; e < 4; ++e) { v0[e] = sigmoidf_(v0[e]); v1[e] = sigmoidf_(v1[e]); }
                        }
                        u32x4 w; w.x = pk2(v0[0], v0[1]); w.y = pk2(v0[2], v0[3]); w.z = pk2(v1[0], v1[1]); w.w = pk2(v1[2], v1[3]);
                        *(u32x4*)(rowp + bj * HALF) = w;
                    }
                }
        }
    }
};

DI void gemm_phase(LAS unsigned char* lds, const int tid, const Gemm g, const StaticOrder& S, const Epi& E) {
    const int wid = __builtin_amdgcn_readfirstlane(tid >> 6), lane = tid & 63, wr = wid >> 2, wc = wid & 3, fr = lane & 15, fq = lane >> 4;
    const int K = g.K, nt = K / BK;
    unsigned voffA[2], voffB[2];
#pragma unroll
    for (int i = 0; i < 2; ++i) { int R, C; stage_rc(tid * 16 + i * 8192, R, C); const int Rb = (R & ~31) + perm32(R & 31);
        voffA[i] = (unsigned)(R * g.lda + C) * 2u; voffB[i] = (unsigned)(Rb * g.ldb + C) * 2u; }
    const size_t kstep = (size_t)(BK * 2);
    const size_t hstepA = (size_t)HALF * g.lda * 2, hstepB = (size_t)HALF * g.ldb * 2;
    const size_t tstepA = 2 * hstepA, tstepB = 2 * hstepB;
    const unsigned ldsw = (unsigned)wid * 1024u;
    const int aoff = lds_byte(wr * 64 + fr, fq * 8), boff = lds_byte(wc * 32 + fr, fq * 8);
#define PG8_SA(b, h) (((b) * 2 + (h)) * HTB)
#define PG8_SB(b, h) ((4 + (b) * 2 + (h)) * HTB)
#define PG8_STAGE(bufoff, gbase, voff) do { _Pragma("unroll") for (int _i = 0; _i < 2; ++_i) \
        __builtin_amdgcn_global_load_lds((const unsigned*)((const char*)(gbase) + (voff)[_i]), (LAS unsigned*)(lds + (bufoff) + ldsw + _i * 8192), 16, 0, 0); } while (0)
#define PG8_LDA(dst, b, h) do { _Pragma("unroll") for (int m = 0; m < 4; ++m) _Pragma("unroll") for (int k = 0; k < 2; ++k) dst[m][k] = *(const LAS bf16x8*)(lds + PG8_SA(b, h) + aoff + m * 2048 + k * 1024); } while (0)
#define PG8_LDB(dst, b, h) do { _Pragma("unroll") for (int n = 0; n < 2; ++n) _Pragma("unroll") for (int k = 0; k < 2; ++k) dst[n][k] = *(const LAS bf16x8*)(lds + PG8_SB(b, h) + boff + n * 2048 + k * 1024); } while (0)
#define PG8_MMA(ai, bj, At, Bt) do { __builtin_amdgcn_s_setprio(1); _Pragma("unroll") for (int m = 0; m < 4; ++m) _Pragma("unroll") for (int n = 0; n < 2; ++n) _Pragma("unroll") for (int k = 0; k < 2; ++k) \
        acc[ai][bj][m][n] = __builtin_amdgcn_mfma_f32_16x16x32_bf16(Bt[n][k], At[m][k], acc[ai][bj][m][n], 0, 0, 0); __builtin_amdgcn_s_setprio(0); } while (0)
#define PG8_WAIT_V(n) asm volatile("s_waitcnt vmcnt(" #n ")" ::: "memory")
#define PG8_WAIT_L(n) asm volatile("s_waitcnt lgkmcnt(" #n ")" ::: "memory")
#define PG8_BAR __builtin_amdgcn_s_barrier()
#define PG8_SCHED __builtin_amdgcn_sched_barrier(0)
    Unit cur, nxt; int ui = 0;
    if (!S.next(0, cur)) return;
    f32x4 acc[2][2][4][2];
#pragma unroll
    for (int a = 0; a < 2; ++a)
#pragma unroll
        for (int b = 0; b < 2; ++b)
#pragma unroll
            for (int m = 0; m < 4; ++m)
#pragma unroll
                for (int n = 0; n < 2; ++n) acc[a][b][m][n] = (f32x4){0.f, 0.f, 0.f, 0.f};
    bf16x8 At[4][2], B0[2][2], B1[2][2];
    const char* cA = (const char*)g.A + (size_t)cur.pm * tstepA; const char* cB = (const char*)g.Bt + (size_t)cur.pn * tstepB;
    PG8_STAGE(PG8_SB(0, 0), cB, voffB); PG8_STAGE(PG8_SB(0, 1), cB + hstepB, voffB); PG8_STAGE(PG8_SA(0, 0), cA, voffA); PG8_STAGE(PG8_SA(0, 1), cA + hstepA, voffA);
    if (wr == 1) PG8_BAR;
    PG8_WAIT_V(2); PG8_BAR;
    PG8_STAGE(PG8_SB(1, 0), cB + kstep, voffB); PG8_STAGE(PG8_SA(1, 0), cA + kstep, voffA); PG8_STAGE(PG8_SB(1, 1), cB + hstepB + kstep, voffB);
    PG8_WAIT_V(6); PG8_BAR;
    for (;;) {
        const bool has_next = S.next(ui + 1, nxt);
        const char* nA = has_next ? (const char*)g.A + (size_t)nxt.pm * tstepA : cA; const char* nB = has_next ? (const char*)g.Bt + (size_t)nxt.pn * tstepB : cB;
        for (int t = 0; t < nt; t += 2) {
            const bool last = (t == nt - 2);
            const char* a1 = cA + (size_t)(t + 1) * kstep;
            const char* a2 = last ? nA : cA + (size_t)(t + 2) * kstep; const char* b2 = last ? nB : cB + (size_t)(t + 2) * kstep;
            const char* a3 = a2 + kstep; const char* b3 = b2 + kstep;
            PG8_LDB(B0, 0, 0); PG8_LDB(B1, 0, 1); PG8_SCHED; PG8_LDA(At, 0, 0); PG8_STAGE(PG8_SA(1, 1), a1 + hstepA, voffA);
            PG8_WAIT_V(8); PG8_WAIT_L(0); PG8_BAR; PG8_MMA(0, 0, At, B0); PG8_MMA(0, 1, At, B1); PG8_BAR; PG8_SCHED;
            PG8_LDA(At, 0, 1); PG8_STAGE(PG8_SB(0, 0), b2, voffB); PG8_STAGE(PG8_SB(0, 1), b2 + hstepB, voffB); PG8_STAGE(PG8_SA(0, 0), a2, voffA);
            PG8_WAIT_V(8); PG8_WAIT_L(0); PG8_BAR; PG8_MMA(1, 0, At, B0); PG8_MMA(1, 1, At, B1); PG8_BAR; PG8_SCHED;
            PG8_LDB(B0, 1, 0); PG8_LDB(B1, 1, 1); PG8_SCHED; PG8_LDA(At, 1, 0); PG8_STAGE(PG8_SA(0, 1), a2 + hstepA, voffA);
            PG8_WAIT_V(8); PG8_WAIT_L(0); PG8_BAR; PG8_MMA(0, 0, At, B0); PG8_MMA(0, 1, At, B1); PG8_BAR; PG8_SCHED;
            PG8_LDA(At, 1, 1); PG8_STAGE(PG8_SB(1, 0), b3, voffB); PG8_STAGE(PG8_SB(1, 1), b3 + hstepB, voffB); PG8_STAGE(PG8_SA(1, 0), a3, voffA);
            PG8_WAIT_V(8); PG8_WAIT_L(0); PG8_BAR; PG8_MMA(1, 0, At, B0); PG8_MMA(1, 1, At, B1); PG8_BAR; PG8_SCHED;
        }
        if (wr == 0) PG8_BAR;
        E(acc, cur, wr, wc, fr, fq);
        if (!has_next) break;
#pragma unroll
        for (int a = 0; a < 2; ++a)
#pragma unroll
            for (int b = 0; b < 2; ++b)
#pragma unroll
                for (int m = 0; m < 4; ++m)
#pragma unroll
                    for (int n = 0; n < 2; ++n) acc[a][b][m][n] = (f32x4){0.f, 0.f, 0.f, 0.f};
        cur = nxt; cA = nA; cB = nB; ++ui;
        if (wr == 1) PG8_BAR;
    }
    PG8_WAIT_V(0);
    PG8_BAR;
#undef PG8_SA
#undef PG8_SB
#undef PG8_STAGE
#undef PG8_LDA
#undef PG8_LDB
#undef PG8_MMA
#undef PG8_WAIT_V
#undef PG8_WAIT_L
#undef PG8_BAR
#undef PG8_SCHED
}
}

struct Args { const float* in[32]; float* out; unsigned char* ws; };

struct Frame {
    LAS unsigned char* lds;
    int tid, lane, wave, vcu, G, gw, NGW, bx;
    const float* const* in;
};
enum { I_X = 0, I_C, I_CTX, I_CCTX, I_ADAW, I_ADAB, I_NORMG, I_FWIN, I_FWOUT, I_DAWIN, I_DAWOUT, I_DALAM, I_DASUB, I_NAWIN, I_NAWOUT, I_NARPB,
       I_RWMU, I_RWWIN, I_RWWOUT, I_RWW0, I_RWW1, I_RWW2, I_RWA0, I_RWA1, I_RWA2, I_RWG1, I_RWG2, I_RWKK, I_RWKA, I_RWRK, I_RWLNG, I_RWLNB };

DI void conv_item(const float* W, int ldw, int k0, int n0, int kmax, const float* mu, bf16_t* dst, int ldd, int dst_row0, int dst_k0, LAS float* scr, int lane) {
    float cv[32];
#pragma unroll
    for (int i = 0; i < 32; ++i) { const int k = k0 + 2 * i + (lane >> 5); cv[i] = (k < kmax) ? W[(size_t)k * ldw + n0 + (lane & 31)] : 0.f; }
    if (mu) {
#pragma unroll
        for (int i = 0; i < 32; ++i) { const int k = k0 + 2 * i + (lane >> 5); cv[i] *= (k < kmax) ? mu[k] : 0.f; }
    }
#pragma unroll
    for (int i = 0; i < 32; ++i) scr[(2 * i + (lane >> 5)) * 33 + (lane & 31)] = cv[i];
    asm volatile("s_waitcnt lgkmcnt(0)" ::: "memory");
    const int c = lane & 7;
#pragma unroll
    for (int j = 0; j < 4; ++j) { const int n = (lane >> 3) + 8 * j; const LAS float* s = scr + (8 * c) * 33 + n;
        u32x4 o; o.x = pk2(s[0 * 33], s[1 * 33]); o.y = pk2(s[2 * 33], s[3 * 33]); o.z = pk2(s[4 * 33], s[5 * 33]); o.w = pk2(s[6 * 33], s[7 * 33]);
        *(u32x4*)(dst + (size_t)(dst_row0 + n) * ldd + dst_k0 + k0 + 8 * c) = o; }
    asm volatile("s_waitcnt lgkmcnt(0)" ::: "memory");
}

DI void convert_layer(Frame& F, unsigned char* ws, int l) {
    bf16_t* WB = (bf16_t*)(ws + WS_WB);
    LAS float* scr = (LAS float*)(F.lds + F.wave * 16384);
    const int kind = l % 3, slot = l / 3;
    constexpr int I_FIN = 16 * 176, I_FOUT = 44 * 32, I_MIN = 16 * 96, I_MOUT = 16 * 32;
    const float* fwin = F.in[I_FWIN] + (size_t)l * 2 * 1024 * 5632;
    const float* fwout = F.in[I_FWOUT] + (size_t)l * 2 * 2816 * 1024;
    int nitems = 2 * I_FIN + 2 * I_FOUT + I_MOUT;
    if (kind == 2) nitems += 2 * I_MIN + 4 * 16 * 2 * 2 + 16 * 5 * 2 + 4 * 32 + 96;
    else nitems += I_MIN;
    for (int it = F.gw; it < nitems; it += F.NGW) {
        int r = it;
        if (r < 2 * I_FIN) { const int s = r / I_FIN; r -= s * I_FIN; const int kb = r / 176, nb = r % 176, n0 = nb * 32;
            const int hf = n0 / 2816, rem = n0 % 2816, p = rem / 128, i = rem % 128;
            conv_item(fwin + (size_t)s * 1024 * 5632, 5632, kb * 64, n0, 1024, nullptr, WB + (s ? WB_IN1 : WB_IN0), 1024, p * 256 + hf * 128 + i, 0, scr, F.lane); continue; }
        r -= 2 * I_FIN;
        if (r < 2 * I_FOUT) { const int s = r / I_FOUT; r -= s * I_FOUT; const int kb = r / 32, nb = r % 32;
            conv_item(fwout + (size_t)s * 2816 * 1024, 1024, kb * 64, nb * 32, 2816, nullptr, WB + (s ? WB_OUT1 : WB_OUT0), 2816, nb * 32, 0, scr, F.lane); continue; }
        r -= 2 * I_FOUT;
        if (r < I_MOUT) { const float* w = kind == 0 ? F.in[I_DAWOUT] + (size_t)slot * 1024 * 1024 : kind == 1 ? F.in[I_NAWOUT] : F.in[I_RWWOUT];
            const int kb = r / 32, nb = r % 32;
            conv_item(w, 1024, kb * 64, nb * 32, 1024, nullptr, WB + WB_MIXOUT, 1024, nb * 32, 0, scr, F.lane); continue; }
        r -= I_MOUT;
        if (kind != 2) { const float* w = kind == 0 ? F.in[I_DAWIN] + (size_t)slot * 1024 * 3072 : F.in[I_NAWIN];
            const int kb = r / 96, nb = r % 96;
            conv_item(w, 3072, kb * 64, nb * 32, 1024, nullptr, WB + WB_MIXIN, 1024, nb * 32, 0, scr, F.lane); continue; }
        const float* mu = F.in[I_RWMU];
        if (r < 2 * I_MIN) { const int var = r / I_MIN; r -= var * I_MIN; const int kb = r / 96, nb = r % 96, n0 = nb * 32;
            const int mj = n0 < 1024 ? 0 : (n0 < 2048 ? 2 : 3);
            conv_item(F.in[I_RWWIN], 3072, kb * 64, n0, 1024, var ? mu + mj * 1024 : nullptr, WB + WB_MIXIN, 2048, n0, var * 1024, scr, F.lane); continue; }
        r -= 2 * I_MIN;
        if (r < 4 * 16 * 2 * 2) { const int var = r & 1; r >>= 1; const int nb = r & 1; r >>= 1; const int kb = r & 15; r >>= 4; const int dir = r & 1, isa = r >> 1;
            const float* w = (isa ? F.in[I_RWA1] : F.in[I_RWW1]) + (size_t)dir * 1024 * 64;
            conv_item(w, 64, kb * 64, nb * 32, 1024, var ? mu + (isa ? 4 : 1) * 1024 : nullptr, WB + WB_MIXIN, 2048, (isa ? 3200 : 3072) + dir * 64 + nb * 32, var * 1024, scr, F.lane); continue; }
        r -= 4 * 16 * 2 * 2;
        if (r < 16 * 5 * 2) { const int var = r & 1; r >>= 1; const int nb = r % 5, kb = r / 5;
            conv_item(F.in[I_RWG1], 160, kb * 64, nb * 32, 1024, var ? mu + 5 * 1024 : nullptr, WB + WB_MIXIN, 2048, 3328 + nb * 32, var * 1024, scr, F.lane); continue; }
        r -= 16 * 5 * 2;
        if (r < 4 * 32) { const int kb = r / 32, nb = r % 32;
            conv_item(F.in[I_RWG2], 1024, kb * 64, nb * 32, 160, nullptr, WB + WB_G2T, 256, nb * 32, 0, scr, F.lane); continue; }
        r -= 4 * 32;
        { bf16_t* z = WB + WB_MIXIN + (size_t)(3488 + r) * 2048;
#pragma unroll
          for (int j = 0; j < 4; ++j) *(u32x4*)(z + (j * 64 + F.lane) * 8) = (u32x4){0u, 0u, 0u, 0u}; }
    }
}

DI void phase0(Frame& F, unsigned char* ws) {
    LAS float* sl = (LAS float*)F.lds;
    LAS float* part = (LAS float*)(F.lds + 69632);
    float* MOD = (float*)(ws + WS_MOD);
    for (int i = F.tid; i < 17 * 1024; i += 512) { const float v = i < 16384 ? F.in[I_C][i] : F.in[I_CCTX][i - 16384]; sl[i] = v / (1.f + expf(-v)); }
    __syncthreads();
    for (int item = F.vcu; item < 4 * 72; item += F.G) {
        const int l = item / 72, n0 = (item % 72) * 128;
        const float* W = F.in[I_ADAW] + (size_t)l * 1024 * NMOD + n0 + 2 * F.lane;
        float acc[17][2];
#pragma unroll
        for (int r = 0; r < 17; ++r) { acc[r][0] = 0.f; acc[r][1] = 0.f; }
        const int kbase = F.wave * 128;
        f32x2 wn[16];
#pragma unroll
        for (int e = 0; e < 16; ++e) wn[e] = *(const f32x2*)(W + (size_t)(kbase + e) * NMOD);
        for (int k16 = 0; k16 < 128; k16 += 16) {
            f32x2 w[16];
#pragma unroll
            for (int e = 0; e < 16; ++e) w[e] = wn[e];
            if (k16 + 16 < 128) {
#pragma unroll
                for (int e = 0; e < 16; ++e) wn[e] = *(const f32x2*)(W + (size_t)(kbase + k16 + 16 + e) * NMOD);
            }
#pragma unroll
            for (int q = 0; q < 4; ++q)
#pragma unroll
                for (int r = 0; r < 17; ++r) { const f32x4 s = *(const LAS f32x4*)(sl + r * 1024 + kbase + k16 + 4 * q);
#pragma unroll
                    for (int e = 0; e < 4; ++e) { acc[r][0] += s[e] * w[4 * q + e].x; acc[r][1] += s[e] * w[4 * q + e].y; } }
        }
#pragma unroll
        for (int r = 0; r < 17; ++r) *(LAS f32x2*)(part + (F.wave * 17 + r) * 128 + 2 * F.lane) = (f32x2){acc[r][0], acc[r][1]};
        __syncthreads();
        for (int idx = F.tid; idx < 17 * 128; idx += 512) { const int r = idx >> 7, cI = idx & 127; float s = 0.f;
#pragma unroll
            for (int w = 0; w < 8; ++w) s += part[(w * 17 + r) * 128 + cI];
            MOD[((size_t)l * 17 + r) * NMOD + n0 + cI] = s + F.in[I_ADAB][(size_t)l * NMOD + n0 + cI]; }
        __syncthreads();
    }
    if (F.bx == 0) {
        for (int i = F.tid; i < 3456; i += 512) ((unsigned*)(ws + WS_BAR))[i] = 0u;
        float* cosT = (float*)(ws + WS_ROPE); float* sinT = cosT + 1024;
        for (int i = F.tid; i < 1024; i += 512) { const int pos = i >> 4, p = i & 15; const float fr = powf(10000.f, -(float)p / 16.f); const float ang = (float)pos * fr; cosT[i] = cosf(ang); sinT[i] = sinf(ang); }
        if (F.tid < 2) { const float* lv = F.in[I_DALAM] + F.tid * 256; float d0 = 0.f, d1 = 0.f;
            for (int i = 0; i < 64; ++i) { d0 += lv[i] * lv[64 + i]; d1 += lv[128 + i] * lv[192 + i]; }
            const float li = 0.8f - 0.6f * expf(-0.3f * (float)(F.tid * 3));
            float* lam = (float*)(ws + WS_LAM); lam[2 * F.tid] = expf(d0) - expf(d1) + li; lam[2 * F.tid + 1] = li; }
    }
    __syncthreads();
    convert_layer(F, ws, 0);
}

struct RowPass {
    const float* hsrc_lat; const float* hsrc_ctx; float* hdst_lat; float* hdst_ctx;
    const bf16_t* Y;
    const float* gpost; int gate_idx; float coef; int lpost;
    const float* gpre; int shift_idx; int lpre;
    bf16_t* U; int ldu; int skip_ctx;
};
DI void row_pass(Frame& F, unsigned char* ws, const RowPass& P, int row_lo, int row_hi, int widx, int nw) {
    const float* MOD = (const float*)(ws + WS_MOD);
    const int rpw = (row_hi - row_lo + nw - 1) / nw;
    const int rbeg = row_lo + widx * rpw, rend = min(rbeg + rpw, row_hi);
    if (rbeg >= rend) return;
    const int l4 = 4 * F.lane;
    f32x4 gpo[4], gpr[4], gat[4], shf[4], scl[4];
#pragma unroll
    for (int j = 0; j < 4; ++j) { gpo[j] = *(const f32x4*)(P.gpost + l4 + 256 * j); gpr[j] = P.gpre ? *(const f32x4*)(P.gpre + l4 + 256 * j) : (f32x4){0.f, 0.f, 0.f, 0.f}; }
    int cur_mrow = -1;
    f32x4 hn[4]; u32x2 yn[4];
#define RP_ADDR(row, isctx, hoff) const int _b = (row) / LROW, _t = (row) % LROW; const bool isctx = _t < CTX; \
        const size_t hoff = isctx ? ((size_t)_b * CTX + _t) * DM : ((size_t)_b * SEQ + (_t - CTX)) * DM;
#define RP_LOAD(row) do { RP_ADDR(row, ic_, ho_) if (!(ic_ && P.skip_ctx)) { const float* hs_ = (ic_ ? P.hsrc_ctx : P.hsrc_lat) + ho_ + l4; \
        _Pragma("unroll") for (int j = 0; j < 4; ++j) hn[j] = *(const f32x4*)(hs_ + 256 * j); \
        if (P.Y) { const bf16_t* yr_ = P.Y + (size_t)(row) * DM + l4; _Pragma("unroll") for (int j = 0; j < 4; ++j) yn[j] = *(const u32x2*)(yr_ + 256 * j); } } } while (0)
    RP_LOAD(rbeg);
    for (int row = rbeg; row < rend; ++row) {
        f32x4 h[4]; u32x2 yv[4];
#pragma unroll
        for (int j = 0; j < 4; ++j) { h[j] = hn[j]; yv[j] = yn[j]; }
        if (row + 1 < rend) RP_LOAD(row + 1);
        RP_ADDR(row, isctx, hoff)
        if (isctx && P.skip_ctx) continue;
        float* hd = (isctx ? P.hdst_ctx : P.hdst_lat) + hoff + l4;
        const bool copy_h = ((isctx ? P.hsrc_ctx : P.hsrc_lat) != (isctx ? P.hdst_ctx : P.hdst_lat));
        const int mrow = isctx ? 16 : _b;
        if (mrow != cur_mrow) { cur_mrow = mrow;
            const float* gate = MOD + ((size_t)P.lpost * 17 + mrow) * NMOD + P.gate_idx * DM + l4;
            const float* sh = MOD + ((size_t)P.lpre * 17 + mrow) * NMOD + P.shift_idx * DM + l4;
#pragma unroll
            for (int j = 0; j < 4; ++j) { gat[j] = *(const f32x4*)(gate + 256 * j) * P.coef; shf[j] = *(const f32x4*)(sh + 256 * j); scl[j] = *(const f32x4*)(sh + DM + 256 * j) + 1.f; } }
        if (P.Y) {
            f32x4 y[4]; float ss = 0.f;
#pragma unroll
            for (int j = 0; j < 4; ++j) { y[j] = (f32x4){bflo(yv[j].x), bfhi(yv[j].x), bflo(yv[j].y), bfhi(yv[j].y)};
                ss += (y[j].x * y[j].x + y[j].y * y[j].y) + (y[j].z * y[j].z + y[j].w * y[j].w); }
            const float rstd = 1.f / sqrtf(wave_sum(ss) * (1.f / DM) + NORM_EPS);
#pragma unroll
            for (int j = 0; j < 4; ++j) h[j] = h[j] + gat[j] * ((y[j] * rstd) * gpo[j]);
        }
        if (P.Y || copy_h) {
#pragma unroll
            for (int j = 0; j < 4; ++j) *(f32x4*)(hd + 256 * j) = h[j];
        }
        if (P.gpre) {
            float ss = 0.f;
#pragma unroll
            for (int j = 0; j < 4; ++j) ss += (h[j].x * h[j].x + h[j].y * h[j].y) + (h[j].z * h[j].z + h[j].w * h[j].w);
            const float rstd = 1.f / sqrtf(wave_sum(ss) * (1.f / DM) + NORM_EPS);
            bf16_t* ur = P.U + (size_t)row * P.ldu + l4;
#pragma unroll
            for (int j = 0; j < 4; ++j) { const f32x4 u = ((h[j] * rstd) * gpr[j]) * scl[j] + shf[j];
                *(u32x2*)(ur + 256 * j) = (u32x2){pk2(u.x, u.y), pk2(u.z, u.w)}; }
        }
    }
#undef RP_ADDR
#undef RP_LOAD
}

DI void xx_pass(Frame& F, unsigned char* ws) {
    bf16_t* U = (bf16_t*)(ws + WS_U);
    u32x4 nc[2], np[2], nn[2];
#define XX_LOAD(row_) do { const int t_ = (row_) % LROW; const bool fi_ = (t_ == 0) || (t_ == CTX), la_ = (t_ == CTX - 1) || (t_ == LROW - 1); \
        const bf16_t* ur_ = U + (size_t)(row_) * 2048 + 8 * F.lane; \
        _Pragma("unroll") for (int j = 0; j < 2; ++j) { nc[j] = *(const u32x4*)(ur_ + 512 * j); np[j] = (u32x4){0u, 0u, 0u, 0u}; nn[j] = np[j]; \
            if (!fi_) np[j] = *(const u32x4*)(ur_ - 2048 + 512 * j); if (!la_) nn[j] = *(const u32x4*)(ur_ + 2048 + 512 * j); } } while (0)
    if (F.gw < MROWS) XX_LOAD(F.gw);
    for (int row = F.gw; row < MROWS; row += F.NGW) {
        u32x4 c[2], p[2], n[2];
#pragma unroll
        for (int j = 0; j < 2; ++j) { c[j] = nc[j]; p[j] = np[j]; n[j] = nn[j]; }
        if (row + F.NGW < MROWS) XX_LOAD(row + F.NGW);
        bf16_t* ur = U + (size_t)row * 2048 + 8 * F.lane;
#pragma unroll
        for (int j = 0; j < 2; ++j) {
            u32x4 o;
#pragma unroll
            for (int e = 0; e < 4; ++e) { const float lo = 0.5f * (bflo(p[j][e]) + bflo(n[j][e])) - bflo(c[j][e]); const float hi = 0.5f * (bfhi(p[j][e]) + bfhi(n[j][e])) - bfhi(c[j][e]); o[e] = pk2(lo, hi); }
            *(u32x4*)(ur + 1024 + 512 * j) = o;
        }
    }
#undef XX_LOAD
}

DI f32x16 mfma32(bf16x8 a, bf16x8 b, f32x16 c) { return __builtin_amdgcn_mfma_f32_32x32x16_bf16(a, b, c, 0, 0, 0); }
DI bf16x8 pack8(const f32x16& x, int s) { u32x4 p; p.x = pk2(x[8 * s], x[8 * s + 1]); p.y = pk2(x[8 * s + 2], x[8 * s + 3]); p.z = pk2(x[8 * s + 4], x[8 * s + 5]); p.w = pk2(x[8 * s + 6], x[8 * s + 7]); return __builtin_bit_cast(bf16x8, p); }
typedef short v4i16_t __attribute__((ext_vector_type(4)));
DI s16x4 vtr(LAS const unsigned char* p) { return __builtin_bit_cast(s16x4, __builtin_amdgcn_ds_read_tr16_b64_v4i16((LAS v4i16_t*)p)); }
DI float max3f(float a, float b, float c) { return __builtin_fmaxf(__builtin_fmaxf(a, b), c); }
DI float max16(const f32x16& p) { float a = max3f(p[0], p[1], p[2]), b = max3f(p[3], p[4], p[5]);
    a = max3f(a, p[6], p[7]); b = max3f(b, p[8], p[9]); a = max3f(a, p[10], p[11]); b = max3f(b, p[12], p[13]); a = max3f(a, p[14], p[15]); return __builtin_fmaxf(a, b); }

template <int NDB>
DI void softmax_pv(f32x16& p0, f32x16& p1, f32x16 (&o)[NDB], f32x16& negm, float& m_run, float& l_run, const bool first, LAS float* wsf, LAS const unsigned char* Vb, int KP, int r, int hh, int lane) {
    const int i16 = lane & 15, q4 = i16 >> 2, p4 = i16 & 3, g1 = (lane >> 4) & 1;
    LAS const unsigned char* vl = Vb + (4 * hh + q4) * 64 + 32 * g1 + 8 * p4;
    s16x4 flo[2][NDB], fhi[2][NDB];
#pragma unroll
    for (int d = 0; d < NDB; ++d) { flo[0][d] = vtr(vl + d * 4096); fhi[0][d] = vtr(vl + 8 * 64 + d * 4096); }
    __builtin_amdgcn_sched_barrier(0);
    float mx = __builtin_fmaxf(max16(p0), max16(p1)); mx = __builtin_fmaxf(mx, __shfl_xor(mx, 32));
    if (first || __any(mx > 8.f)) {
        const float delta = first ? mx : __builtin_fmaxf(mx, 0.f);
        m_run += delta;
#pragma unroll
        for (int i = 0; i < 16; ++i) { p0[i] -= delta; p1[i] -= delta; negm[i] = -m_run; }
        if (!first) {
            const float alpha = __builtin_amdgcn_exp2f(-delta);
            l_run *= alpha;
            if (hh == 0) wsf[r] = alpha;
#pragma unroll
            for (int g4 = 0; g4 < 4; ++g4) { const f32x4 a4 = *(const LAS f32x4*)(wsf + 8 * g4 + 4 * hh);
#pragma unroll
                for (int d = 0; d < NDB; ++d)
#pragma unroll
                    for (int e = 0; e < 4; ++e) o[d][4 * g4 + e] *= a4[e]; }
        }
    }
    f32x2 ls2 = {0.f, 0.f};
#pragma unroll
    for (int i = 0; i < 16; i += 2) {
        p0[i] = __builtin_amdgcn_exp2f(p0[i]); p0[i + 1] = __builtin_amdgcn_exp2f(p0[i + 1]); p1[i] = __builtin_amdgcn_exp2f(p1[i]); p1[i + 1] = __builtin_amdgcn_exp2f(p1[i + 1]);
        ls2 += (f32x2){p0[i], p0[i + 1]}; ls2 += (f32x2){p1[i], p1[i + 1]};
    }
    l_run += ls2.x + ls2.y;
    const bf16x8 pa[4] = {pack8(p0, 0), pack8(p0, 1), pack8(p1, 0), pack8(p1, 1)};
#pragma unroll
    for (int k = 0; k < 4; ++k) {
        if (k + 1 < 4) {
            LAS const unsigned char* vk = vl + 16 * (k + 1) * 64;
#pragma unroll
            for (int d = 0; d < NDB; ++d) { flo[(k + 1) & 1][d] = vtr(vk + d * 4096); fhi[(k + 1) & 1][d] = vtr(vk + 8 * 64 + d * 4096); }
        }
        __builtin_amdgcn_sched_barrier(0);
#pragma unroll
        for (int d = 0; d < NDB; ++d) { const bf16x8 vb = __builtin_shufflevector(flo[k & 1][d], fhi[k & 1][d], 0, 1, 2, 3, 4, 5, 6, 7); o[d] = mfma32(pa[k], vb, o[d]); }
        __builtin_amdgcn_sched_barrier(0);
    }
}

DI void da_pv_plain(const bf16x8 (&pa)[4], f32x16 (&o)[4], LAS const unsigned char* Vb, int hh, int lane) {
    const int i16 = lane & 15, q4 = i16 >> 2, p4 = i16 & 3, g1 = (lane >> 4) & 1;
    LAS const unsigned char* vl = Vb + (4 * hh + q4) * 64 + 32 * g1 + 8 * p4;
#pragma unroll
    for (int k = 0; k < 4; ++k) {
        s16x4 lo[4], hi[4];
#pragma unroll
        for (int d = 0; d < 4; ++d) { lo[d] = vtr(vl + 16 * k * 64 + d * 4096); hi[d] = vtr(vl + 16 * k * 64 + 8 * 64 + d * 4096); }
#pragma unroll
        for (int d = 0; d < 4; ++d) { const bf16x8 vb = __builtin_shufflevector(lo[d], hi[d], 0, 1, 2, 3, 4, 5, 6, 7); o[d] = mfma32(pa[k], vb, o[d]); }
    }
}
DI void da_step(f32x16& p0, f32x16& p1, f32x16 (&o)[4], float& m_run, float& l_run, bf16x8 (&pa)[4], const bool first, LAS float* wsf, LAS const unsigned char* Vprev, int r, int hh, int lane) {
    float mx = __builtin_fmaxf(max16(p0), max16(p1)); mx = __builtin_fmaxf(mx, __shfl_xor(mx, 32));
    const bool need = first || __any(mx > 8.f);
    float delta = 0.f;
    if (need) { delta = first ? mx : __builtin_fmaxf(mx, 0.f); m_run += delta;
#pragma unroll
        for (int i = 0; i < 16; ++i) { p0[i] -= delta; p1[i] -= delta; } }
    const int i16 = lane & 15, q4 = i16 >> 2, p4 = i16 & 3, g1 = (lane >> 4) & 1;
    LAS const unsigned char* vl = Vprev + (4 * hh + q4) * 64 + 32 * g1 + 8 * p4;
    s16x4 flo[2][4], fhi[2][4];
#pragma unroll
    for (int d = 0; d < 4; ++d) { flo[0][d] = vtr(vl + d * 4096); fhi[0][d] = vtr(vl + 8 * 64 + d * 4096); }
    u32x4 pn[4]; f32x2 ls2 = {0.f, 0.f};
#pragma unroll
    for (int k = 0; k < 4; ++k) {
#pragma unroll
        for (int d = 0; d < 4; ++d) {
            __builtin_amdgcn_sched_barrier(0);
            { const bf16x8 vb = __builtin_shufflevector(flo[k & 1][d], fhi[k & 1][d], 0, 1, 2, 3, 4, 5, 6, 7); o[d] = mfma32(pa[k], vb, o[d]); }
            if (k + 1 < 4) { flo[(k + 1) & 1][d] = vtr(vl + 16 * (k + 1) * 64 + d * 4096); fhi[(k + 1) & 1][d] = vtr(vl + 16 * (k + 1) * 64 + 8 * 64 + d * 4096); }
            const int i = 8 * (k & 1) + 2 * d;
            if (k < 2) { p0[i] = __builtin_amdgcn_exp2f(p0[i]); p0[i + 1] = __builtin_amdgcn_exp2f(p0[i + 1]); ls2 += (f32x2){p0[i], p0[i + 1]}; pn[k][d] = pk2(p0[i], p0[i + 1]); }
            else       { p1[i] = __builtin_amdgcn_exp2f(p1[i]); p1[i + 1] = __builtin_amdgcn_exp2f(p1[i + 1]); ls2 += (f32x2){p1[i], p1[i + 1]}; pn[k][d] = pk2(p1[i], p1[i + 1]); }
        }
    }
    __builtin_amdgcn_sched_barrier(0);
#pragma unroll
    for (int k = 0; k < 4; ++k) pa[k] = __builtin_bit_cast(bf16x8, pn[k]);
    if (need && !first) {
        const float alpha = __builtin_amdgcn_exp2f(-delta);
        l_run *= alpha;
        if (hh == 0) wsf[r] = alpha;
#pragma unroll
        for (int g4 = 0; g4 < 4; ++g4) { const f32x4 a4 = *(const LAS f32x4*)(wsf + 8 * g4 + 4 * hh);
#pragma unroll
            for (int d = 0; d < 4; ++d)
#pragma unroll
                for (int e = 0; e < 4; ++e) o[d][4 * g4 + e] *= a4[e]; }
    }
    l_run += ls2.x + ls2.y;
}

DI void da_unit(LAS unsigned char* lds, const int tid, const bf16_t* QKV, bf16_t* O, int q_row0, int kv_row0, int NT, int h, float lam, float one_m_li, const float* subg) {
    const int lane = tid & 63, wid = __builtin_amdgcn_readfirstlane(tid >> 6), r = lane & 31, hh = lane >> 5;
    const int qg = wid >> 1, j = wid & 1;
    constexpr int KP = 272, STG = 2 * 64 * KP;
    LAS float* wsf = (LAS float*)(lds + 3 * STG) + wid * 64;
    const bf16_t* gbase = QKV + (size_t)(kv_row0 + (tid >> 4)) * 3072 + 1024 + h * 128 + (tid & 15) * 8;
    const int lbase = (tid >> 4) * KP + (tid & 15) * 16;
    const int vbase = 64 * KP + ((tid & 15) >> 2) * 4096 + (tid >> 4) * 64 + (tid & 3) * 16;
    u32x4 st[4];
#define DA_LOAD(t) do { _Pragma("unroll") for (int i = 0; i < 4; ++i) st[i] = *(const u32x4*)(gbase + (size_t)(t) * 64 * 3072 + (size_t)(i & 1) * 32 * 3072 + (i >> 1) * 1024); } while (0)
#define DA_STORE(boff) do { _Pragma("unroll") for (int i = 0; i < 2; ++i) { *(LAS u32x4*)(lds + (boff) + lbase + i * 32 * KP) = st[i]; *(LAS u32x4*)(lds + (boff) + vbase + i * 32 * 64) = st[2 + i]; } } while (0)
    const bf16_t* qp = QKV + (size_t)(q_row0 + 32 * qg + r) * 3072 + h * 128 + j * 64 + 8 * hh;
    bf16x8 qr[4];
#pragma unroll
    for (int d0 = 0; d0 < 4; ++d0) qr[d0] = *(const bf16x8*)(qp + 16 * d0);
    f32x16 o[4];
#pragma unroll
    for (int d = 0; d < 4; ++d)
#pragma unroll
        for (int i = 0; i < 16; ++i) o[d][i] = 0.f;
    float m_run = 0.f, l_run = 0.f;
    bf16x8 pa[4];
#pragma unroll
    for (int k = 0; k < 4; ++k) pa[k] = (bf16x8){0, 0, 0, 0, 0, 0, 0, 0};
    DA_LOAD(0); DA_STORE(0);
    { LAS u32x4* z = (LAS u32x4*)(lds + 2 * STG + 64 * KP) + tid; z[0] = (u32x4){0u, 0u, 0u, 0u}; z[512] = (u32x4){0u, 0u, 0u, 0u}; }
    __syncthreads();
    int b_prv = 2 * STG, b_cur = 0, b_nxt = STG;
    for (int t = 0; t < NT; ++t) {
        if (t + 1 < NT) DA_LOAD(t + 1);
        LAS const unsigned char* Kb = lds + b_cur + j * 128 + r * KP + hh * 16;
        f32x16 p0, p1;
        { const float nm = -m_run;
#pragma unroll
          for (int i = 0; i < 16; ++i) { p0[i] = nm; p1[i] = nm; } }
#pragma unroll
        for (int d0 = 0; d0 < 4; ++d0) { const bf16x8 k0 = *(const LAS bf16x8*)(Kb + d0 * 32), k1 = *(const LAS bf16x8*)(Kb + 32 * KP + d0 * 32);
            p0 = mfma32(k0, qr[d0], p0); p1 = mfma32(k1, qr[d0], p1); }
        da_step(p0, p1, o, m_run, l_run, pa, t == 0, wsf, lds + b_prv + 64 * KP, r, hh, lane);
        if (t + 1 < NT) DA_STORE(b_nxt);
        LDS_BARRIER();
        { const int tmp_ = b_prv; b_prv = b_cur; b_cur = b_nxt; b_nxt = tmp_; }
    }
    da_pv_plain(pa, o, lds + b_prv + 64 * KP, hh, lane);
    LDS_BARRIER();
#undef DA_LOAD
#undef DA_STORE
    const float lt = l_run + __shfl_xor(l_run, 32);
    if (hh == 0) wsf[r] = 1.f / lt;
    float rl[16];
#pragma unroll
    for (int g4 = 0; g4 < 4; ++g4) { const f32x4 a4 = *(const LAS f32x4*)(wsf + 8 * g4 + 4 * hh);
#pragma unroll
        for (int e = 0; e < 4; ++e) rl[4 * g4 + e] = a4[e]; }
    LAS float* R = (LAS float*)lds + qg * 32 * 132;
    if (j == 1) {
#pragma unroll
        for (int d = 0; d < 4; ++d)
#pragma unroll
            for (int i = 0; i < 16; ++i) R[((i & 3) + 8 * (i >> 2) + 4 * hh) * 132 + d * 32 + r] = o[d][i] * rl[i] * lam;
    }
    __syncthreads();
    if (j == 0) {
#pragma unroll
        for (int d = 0; d < 4; ++d)
#pragma unroll
            for (int i = 0; i < 16; ++i) { const int idx = ((i & 3) + 8 * (i >> 2) + 4 * hh) * 132 + d * 32 + r; R[idx] = o[d][i] * rl[i] - R[idx]; }
    }
    __syncthreads();
    {
        const int row = tid >> 2, qtr = tid & 3;
        LAS const float* rp = (LAS const float*)lds + (row >> 5) * 32 * 132 + (row & 31) * 132 + qtr * 32;
        f32x4 v[8]; float ss = 0.f;
#pragma unroll
        for (int c = 0; c < 8; ++c) { v[c] = *(const LAS f32x4*)(rp + 4 * c); ss += (v[c].x * v[c].x + v[c].y * v[c].y) + (v[c].z * v[c].z + v[c].w * v[c].w); }
        ss += __shfl_xor(ss, 1); ss += __shfl_xor(ss, 2);
        const float rs = one_m_li / sqrtf(ss * (1.f / 128.f) + NORM_EPS);
        bf16_t* op = O + (size_t)(q_row0 + row) * DM + h * 128 + qtr * 32;
        const float* gp = subg + qtr * 32;
#pragma unroll
        for (int c = 0; c < 4; ++c) { const f32x4 g0 = *(const f32x4*)(gp + 8 * c), g1 = *(const f32x4*)(gp + 8 * c + 4); const f32x4 a = v[2 * c] * rs * g0, b = v[2 * c + 1] * rs * g1;
            *(u32x4*)(op + 8 * c) = (u32x4){pk2(a.x, a.y), pk2(a.z, a.w), pk2(b.x, b.y), pk2(b.z, b.w)}; }
    }
    __syncthreads();
}

DI void da_phase(Frame& F, unsigned char* ws, int l) {
    const bf16_t* QKV = (const bf16_t*)(ws + WS_ACT); bf16_t* O = (bf16_t*)(ws + WS_U);
    const int slot = l / 3; const bool last = (l == 3);
    const float* lamv = (const float*)(ws + WS_LAM); const float lam = lamv[2 * slot], li = lamv[2 * slot + 1];
    const float* subg = F.in[I_DASUB] + slot * 128;
    const int nunits = 2048 + (last ? 0 : 256);
    for (int u = F.vcu; u < nunits; u += F.G) {
        if (u < 2048) { const int bh = u >> 4, qt = u & 15, b = bh >> 3, h = bh & 7;
            da_unit(F.lds, F.tid, QKV, O, b * LROW + CTX + qt * 128, b * LROW, 36, h, lam, 1.f - li, subg); }
        else { const int v = u - 2048, bh = v >> 1, qt = v & 1, b = bh >> 3, h = bh & 7;
            da_unit(F.lds, F.tid, QKV, O, b * LROW + qt * 128, b * LROW, 4, h, lam, 1.f - li, subg); }
    }
}

DI void na_unit(LAS unsigned char* lds, const int tid, const bf16_t* QKV, bf16_t* O, const float* rpb, int b, int h, int R, int ctxq) {
    const int lane = tid & 63, wid = __builtin_amdgcn_readfirstlane(tid >> 6), r = lane & 31, hh = lane >> 5;
    constexpr int KP = 144, STG = 2 * 64 * KP;
    LAS float* wsf = (LAS float*)(lds + 2 * STG) + wid * 64;
    LAS float* rpbL = (LAS float*)(lds + 2 * STG + 2048) + 48;
    const int rw = 4 * R + (wid >> 1), cq = 32 * (wid & 1) + r;
    const int rs_w = min(max(rw - 4, 0), 24);
    const int rlo = min(max(4 * R - 4, 0), 24), rhi = min(max(4 * R - 1, 0), 24) + 7;
    const int NT = ctxq ? 4 : 4 + (rhi - rlo + 1);
    const int q_row = ctxq ? b * LROW + 32 * wid + r : b * LROW + CTX + R * 256 + 32 * wid + r;
    if (!ctxq) { for (int i = tid; i < 465; i += 512) rpbL[i] = rpb[h * 465 + i] * LOG2E; if (tid < 48) { rpbL[tid - 48] = 0.f; rpbL[465 + tid] = 0.f; } }
    const int srow = tid >> 3, sch = tid & 7;
    const bf16_t* gb = QKV + (size_t)(b * LROW) * 3072 + 1024 + h * 64 + sch * 8;
    const int lbase = srow * KP + sch * 16;
    u32x4 st[2];
#define NA_ROW(t) ((t) < 4 ? 64 * (t) : CTX + (rlo + (t) - 4) * 64)
#define NA_LOAD(t) do { const bf16_t* _g = gb + (size_t)(NA_ROW(t) + srow) * 3072; st[0] = *(const u32x4*)_g; st[1] = *(const u32x4*)(_g + 1024); } while (0)
#define NA_STORE(buf) do { *(LAS u32x4*)(lds + (buf) * STG + lbase) = st[0]; *(LAS u32x4*)(lds + (buf) * STG + 64 * KP + (sch >> 2) * 4096 + srow * 64 + (sch & 3) * 16) = st[1]; } while (0)
    const bf16_t* qp = QKV + (size_t)q_row * 3072 + h * 64 + 8 * hh;
    bf16x8 qr[4];
#pragma unroll
    for (int d0 = 0; d0 < 4; ++d0) qr[d0] = *(const bf16x8*)(qp + 16 * d0);
    f32x16 o[2];
#pragma unroll
    for (int d = 0; d < 2; ++d)
#pragma unroll
        for (int i = 0; i < 16; ++i) o[d][i] = 0.f;
    float m_run = 0.f, l_run = 0.f;
    f32x16 negm;
#pragma unroll
    for (int i = 0; i < 16; ++i) negm[i] = 0.f;
    const int cs = min(max(cq - 8, 0), 48);
    float mk0[16], mk1[16];
#pragma unroll
    for (int i = 0; i < 16; ++i) { const int ck = (i & 3) + 8 * (i >> 2) + 4 * hh;
        mk0[i] = (ck >= cs && ck < cs + 16) ? 0.f : -1e30f; mk1[i] = (ck + 32 >= cs && ck + 32 < cs + 16) ? 0.f : -1e30f; }
    NA_LOAD(0); NA_STORE(0); __syncthreads();
    for (int t = 0; t < NT; ++t) {
        const int cur = t & 1;
        if (t + 1 < NT) NA_LOAD(t + 1);
        const int ri = rlo + t - 4;
        const bool active = (t < 4) || (ri >= rs_w && ri <= rs_w + 7);
        if (active) {
            LAS const unsigned char* Kb = lds + cur * STG + r * KP + hh * 16;
            LAS const unsigned char* Vb = lds + cur * STG + 64 * KP;
            f32x16 p0 = negm, p1 = negm;
#pragma unroll
            for (int d0 = 0; d0 < 4; ++d0) { const bf16x8 k0 = *(const LAS bf16x8*)(Kb + d0 * 32), k1 = *(const LAS bf16x8*)(Kb + 32 * KP + d0 * 32);
                p0 = mfma32(k0, qr[d0], p0); p1 = mfma32(k1, qr[d0], p1); }
            if (t >= 4) {
                LAS const float* bt = rpbL + (ri - rw + 7) * 31 + 15 - cq + 4 * hh;
#pragma unroll
                for (int i = 0; i < 16; ++i) { const int ci = (i & 3) + 8 * (i >> 2);
                    p0[i] = (p0[i] + bt[ci]) + mk0[i]; p1[i] = (p1[i] + bt[ci + 32]) + mk1[i]; }
            }
            softmax_pv<2>(p0, p1, o, negm, m_run, l_run, t == 0, wsf, Vb, KP, r, hh, lane);
        }
        if (t + 1 < NT) NA_STORE(cur ^ 1);
        LDS_BARRIER();
    }
#undef NA_ROW
#undef NA_LOAD
#undef NA_STORE
    const float lt = l_run + __shfl_xor(l_run, 32);
    if (hh == 0) wsf[r] = 1.f / lt;
    const int orow0 = (ctxq ? b * LROW : b * LROW + CTX + R * 256) + 32 * wid;
#pragma unroll
    for (int g4 = 0; g4 < 4; ++g4) { const f32x4 a4 = *(const LAS f32x4*)(wsf + 8 * g4 + 4 * hh);
#pragma unroll
        for (int e = 0; e < 4; ++e) { const int i = 4 * g4 + e; const int q = 8 * g4 + 4 * hh + e;
            bf16_t* op = O + (size_t)(orow0 + q) * DM + h * 64 + r;
            op[0] = (bf16_t)(pk2(o[0][i] * a4[e], 0.f) & 0xffffu); op[32] = (bf16_t)(pk2(o[1][i] * a4[e], 0.f) & 0xffffu); } }
    __syncthreads();
}

DI void na_phase(Frame& F, unsigned char* ws) {
    const bf16_t* QKV = (const bf16_t*)(ws + WS_ACT); bf16_t* O = (bf16_t*)(ws + WS_U);
    for (int u = F.vcu; u < 2048 + 256; u += F.G) {
        if (u < 2048) { const int bh = u >> 3, R = u & 7; na_unit(F.lds, F.tid, QKV, O, F.in[I_NARPB], bh >> 4, bh & 15, R, 0); }
        else { const int bh = u - 2048; na_unit(F.lds, F.tid, QKV, O, F.in[I_NARPB], bh >> 4, bh & 15, 0, 1); }
    }
}

template <int CTRL> DI float dppf(float x) { return __int_as_float(__builtin_amdgcn_update_dpp(0, __float_as_int(x), CTRL, 0xf, 0xf, false)); }
DI float allred8(float x) {
    float a, b, c;
    asm volatile("s_nop 1\n\tv_add_f32_dpp %0, %1, %1 row_half_mirror row_mask:0xf bank_mask:0xf bound_ctrl:1" : "=v"(a) : "v"(x));
    asm volatile("s_nop 1\n\tv_add_f32_dpp %0, %1, %1 quad_perm:[1,0,3,2] row_mask:0xf bank_mask:0xf bound_ctrl:1" : "=v"(b) : "v"(a));
    asm volatile("s_nop 1\n\tv_add_f32_dpp %0, %1, %1 quad_perm:[2,3,0,1] row_mask:0xf bank_mask:0xf bound_ctrl:1" : "=v"(c) : "v"(b));
    return c;
}
DI float allred8_ref(float x) { x += dppf<0x141>(x); x += dppf<0xB1>(x); x += dppf<0x4E>(x); return x; }
DI float allred16(float x) { x += dppf<0x128>(x); x += dppf<0x124>(x); x += dppf<0x122>(x); x += dppf<0x121>(x); return x; }
DI void rwkv_scan(Frame& F, unsigned char* ws) {
    const bf16_t* X = (const bf16_t*)(ws + WS_ACT);
    bf16_t* Y0 = (bf16_t*)(ws + WS_U) + (size_t)MROWS * DM;
    bf16_t* Y1 = (bf16_t*)(ws + WS_Y);
    float* CD = (float*)(ws + WS_CD);
    const int tid = F.tid, lane = F.lane, g = tid >> 8, gt = tid & 255, gwv = (tid >> 6) & 3;
    LAS float* buf = (LAS float*)(F.lds) + g * 5120;
    LAS float* ybuf0 = (LAS float*)(F.lds + 40960) + g * 2048;
    LAS float* red = (LAS float*)(F.lds + 57344) + g * 128;
    for (int s0 = F.vcu * 2; s0 < 512; s0 += F.G * 2) {
        const int s = s0 + g, dir = s >> 8, b = (s >> 4) & 15, h = s & 15;
        const int ch = 16 * gwv + (lane & 15), chn = h * 64 + ch, rq = lane >> 4;
        bf16x8 bw[2], ba[2];
#pragma unroll
        for (int ks = 0; ks < 2; ++ks) { u32x4 pw, pa;
#pragma unroll
            for (int e = 0; e < 4; ++e) { const int k = 32 * ks + 8 * rq + 2 * e;
                pw[e] = pk2(F.in[I_RWW2][(size_t)(dir * 64 + k) * 1024 + chn], F.in[I_RWW2][(size_t)(dir * 64 + k + 1) * 1024 + chn]);
                pa[e] = pk2(F.in[I_RWA2][(size_t)(dir * 64 + k) * 1024 + chn], F.in[I_RWA2][(size_t)(dir * 64 + k + 1) * 1024 + chn]); }
            bw[ks] = __builtin_bit_cast(bf16x8, pw); ba[ks] = __builtin_bit_cast(bf16x8, pa); }
        const float w0c = F.in[I_RWW0][dir * 1024 + chn], a0c = F.in[I_RWA0][dir * 1024 + chn], kkc = F.in[I_RWKK][chn], kac = F.in[I_RWKA][chn], rkc = F.in[I_RWRK][chn];
        const bf16_t* Xb = X + (size_t)(b * LROW) * 3584;
        bf16_t* Yd = (dir ? Y1 : Y0) + (size_t)(b * LROW) * DM + h * 64;
        float* CDd = CD + ((size_t)dir * MROWS + (size_t)b * LROW) * 16 + h;
        f32x2 S2[8];
#pragma unroll
        for (int i = 0; i < 8; ++i) S2[i] = (f32x2){0.f, 0.f};
        bf16x8 Bs[2];
        Bs[0] = (bf16x8){0, 0, 0, 0, 0, 0, 0, 0}; Bs[1] = Bs[0];
        const int vl = lane & 15, kq = lane >> 4;
        bf16x8 ahw[2], aha[2]; bf16_t rr_[4], kr_[4], vr_[4];
#define SC_RLO(c) (dir ? (((c) < 16 ? 255 - 16 * (c) : 2559 - 16 * (c)) - 15) : 16 * (c))
#define SC_LOAD(c) do { const int _rlo = SC_RLO(c); const bf16_t* _p = Xb + (size_t)(_rlo + (lane & 15)) * 3584 + 3072 + dir * 64 + 8 * rq; \
        ahw[0] = *(const bf16x8*)_p; ahw[1] = *(const bf16x8*)(_p + 32); aha[0] = *(const bf16x8*)(_p + 128); aha[1] = *(const bf16x8*)(_p + 160); \
        _Pragma("unroll") for (int j = 0; j < 4; ++j) { const bf16_t* _q = Xb + (size_t)(_rlo + 4 * rq + j) * 3584 + chn; rr_[j] = _q[0]; kr_[j] = _q[1024]; vr_[j] = _q[2048]; } } while (0)
#define SC_OUT(cc) do { const int rr_o = gt >> 4, c4_o = (gt & 15) * 4, js_o = dir ? 15 - rr_o : rr_o; const int rlo_o = SC_RLO(cc); \
        const f32x4 yv_o = *(const LAS f32x4*)(ybuf0 + ((cc) & 1) * 1024 + js_o * 64 + c4_o); \
        *(u32x2*)(Yd + (size_t)(rlo_o + rr_o) * DM + c4_o) = (u32x2){pk2(yv_o.x, yv_o.y), pk2(yv_o.z, yv_o.w)}; } while (0)
        SC_LOAD(0);
        for (int c = 0; c < 144; ++c) {
            const int rlo = SC_RLO(c);
            LAS float* cb = buf;
            LAS float* ybuf = ybuf0 + (c & 1) * 1024;
            f32x4 accw = {0.f, 0.f, 0.f, 0.f}, acca = {0.f, 0.f, 0.f, 0.f};
#pragma unroll
            for (int ks = 0; ks < 2; ++ks) { accw = __builtin_amdgcn_mfma_f32_16x16x32_bf16(ahw[ks], bw[ks], accw, 0, 0, 0); acca = __builtin_amdgcn_mfma_f32_16x16x32_bf16(aha[ks], ba[ks], acca, 0, 0, 0); }
            float dec[4], av[4], kkv[4], kd[4], rv[4], vv[4];
#pragma unroll
            for (int j = 0; j < 4; ++j) {
                const float z = w0c + accw[j]; dec[j] = fast_exp(-0.6065306597126334f * sigmoidf_(z));
                av[j] = sigmoidf_(a0c + acca[j]);
                const float kx = bf2f(kr_[j]); rv[j] = bf2f(rr_[j]); vv[j] = bf2f(vr_[j]);
                kkv[j] = kx * kkc; kd[j] = kx * (1.f + (av[j] - 1.f) * kac);
                const float nsq = allred16(kkv[j] * kkv[j]), cp = allred16(rv[j] * kd[j] * rkc);
                if ((lane & 15) == 0) { red[(4 * rq + j) * 4 + gwv] = nsq; red[64 + (4 * rq + j) * 4 + gwv] = cp; }
            }
            LDS_BARRIER();
            if (c > 0) SC_OUT(c - 1);
            const bf16_t rr_s[4] = {rr_[0], rr_[1], rr_[2], rr_[3]};
#pragma unroll
            for (int j = 0; j < 4; ++j) {
                const int rr = 4 * rq + j, js = dir ? 15 - rr : rr;
                const f32x4 n4 = *(const LAS f32x4*)(red + rr * 4);
                const float inv = __builtin_amdgcn_rsqf(fmaxf((n4.x + n4.y) + (n4.z + n4.w), 1e-24f));
                const float kkn = kkv[j] * inv;
                LAS float* d = cb + js * 320 + ch;
                d[0] = dec[j]; d[64] = kkn * av[j]; d[128] = kd[j]; d[192] = vv[j];
                LAS bf16_t* db = (LAS bf16_t*)(cb + js * 320 + 256) + ch;
                db[0] = (bf16_t)(pk2(-kkn, 0.f) & 0xffffu); db[64] = rr_s[j];
            }
            if (gt < 16) { const f32x4 c4 = *(const LAS f32x4*)(red + 64 + gt * 4); CDd[(size_t)(rlo + gt) * 16] = (c4.x + c4.y) + (c4.z + c4.w); }
            if (c + 1 < 144) SC_LOAD(c + 1);
            LDS_BARRIER();
            bf16x8 oa[2][2], orr[2][2]; f32x4 ow[2][4]; float ovt[2];
#define SC_OPS(P, js_) do { LAS const float* sb_ = cb + (js_) * 320; LAS const bf16_t* ab_ = (LAS const bf16_t*)(sb_ + 256) + 8 * kq; \
                oa[P][0] = *(const LAS bf16x8*)(ab_); oa[P][1] = *(const LAS bf16x8*)(ab_ + 32); orr[P][0] = *(const LAS bf16x8*)(ab_ + 64); orr[P][1] = *(const LAS bf16x8*)(ab_ + 96); \
                _Pragma("unroll") for (int s_ = 0; s_ < 2; ++s_) { LAS const float* ob2_ = sb_ + 32 * s_ + 8 * kq; ow[P][2 * s_] = *(const LAS f32x4*)(ob2_); ow[P][2 * s_ + 1] = *(const LAS f32x4*)(ob2_ + 4); } \
                ovt[P] = sb_[192 + 16 * gwv + vl]; } while (0)
            SC_OPS(0, 0);
#pragma unroll
            for (int js = 0; js < 16; ++js) {
                const int P = js & 1;
                f32x4 obv[4], odv[4];
                { LAS const float* sb_ = cb + js * 320 + 8 * kq;
#pragma unroll
                  for (int s_ = 0; s_ < 2; ++s_) { obv[2 * s_] = *(const LAS f32x4*)(sb_ + 32 * s_ + 64); obv[2 * s_ + 1] = *(const LAS f32x4*)(sb_ + 32 * s_ + 68); odv[2 * s_] = *(const LAS f32x4*)(sb_ + 32 * s_ + 128); odv[2 * s_ + 1] = *(const LAS f32x4*)(sb_ + 32 * s_ + 132); } }
                __builtin_amdgcn_sched_barrier(0);
                if (js + 1 < 16) SC_OPS(P ^ 1, js + 1);
                __builtin_amdgcn_sched_barrier(0);
                f32x4 acs = {0.f, 0.f, 0.f, 0.f};
                acs = __builtin_amdgcn_mfma_f32_16x16x32_bf16(oa[P][0], Bs[0], acs, 0, 0, 0); acs = __builtin_amdgcn_mfma_f32_16x16x32_bf16(oa[P][1], Bs[1], acs, 0, 0, 0);
                const float vt = ovt[P];
                const float sa = acs[0];
#pragma unroll
                for (int s_ = 0; s_ < 2; ++s_) {
                    const f32x4 w0 = ow[P][2 * s_], w1 = ow[P][2 * s_ + 1], b0 = obv[2 * s_], b1 = obv[2 * s_ + 1], d0 = odv[2 * s_], d1 = odv[2 * s_ + 1];
                    S2[4 * s_ + 0] = S2[4 * s_ + 0] * (f32x2){w0.x, w0.y} + ((f32x2){b0.x, b0.y} * sa + (f32x2){d0.x, d0.y} * vt);
                    S2[4 * s_ + 1] = S2[4 * s_ + 1] * (f32x2){w0.z, w0.w} + ((f32x2){b0.z, b0.w} * sa + (f32x2){d0.z, d0.w} * vt);
                    S2[4 * s_ + 2] = S2[4 * s_ + 2] * (f32x2){w1.x, w1.y} + ((f32x2){b1.x, b1.y} * sa + (f32x2){d1.x, d1.y} * vt);
                    S2[4 * s_ + 3] = S2[4 * s_ + 3] * (f32x2){w1.z, w1.w} + ((f32x2){b1.z, b1.w} * sa + (f32x2){d1.z, d1.w} * vt);
                    u32x4 pk; pk.x = pk2(S2[4 * s_ + 0].x, S2[4 * s_ + 0].y); pk.y = pk2(S2[4 * s_ + 1].x, S2[4 * s_ + 1].y); pk.z = pk2(S2[4 * s_ + 2].x, S2[4 * s_ + 2].y); pk.w = pk2(S2[4 * s_ + 3].x, S2[4 * s_ + 3].y);
                    Bs[s_] = __builtin_bit_cast(bf16x8, pk);
                }
                f32x4 acy = {0.f, 0.f, 0.f, 0.f};
                acy = __builtin_amdgcn_mfma_f32_16x16x32_bf16(orr[P][0], Bs[0], acy, 0, 0, 0); acy = __builtin_amdgcn_mfma_f32_16x16x32_bf16(orr[P][1], Bs[1], acy, 0, 0, 0);
                if (kq == 0) ybuf[js * 64 + 16 * gwv + vl] = acy[0];
                __builtin_amdgcn_sched_barrier(0);
            }
#undef SC_OPS
        }
        LDS_BARRIER();
        SC_OUT(143);
#undef SC_OUT
#undef SC_RLO
#undef SC_LOAD
        __syncthreads();
    }
}

DI void rwkv_readout(Frame& F, unsigned char* ws) {
    const bf16_t* X = (const bf16_t*)(ws + WS_ACT);
    bf16_t* G = (bf16_t*)(ws + WS_U);
    const bf16_t* Y0 = G + (size_t)MROWS * DM; const bf16_t* Y1 = (const bf16_t*)(ws + WS_Y);
    const float* CD = (const float*)(ws + WS_CD);
    const int c0 = 16 * F.lane, hd = F.lane >> 2;
    float lng[16], lnb[16];
#pragma unroll
    for (int i = 0; i < 16; i += 4) { const f32x4 g_ = *(const f32x4*)(F.in[I_RWLNG] + c0 + i), b_ = *(const f32x4*)(F.in[I_RWLNB] + c0 + i);
        lng[i] = g_.x; lng[i + 1] = g_.y; lng[i + 2] = g_.z; lng[i + 3] = g_.w; lnb[i] = b_.x; lnb[i + 1] = b_.y; lnb[i + 2] = b_.z; lnb[i + 3] = b_.w; }
    u32x4 na[2], nb[2], nv[2], ng_[2]; float ncd0 = 0.f, ncd1 = 0.f;
#define RD_LOAD(row_) do { _Pragma("unroll") for (int j = 0; j < 2; ++j) { na[j] = *(const u32x4*)(Y0 + (size_t)(row_) * DM + c0 + 8 * j); nb[j] = *(const u32x4*)(Y1 + (size_t)(row_) * DM + c0 + 8 * j); \
        nv[j] = *(const u32x4*)(X + (size_t)(row_) * 3584 + 2048 + c0 + 8 * j); ng_[j] = *(const u32x4*)(G + (size_t)(row_) * DM + c0 + 8 * j); } \
        ncd0 = CD[(size_t)(row_) * 16 + hd]; ncd1 = CD[((size_t)MROWS + (row_)) * 16 + hd]; } while (0)
    if (F.gw < MROWS) RD_LOAD(F.gw);
    for (int row = F.gw; row < MROWS; row += F.NGW) {
        float y[16], vv[16], gg[16];
        const float cc = ncd0 + ncd1;
#pragma unroll
        for (int j = 0; j < 2; ++j) {
            const u32x4 a = na[j], bq = nb[j], v4 = nv[j], g4 = ng_[j];
#pragma unroll
            for (int e = 0; e < 4; ++e) { y[8 * j + 2 * e] = bflo(a[e]) + bflo(bq[e]); y[8 * j + 2 * e + 1] = bfhi(a[e]) + bfhi(bq[e]);
                vv[8 * j + 2 * e] = bflo(v4[e]); vv[8 * j + 2 * e + 1] = bfhi(v4[e]); gg[8 * j + 2 * e] = bflo(g4[e]); gg[8 * j + 2 * e + 1] = bfhi(g4[e]); }
        }
        if (row + F.NGW < MROWS) RD_LOAD(row + F.NGW);
        float s = 0.f;
#pragma unroll
        for (int i = 0; i < 16; ++i) s += y[i];
        s += __shfl_xor(s, 1); s += __shfl_xor(s, 2);
        const float mean = s * (1.f / 64.f); float q = 0.f;
#pragma unroll
        for (int i = 0; i < 16; ++i) { y[i] -= mean; q += y[i] * y[i]; }
        q += __shfl_xor(q, 1); q += __shfl_xor(q, 2);
        const float rstd = 1.f / sqrtf(q * (1.f / 64.f) + 64e-5f);
        u32x4 o[2];
#pragma unroll
        for (int j = 0; j < 2; ++j)
#pragma unroll
            for (int e = 0; e < 4; ++e) { const int i = 8 * j + 2 * e;
                const float z0 = ((y[i] * rstd) * lng[i] + lnb[i] + cc * vv[i]) * gg[i];
                const float z1 = ((y[i + 1] * rstd) * lng[i + 1] + lnb[i + 1] + cc * vv[i + 1]) * gg[i + 1];
                o[j][e] = pk2(z0, z1); }
        *(u32x4*)(G + (size_t)row * DM + c0) = o[0]; *(u32x4*)(G + (size_t)row * DM + c0 + 8) = o[1];
    }
#undef RD_LOAD
}


#define XB_TMO      128
#define XB_XCNT(j)  (256  + 64 * (j))
#define XB_XSUB(j)  (1280 + 64 * (j))
#define XB_XGEN(j)  (2304 + 64 * (j))
#define XB_TOP      3328
#define XB_TOPGEN   3392
#define XCD_BAR_WORDS 3456
#define XB_SPIN_CAP (1u << 18)
DI unsigned xb_ld(unsigned* p)              { return __hip_atomic_load(p, __ATOMIC_RELAXED, __HIP_MEMORY_SCOPE_AGENT); }
DI unsigned xb_add(unsigned* p, unsigned v) { return __hip_atomic_fetch_add(p, v, __ATOMIC_RELAXED, __HIP_MEMORY_SCOPE_AGENT); }
DI unsigned xb_xcc_id() { return (unsigned)__builtin_amdgcn_s_getreg((3 << 11) | 20) & 0xFu; }
#define XB_SPIN(cond, bar) do { unsigned _sp = 0; while (cond) { __builtin_amdgcn_s_sleep(1); \
    if ((++_sp & 255u) == 0u) { if (xb_ld(&(bar)[XB_TMO])) break; if (_sp > XB_SPIN_CAP) { atomicAdd(&(bar)[XB_TMO], 1u); break; } } } } while (0)
struct XcdBarrier { unsigned* bar; unsigned x; volatile LAS unsigned* st; };
DI XcdBarrier xcd_barrier_post(unsigned* bar, volatile LAS unsigned* st) {
    XcdBarrier b; b.bar = bar; b.x = xb_xcc_id(); b.st = st;
    if (threadIdx.x == 0) (void)xb_add(&bar[XB_XCNT(b.x)], 1u);
    return b;
}
DI void xcd_barrier_complete(unsigned* bar, unsigned x, unsigned& nloc, unsigned& nx) {
    const unsigned G = gridDim.x * gridDim.y * gridDim.z;
    unsigned sum, cnt, mine, sp = 0u;
    for (;;) {
        sum = 0u; cnt = 0u; mine = 0u;
#pragma unroll
        for (unsigned j = 0; j < 16; ++j) { const unsigned c = xb_ld(&bar[XB_XCNT(j)]); sum += c; cnt += (c > 0u) ? 1u : 0u; mine = (j == x) ? c : mine; }
        if (sum == G) break;
        __builtin_amdgcn_s_sleep(1);
        if ((++sp & 255u) == 0u) { if (xb_ld(&bar[XB_TMO])) break; if (sp > XB_SPIN_CAP) { atomicAdd(&bar[XB_TMO], 1u); break; } }
    }
    nloc = mine > 0u ? mine : 1u; nx = cnt > 0u ? cnt : 1u;
}
DI void xcd_barrier(const XcdBarrier& b) {
    asm volatile("s_waitcnt vmcnt(0)" ::: "memory");
    __syncthreads();
    if (threadIdx.x == 0) {
        unsigned* bar = b.bar;
        __builtin_amdgcn_s_waitcnt(0);
        unsigned nloc = b.st[0], nx = b.st[1];
        if (nloc == 0u) { xcd_barrier_complete(bar, b.x, nloc, nx); b.st[0] = nloc; b.st[1] = nx; }
        const unsigned old = xb_add(&bar[XB_XSUB(b.x)], 1u);
        const unsigned gen = old / nloc;
        if (old + 1u == (gen + 1u) * nloc) {
            __builtin_amdgcn_fence(__ATOMIC_RELEASE, "agent");
            asm volatile("s_waitcnt vmcnt(0)" ::: "memory");
            const unsigned og = xb_add(&bar[XB_TOP], 1u);
            const unsigned tg = og / nx;
            if (og + 1u == (tg + 1u) * nx) xb_add(&bar[XB_TOPGEN], 1u);
            else XB_SPIN(xb_ld(&bar[XB_TOPGEN]) == tg, bar);
            __builtin_amdgcn_fence(__ATOMIC_ACQUIRE, "agent");
            xb_add(&bar[XB_XGEN(b.x)], 1u);
            asm volatile("s_waitcnt vmcnt(0)" ::: "memory");
        } else {
            XB_SPIN(xb_ld(&bar[XB_XGEN(b.x)]) == gen, bar);
            __builtin_amdgcn_fence(__ATOMIC_ACQUIRE, "agent");
            asm volatile("s_waitcnt vmcnt(0)" ::: "memory");
        }
    }
    __syncthreads();
}

enum { OP_RP0 = 0, OP_G1, OP_G2, OP_RP1, OP_XX, OP_RKVH, OP_GG, OP_SCAN, OP_RDOUT, OP_QKV, OP_ATT, OP_OPROJ, OP_RP2, OP_G5, OP_G6, OP_RP3, OP_END };
DI int next_op(int kind, int op) {
    switch (op) {
        case OP_RP0: return OP_G1; case OP_G1: return OP_G2; case OP_G2: return OP_RP1;
        case OP_RP1: return kind == 2 ? OP_XX : OP_QKV;
        case OP_XX: return OP_RKVH; case OP_RKVH: return OP_GG; case OP_GG: return OP_SCAN; case OP_SCAN: return OP_RDOUT; case OP_RDOUT: return OP_OPROJ;
        case OP_QKV: return OP_ATT; case OP_ATT: return OP_OPROJ; case OP_OPROJ: return OP_RP2;
        case OP_RP2: return OP_G5; case OP_G5: return OP_G6; case OP_G6: return OP_RP3; default: return OP_END;
    }
}

__global__ void __launch_bounds__(512, 2) mega(const float* i0, const float* i1, const float* i2, const float* i3, const float* i4, const float* i5, const float* i6, const float* i7, const float* i8, const float* i9, const float* i10, const float* i11, const float* i12, const float* i13, const float* i14, const float* i15, const float* i16, const float* i17, const float* i18, const float* i19, const float* i20, const float* i21, const float* i22, const float* i23, const float* i24, const float* i25, const float* i26, const float* i27, const float* i28, const float* i29, const float* i30, const float* i31, float* out, unsigned char* ws0) {
    const float* in_[32] = {i0, i1, i2, i3, i4, i5, i6, i7, i8, i9, i10, i11, i12, i13, i14, i15, i16, i17, i18, i19, i20, i21, i22, i23, i24, i25, i26, i27, i28, i29, i30, i31};
    extern __shared__ __attribute__((aligned(16))) unsigned char lds_raw[];
    cg::grid_group grid = cg::this_grid();
    Frame F;
#define BUILD_FRAME() do { int tid_ = threadIdx.x; asm volatile("" : "+v"(tid_)); int bx_ = blockIdx.x; asm volatile("" : "+s"(bx_)); \
    F.lds = (LAS unsigned char*)lds_raw; F.tid = tid_; F.lane = tid_ & 63; F.wave = __builtin_amdgcn_readfirstlane(tid_ >> 6); \
    F.G = gridDim.x; F.bx = bx_; F.vcu = (F.G % 8 == 0) ? (bx_ % 8) * (F.G / 8) + bx_ / 8 : bx_; \
    F.gw = F.vcu * 8 + F.wave; F.NGW = F.G * 8; F.in = in_; } while (0)
    BUILD_FRAME();
    unsigned char* ws = ws0;

#ifndef NO_P0
    phase0(F, ws);
#endif
    grid.sync();
    volatile LAS unsigned* bst = (volatile LAS unsigned*)(F.lds + LDS_BYTES - 64);
    if (F.tid < 2) bst[F.tid] = 0u;
    __syncthreads();
    const XcdBarrier xbar = xcd_barrier_post((unsigned*)(ws0 + WS_BAR), bst);

    for (int l = 0; l < 4; ++l) {
        const int kind = l % 3; const bool last = (l == 3);
        const float* ng = F.in[I_NORMG] + l * 6 * DM;
        int op = (l == 0) ? OP_RP0 : OP_G1;
        int sub = 0, rp_lo = 0;
        while (op != OP_END) {
            { size_t zoff = 0; asm volatile("" : "+s"(zoff)); ws = ws0 + zoff; }
            BUILD_FRAME();
            float* HC = (float*)(ws + WS_HC); bf16_t* WB = (bf16_t*)(ws + WS_WB); bf16_t* U = (bf16_t*)(ws + WS_U); bf16_t* ACT = (bf16_t*)(ws + WS_ACT); bf16_t* YB = (bf16_t*)(ws + WS_Y);
            const float* cosT = (const float*)(ws + WS_ROPE); const float* sinT = cosT + 1024;
            int rpop = -1, rlo = 0, rhi = MROWS, rwidx = F.gw, rnw = F.NGW; bool fill = false;
            if (op == OP_G1 || op == OP_G2 || op == OP_G5 || op == OP_G6 || op == OP_QKV || op == OP_RKVH || op == OP_GG || op == OP_OPROJ) {
                pg8::Gemm g; pg8::Epi E; E.cosT = cosT; E.sinT = sinT; int skip = 0;
                if (op == OP_G1 || op == OP_G5) { g.A = U; g.lda = 1024; g.Bt = WB + (op == OP_G1 ? WB_IN0 : WB_IN1); g.ldb = 1024; g.N = 5632; g.K = 1024; E.mode = pg8::EPI_SWIGLU; E.O = ACT; E.ldc = FF; skip = (last && op == OP_G5); }
                else if (op == OP_G2 || op == OP_G6) { g.A = ACT; g.lda = FF; g.Bt = WB + (op == OP_G2 ? WB_OUT0 : WB_OUT1); g.ldb = FF; g.N = 1024; g.K = FF; E.mode = pg8::EPI_PLAIN; E.O = YB; E.ldc = 1024; skip = (last && op == OP_G6); }
                else if (op == OP_QKV) { g.A = U; g.lda = 1024; g.Bt = WB + WB_MIXIN; g.ldb = 1024; g.N = 3072; g.K = 1024; E.mode = kind == 0 ? pg8::EPI_QKV_DA : pg8::EPI_QKV_NA; E.O = ACT; E.ldc = 3072; }
                else if (op == OP_RKVH) { g.A = U; g.lda = 2048; g.Bt = WB + WB_MIXIN; g.ldb = 2048; g.N = 3584; g.K = 2048; E.mode = pg8::EPI_RWKV; E.O = ACT; E.ldc = 3584; }
                else if (op == OP_GG) { g.A = ACT + 3328; g.lda = 3584; g.Bt = WB + WB_G2T; g.ldb = 256; g.N = 1024; g.K = 256; E.mode = pg8::EPI_PLAIN; E.O = U; E.ldc = 1024; }
                else { g.A = U; g.lda = 1024; g.Bt = WB + WB_MIXOUT; g.ldb = 1024; g.N = 1024; g.K = 1024; E.mode = pg8::EPI_PLAIN; E.O = YB; E.ldc = 1024; skip = last; }
                g.nM = skip ? 128 : 144; g.skip = skip;
                pg8::StaticOrder S; S.init(g.nM, g.N, F.G, F.bx, skip);
                fill = (op == OP_G2 || op == OP_G6 || op == OP_OPROJ) && !skip && F.G == 256;
                if (fill) { S.pmode = 1; S.r0 = sub ? 2 : 0; S.nr = sub ? 1 : 2;
                    if (sub == 1 && F.bx >= 64) { rpop = (op == OP_G2) ? OP_RP1 : (op == OP_G6 ? OP_RP3 : OP_RP2); rlo = 0; rhi = 128 * 256; rwidx = (F.bx - 64) * 8 + F.wave; rnw = 192 * 8; } }
#ifndef NO_GEMM
                pg8::gemm_phase(F.lds, F.tid, g, S, E);
#endif
            } else if (op == OP_RP0 || op == OP_RP1 || op == OP_RP2 || op == OP_RP3) { rpop = op; rlo = rp_lo; }
            if (rpop >= 0) {
                RowPass P;
                P.hsrc_lat = out; P.hsrc_ctx = HC; P.hdst_lat = out; P.hdst_ctx = HC; P.U = U; P.ldu = 1024; P.skip_ctx = 0; P.lpost = l; P.lpre = l;
                if (rpop == OP_RP0) { P.hsrc_lat = F.in[I_X]; P.hsrc_ctx = F.in[I_CTX]; P.hdst_lat = (float*)F.in[I_X]; P.hdst_ctx = (float*)F.in[I_CTX];   P.Y = nullptr; P.gpost = ng; P.gate_idx = 0; P.coef = 0.f; P.gpre = ng; P.shift_idx = 0; }
                else if (rpop == OP_RP1) { if (l == 0) { P.hsrc_lat = F.in[I_X]; P.hsrc_ctx = F.in[I_CTX]; } P.Y = YB; P.gpost = ng + DM; P.gate_idx = 2; P.coef = 0.5f; P.gpre = ng + 2 * DM; P.shift_idx = 3; P.ldu = (kind == 2) ? 2048 : 1024; }
                else if (rpop == OP_RP2) { P.Y = YB; P.gpost = ng + 3 * DM; P.gate_idx = 5; P.coef = 1.f; P.gpre = ng + 4 * DM; P.shift_idx = 6; P.skip_ctx = last; }
                else { P.Y = YB; P.gpost = ng + 5 * DM; P.gate_idx = 8; P.coef = 0.5f; P.gpre = last ? nullptr : ng + 6 * DM; P.shift_idx = 0; P.lpre = l + 1; P.skip_ctx = last; }
#ifndef NO_RP
                row_pass(F, ws, P, rlo, rhi, rwidx, rnw);
#endif
#ifndef NO_CONV
                if (op == OP_RP3 && !last) { __syncthreads(); convert_layer(F, ws, l + 1); }
#endif
            }
#ifndef NO_XX
            if (op == OP_XX) { xx_pass(F, ws); }
#endif

#ifndef NO_SCAN
            if (op == OP_SCAN) { rwkv_scan(F, ws); }
#endif

#ifndef NO_RDOUT
            if (op == OP_RDOUT) { rwkv_readout(F, ws); }
#endif

#ifndef NO_ATT
            if (op == OP_ATT) {
#ifndef NO_DA
 if (kind == 0) da_phase(F, ws, l);
#endif
#ifndef NO_NA
 if (kind == 1) na_phase(F, ws);
#endif
 }
#endif
            xcd_barrier(xbar);
            if (fill) { if (sub == 0) { sub = 1; continue; } sub = 0; rp_lo = 128 * 256; }
            else if (rpop >= 0) rp_lo = 0;
            op = next_op(kind, op);
        }
    }
}

extern "C" void kernel_launch(void* const* d_in, const int* in_sizes, int n_in, void* d_out, int out_size,
                              void* d_ws, size_t ws_size, hipStream_t stream) {
    static int grid = 0;
    if (grid == 0) {
        if (n_in != 32 || ws_size < WS_END) { fprintf(stderr, "kernel_launch: need 32 inputs and %zu B of workspace; got %d, %zu\n", (size_t)WS_END, n_in, ws_size); grid = -1; return; }
        int dev = 0, cus = 0, per_cu = 0;
        (void)hipGetDevice(&dev);
        (void)hipDeviceGetAttribute(&cus, hipDeviceAttributeMultiprocessorCount, dev);
        (void)hipFuncSetAttribute((const void*)mega, hipFuncAttributeMaxDynamicSharedMemorySize, LDS_BYTES);
        (void)hipOccupancyMaxActiveBlocksPerMultiprocessor(&per_cu, (const void*)mega, 512, LDS_BYTES);
        if (per_cu < 1) per_cu = 1;
        grid = cus * per_cu;
    }
    if (grid < 0) return;
    const float* inp[32]; for (int i = 0; i < 32; ++i) inp[i] = (const float*)d_in[i];
    float* outp = (float*)d_out; unsigned char* wsp = (unsigned char*)d_ws;
    void* kargs[34]; for (int i = 0; i < 32; ++i) kargs[i] = (void*)&inp[i];
    kargs[32] = (void*)&outp; kargs[33] = (void*)&wsp;
    hipError_t e = hipLaunchCooperativeKernel((const void*)mega, dim3(grid), dim3(512), kargs, LDS_BYTES, stream);
    if (e != hipSuccess) fprintf(stderr, "cooperative launch failed: %s (grid %d)\n", hipGetErrorString(e), grid);
}
```

```cpp
#include <hip/hip_runtime.h>
#include <hip/hip_cooperative_groups.h>
#include <cstdio>
#include <cstdint>
namespace cg = cooperative_groups;
#ifndef REP_MASK
#define REP_MASK 0
#endif

#define LAS __attribute__((address_space(3)))
#define DI __device__ __forceinline__
typedef unsigned short bf16_t;
typedef short bf16x8 __attribute__((ext_vector_type(8)));
typedef short s16x4 __attribute__((ext_vector_type(4)));
typedef float f32x2 __attribute__((ext_vector_type(2)));
typedef float f32x4 __attribute__((ext_vector_type(4)));
typedef float f32x16 __attribute__((ext_vector_type(16)));
typedef unsigned u32x4 __attribute__((ext_vector_type(4)));
typedef unsigned u32x2 __attribute__((ext_vector_type(2)));
typedef __bf16 bf2_t __attribute__((ext_vector_type(2)));

constexpr int DM = 1024, NB = 16, SEQ = 2048, CTX = 256, LROW = 2304, MROWS = NB * LROW, FF = 2816, NMOD = 9216;
constexpr float NORM_EPS = 1e-6f;
constexpr float LOG2E = 1.4426950408889634f;
constexpr float QSCALE = 0.125f * LOG2E;

constexpr size_t MiB = 1u << 20;
constexpr size_t WS_MOD = 0, WS_ROPE = 3 * MiB, WS_LAM = 3 * MiB + 16384, WS_BAR = 3 * MiB + 32768, WS_CD = 4 * MiB, WS_HC = 9 * MiB, WS_WB = 25 * MiB,
                 WS_U = 75 * MiB, WS_ACT = 219 * MiB, WS_Y = 471 * MiB, WS_END = 543 * MiB;
constexpr size_t WB_IN0 = 0, WB_OUT0 = 5767168, WB_IN1 = 8650752, WB_OUT1 = 14417920, WB_MIXIN = 17301504, WB_MIXOUT = 24641536, WB_G2T = 25690112;
constexpr int LDS_BYTES = 147456;

DI unsigned pk2(float lo, float hi) { f32x2 v = {lo, hi}; bf2_t b = __builtin_convertvector(v, bf2_t); return __builtin_bit_cast(unsigned, b); }
DI float bf2f(bf16_t h) { return __uint_as_float(((unsigned)h) << 16); }
DI float bflo(unsigned w) { return __uint_as_float(w << 16); }
DI float bfhi(unsigned w) { return __uint_as_float(w & 0xffff0000u); }
DI float wave_sum(float v) {
#pragma unroll
    for (int o = 1; o < 64; o <<= 1) v += __shfl_xor(v, o);
    return v;
}
#define LDS_BARRIER() asm volatile("s_waitcnt lgkmcnt(0)\n\ts_barrier" ::: "memory")
DI float fast_exp(float x) { return __builtin_amdgcn_exp2f(x * LOG2E); }
DI float sigmoidf_(float x) { return __builtin_amdgcn_rcpf(1.f + fast_exp(-x)); }
DI float siluf_(float x) { return x * sigmoidf_(x); }
DI float tanhf_(float x) { return 1.f - 2.f * __builtin_amdgcn_rcpf(1.f + fast_exp(2.f * x)); }

namespace pg8 {
constexpr int BM = 256, BK = 64, HALF = 128, HTB = HALF * BK * 2, NXCD = 8, WGM = 4;
__host__ __device__ __forceinline__ int lds_byte(int r, int c) { const int st = (r >> 4) * 2 + (c >> 5), rr = r & 15, cc = c & 31, ob = rr * 64 + cc * 2; return st * 1024 + (ob ^ (((ob >> 9) & 1) << 5)); }
__host__ __device__ __forceinline__ void stage_rc(int b, int& R, int& C) { const int st = b / 1024, sb = b % 1024, swz = sb ^ (((sb >> 9) & 1) << 5); R = (st >> 1) * 16 + swz / 64; C = (st & 1) * 32 + (swz % 64) / 2; }
__host__ __device__ __forceinline__ int perm32(int rho) { const int n = rho >> 4, i = rho & 15; return 8 * (i >> 2) + 4 * n + (i & 3); }

struct Unit { int pm, pn; };
struct Gemm { const bf16_t* A; const bf16_t* Bt; int lda, ldb, N, K, nM, skip; };

struct StaticOrder {
    int nM, nN, nwg, G, c, skip;
    int pmode, r0, nr;
    DI void init(int nM_, int N, int G_, int c_, int skip_) { nM = nM_; nN = N / BM; nwg = nM * nN; G = G_; c = c_; skip = skip_; pmode = 0; r0 = 0; nr = 0; }
    DI bool next(int i, Unit& u) const {
        if (pmode) {
            if (i >= nr) return false;
            const int round = r0 + i, xcd = c & 7, j = c >> 3, full = nM >> 6; int panel;
            if (round < full) { panel = round * 64 + xcd * 8 + (j & 7); u.pn = j >> 3; }
            else { if (j >= 8) return false; panel = full * 64 + 2 * xcd + (j & 1); u.pn = j >> 1; if (panel >= nM) return false; }
            u.pm = skip ? (panel + panel / 8 + 1) : panel;
            return true;
        }
        const long L = (long)i * G + c; if (L >= nwg) return false;
        int wgid = (int)L; { const int q = nwg / NXCD, r = nwg % NXCD, xcd = wgid % NXCD, off = wgid / NXCD; wgid = (xcd < r ? xcd * (q + 1) : r * (q + 1) + (xcd - r) * q) + off; }
        const int nig = WGM * nN, gid = wgid / nig, fm = gid * WGM, gsz = (nM - fm) < WGM ? (nM - fm) : WGM;
        int pm = fm + ((wgid % nig) % gsz); u.pn = (wgid % nig) / gsz;
        u.pm = skip ? (pm + pm / 8 + 1) : pm;
        return true;
    }
};

enum { EPI_PLAIN = 0, EPI_SWIGLU = 1, EPI_QKV_DA = 2, EPI_QKV_NA = 3, EPI_RWKV = 4 };
struct Epi {
    static constexpr bool PERM = true;
    int mode; bf16_t* O; int ldc; const float* cosT; const float* sinT;
    DI void operator()(const f32x4 (&acc)[2][2][4][2], const Unit& u, int wr, int wc, int fr, int fq) const {
        const int row0 = u.pm * BM + wr * 64 + fr;
        if (mode == EPI_SWIGLU) {
            const int col0 = u.pn * 128 + wc * 32 + 8 * fq;
#pragma unroll
            for (int ai = 0; ai < 2; ++ai)
#pragma unroll
                for (int m = 0; m < 4; ++m) {
                    bf16_t* rowp = O + (size_t)(row0 + ai * HALF + m * 16) * ldc + col0;
                    const f32x4 a0 = acc[ai][0][m][0], a1 = acc[ai][0][m][1], b0 = acc[ai][1][m][0], b1 = acc[ai][1][m][1];
                    u32x4 w;
                    w.x = pk2(siluf_(a0[0]) * b0[0], siluf_(a0[1]) * b0[1]); w.y = pk2(siluf_(a0[2]) * b0[2], siluf_(a0[3]) * b0[3]);
                    w.z = pk2(siluf_(a1[0]) * b1[0], siluf_(a1[1]) * b1[1]); w.w = pk2(siluf_(a1[2]) * b1[2], siluf_(a1[3]) * b1[3]);
                    *(u32x4*)rowp = w;
                }
        } else {
            const int col0 = u.pn * BM + wc * 32 + 8 * fq;
            const int jt = u.pm % 9;
            float sc = 1.f; bool rope = false; int act0 = 0, act1 = 0;
            if (mode == EPI_QKV_DA) { if (u.pn < 4) sc = QSCALE; if (u.pn < 8 && jt != 0) rope = true; }
            else if (mode == EPI_QKV_NA) { if (u.pn < 4) sc = QSCALE; }
            else if (mode == EPI_RWKV) { if (u.pn == 12) act0 = 1; if (u.pn == 13) { act0 = 2; act1 = 2; } }
#pragma unroll
            for (int ai = 0; ai < 2; ++ai)
#pragma unroll
                for (int m = 0; m < 4; ++m) {
                    bf16_t* rowp = O + (size_t)(row0 + ai * HALF + m * 16) * ldc + col0;
                    f32x4 c0 = {1.f, 1.f, 1.f, 1.f}, c1 = c0, s0 = {0.f, 0.f, 0.f, 0.f}, s1 = s0;
                    if (rope) {
                        const int t = (jt - 1) * 256 + ai * HALF + wr * 64 + m * 16 + fr;
                        const int pos = (wc & 1) ? (t & 63) : (t >> 6);
                        const float* cp = cosT + pos * 16 + 8 * (fq & 1); const float* sp = sinT + pos * 16 + 8 * (fq & 1);
                        c0 = *(const f32x4*)cp; c1 = *(const f32x4*)(cp + 4); s0 = *(const f32x4*)sp; s1 = *(const f32x4*)(sp + 4);
                        if (!(fq & 2)) { s0 = -s0; s1 = -s1; }
                    }
#pragma unroll
                    for (int bj = 0; bj < 2; ++bj) {
                        f32x4 v0 = acc[ai][bj][m][0], v1 = acc[ai][bj][m][1];
                        if (rope) {
                            f32x4 p0, p1;
#pragma unroll
                            for (int e = 0; e < 4; ++e) { p0[e] = __shfl_xor(v0[e], 32); p1[e] = __shfl_xor(v1[e], 32); }
                            v0 = v0 * c0 + p0 * s0; v1 = v1 * c1 + p1 * s1;
                        }
                        v0 = v0 * sc; v1 = v1 * sc;
                        const int act = bj ? act1 : act0;
                        if (act == 1) {
#pragma unroll
                            for (int e = 0; e < 4; ++e) { v0[e] = tanhf_(v0[e]); v1[e] = tanhf_(v1[e]); }
                        } else if (act == 2) {
#pragma unroll
                            for (int e = 0; e < 4; ++e) { v0[e] = sigmoidf_(v0[e]); v1[e] = sigmoidf_(v1[e]); }
                        }
                        u32x4 w; w.x = pk2(v0[0], v0[1]); w.y = pk2(v0[2], v0[3]); w.z = pk2(v1[0], v1[1]); w.w = pk2(v1[2], v1[3]);
                        *(u32x4*)(rowp + bj * HALF) = w;
                    }
                }
        }
    }
};

DI void gemm_phase(LAS unsigned char* lds, const int tid, const Gemm g, const StaticOrder& S, const Epi& E) {
    const int wid = __builtin_amdgcn_readfirstlane(tid >> 6), lane = tid & 63, wr = wid >> 2, wc = wid & 3, fr = lane & 15, fq = lane >> 4;
    const int K = g.K, nt = K / BK;
    unsigned voffA[2], voffB[2];
#pragma unroll
    for (int i = 0; i < 2; ++i) { int R, C; stage_rc(tid * 16 + i * 8192, R, C); const int Rb = (R & ~31) + perm32(R & 31);
        voffA[i] = (unsigned)(R * g.lda + C) * 2u; voffB[i] = (unsigned)(Rb * g.ldb + C) * 2u; }
    const size_t kstep = (size_t)(BK * 2);
    const size_t hstepA = (size_t)HALF * g.lda * 2, hstepB = (size_t)HALF * g.ldb * 2;
    const size_t tstepA = 2 * hstepA, tstepB = 2 * hstepB;
    const unsigned ldsw = (unsigned)wid * 1024u;
    const int aoff = lds_byte(wr * 64 + fr, fq * 8), boff = lds_byte(wc * 32 + fr, fq * 8);
#define PG8_SA(b, h) (((b) * 2 + (h)) * HTB)
#define PG8_SB(b, h) ((4 + (b) * 2 + (h)) * HTB)
#define PG8_STAGE(bufoff, gbase, voff) do { _Pragma("unroll") for (int _i = 0; _i < 2; ++_i) \
        __builtin_amdgcn_global_load_lds((const unsigned*)((const char*)(gbase) + (voff)[_i]), (LAS unsigned*)(lds + (bufoff) + ldsw + _i * 8192), 16, 0, 0); } while (0)
#define PG8_LDA(dst, b, h) do { _Pragma("unroll") for (int m = 0; m < 4; ++m) _Pragma("unroll") for (int k = 0; k < 2; ++k) dst[m][k] = *(const LAS bf16x8*)(lds + PG8_SA(b, h) + aoff + m * 2048 + k * 1024); } while (0)
#define PG8_LDB(dst, b, h) do { _Pragma("unroll") for (int n = 0; n < 2; ++n) _Pragma("unroll") for (int k = 0; k < 2; ++k) dst[n][k] = *(const LAS bf16x8*)(lds + PG8_SB(b, h) + boff + n * 2048 + k * 1024); } while (0)
#define PG8_MMA(ai, bj, At, Bt) do { __builtin_amdgcn_s_setprio(1); _Pragma("unroll") for (int m = 0; m < 4; ++m) _Pragma("unroll") for (int n = 0; n < 2; ++n) _Pragma("unroll") for (int k = 0; k < 2; ++k) \
        acc[ai][bj][m][n] = __builtin_amdgcn_mfma_f32_16x16x32_bf16(Bt[n][k], At[m][k], acc[ai][bj][m][n], 0, 0, 0); __builtin_amdgcn_s_setprio(0); } while (0)
#define PG8_WAIT_V(n) asm volatile("s_waitcnt vmcnt(" #n ")" ::: "memory")
#define PG8_WAIT_L(n) asm volatile("s_waitcnt lgkmcnt(" #n ")" ::: "memory")
#define PG8_BAR __builtin_amdgcn_s_barrier()
#define PG8_SCHED __builtin_amdgcn_sched_barrier(0)
    Unit cur, nxt; int ui = 0;
    if (!S.next(0, cur)) return;
    f32x4 acc[2][2][4][2];
#pragma unroll
    for (int a = 0; a < 2; ++a)
#pragma unroll
        for (int b = 0; b < 2; ++b)
#pragma unroll
            for (int m = 0; m < 4; ++m)
#pragma unroll
                for (int n = 0; n < 2; ++n) acc[a][b][m][n] = (f32x4){0.f, 0.f, 0.f, 0.f};
    bf16x8 At[4][2], B0[2][2], B1[2][2];
    const char* cA = (const char*)g.A + (size_t)cur.pm * tstepA; const char* cB = (const char*)g.Bt + (size_t)cur.pn * tstepB;
    PG8_STAGE(PG8_SB(0, 0), cB, voffB); PG8_STAGE(PG8_SB(0, 1), cB + hstepB, voffB); PG8_STAGE(PG8_SA(0, 0), cA, voffA); PG8_STAGE(PG8_SA(0, 1), cA + hstepA, voffA);
    if (wr == 1) PG8_BAR;
    PG8_WAIT_V(2); PG8_BAR;
    PG8_STAGE(PG8_SB(1, 0), cB + kstep, voffB); PG8_STAGE(PG8_SA(1, 0), cA + kstep, voffA); PG8_STAGE(PG8_SB(1, 1), cB + hstepB + kstep, voffB);
    PG8_WAIT_V(6); PG8_BAR;
    for (;;) {
        const bool has_next = S.next(ui + 1, nxt);
        const char* nA = has_next ? (const char*)g.A + (size_t)nxt.pm * tstepA : cA; const char* nB = has_next ? (const char*)g.Bt + (size_t)nxt.pn * tstepB : cB;
        for (int t = 0; t < nt; t += 2) {
            const bool last = (t == nt - 2);
            const char* a1 = cA + (size_t)(t + 1) * kstep;
            const char* a2 = last ? nA : cA + (size_t)(t + 2) * kstep; const char* b2 = last ? nB : cB + (size_t)(t + 2) * kstep;
            const char* a3 = a2 + kstep; const char* b3 = b2 + kstep;
            PG8_LDB(B0, 0, 0); PG8_LDB(B1, 0, 1); PG8_SCHED; PG8_LDA(At, 0, 0); PG8_STAGE(PG8_SA(1, 1), a1 + hstepA, voffA);
            PG8_WAIT_V(8); PG8_WAIT_L(0); PG8_BAR; PG8_MMA(0, 0, At, B0); PG8_MMA(0, 1, At, B1); PG8_BAR; PG8_SCHED;
            PG8_LDA(At, 0, 1); PG8_STAGE(PG8_SB(0, 0), b2, voffB); PG8_STAGE(PG8_SB(0, 1), b2 + hstepB, voffB); PG8_STAGE(PG8_SA(0, 0), a2, voffA);
            PG8_WAIT_V(8); PG8_WAIT_L(0); PG8_BAR; PG8_MMA(1, 0, At, B0); PG8_MMA(1, 1, At, B1); PG8_BAR; PG8_SCHED;
            PG8_LDB(B0, 1, 0); PG8_LDB(B1, 1, 1); PG8_SCHED; PG8_LDA(At, 1, 0); PG8_STAGE(PG8_SA(0, 1), a2 + hstepA, voffA);
            PG8_WAIT_V(8); PG8_WAIT_L(0); PG8_BAR; PG8_MMA(0, 0, At, B0); PG8_MMA(0, 1, At, B1); PG8_BAR; PG8_SCHED;
            PG8_LDA(At, 1, 1); PG8_STAGE(PG8_SB(1, 0), b3, voffB); PG8_STAGE(PG8_SB(1, 1), b3 + hstepB, voffB); PG8_STAGE(PG8_SA(1, 0), a3, voffA);
            PG8_WAIT_V(8); PG8_WAIT_L(0); PG8_BAR; PG8_MMA(1, 0, At, B0); PG8_MMA(1, 1, At, B1); PG8_BAR; PG8_SCHED;
        }
        if (wr == 0) PG8_BAR;
        E(acc, cur, wr, wc, fr, fq);
        if (!has_next) break;
#pragma unroll
        for (int a = 0; a < 2; ++a)
#pragma unroll
            for (int b = 0; b < 2; ++b)
#pragma unroll
                for (int m = 0; m < 4; ++m)
#pragma unroll
                    for (int n = 0; n < 2; ++n) acc[a][b][m][n] = (f32x4){0.f, 0.f, 0.f, 0.f};
        cur = nxt; cA = nA; cB = nB; ++ui;
        if (wr == 1) PG8_BAR;
    }
    PG8_WAIT_V(0);
    PG8_BAR;
#undef PG8_SA
#undef PG8_SB
#undef PG8_STAGE
#undef PG8_LDA
#undef PG8_LDB
#undef PG8_MMA
#undef PG8_WAIT_V
#undef PG8_WAIT_L
#undef PG8_BAR
#undef PG8_SCHED
}
}

struct Args { const float* in[32]; float* out; unsigned char* ws; };

struct Frame {
    LAS unsigned char* lds;
    int tid, lane, wave, vcu, G, gw, NGW, bx;
    const float* const* in;
};
enum { I_X = 0, I_C, I_CTX, I_CCTX, I_ADAW, I_ADAB, I_NORMG, I_FWIN, I_FWOUT, I_DAWIN, I_DAWOUT, I_DALAM, I_DASUB, I_NAWIN, I_NAWOUT, I_NARPB,
       I_RWMU, I_RWWIN, I_RWWOUT, I_RWW0, I_RWW1, I_RWW2, I_RWA0, I_RWA1, I_RWA2, I_RWG1, I_RWG2, I_RWKK, I_RWKA, I_RWRK, I_RWLNG, I_RWLNB };

DI void conv_item(const float* W, int ldw, int k0, int n0, int kmax, const float* mu, bf16_t* dst, int ldd, int dst_row0, int dst_k0, LAS float* scr, int lane) {
    float cv[32];
#pragma unroll
    for (int i = 0; i < 32; ++i) { const int k = k0 + 2 * i + (lane >> 5); cv[i] = (k < kmax) ? W[(size_t)k * ldw + n0 + (lane & 31)] : 0.f; }
    if (mu) {
#pragma unroll
        for (int i = 0; i < 32; ++i) { const int k = k0 + 2 * i + (lane >> 5); cv[i] *= (k < kmax) ? mu[k] : 0.f; }
    }
#pragma unroll
    for (int i = 0; i < 32; ++i) scr[(2 * i + (lane >> 5)) * 33 + (lane & 31)] = cv[i];
    asm volatile("s_waitcnt lgkmcnt(0)" ::: "memory");
    const int c = lane & 7;
#pragma unroll
    for (int j = 0; j < 4; ++j) { const int n = (lane >> 3) + 8 * j; const LAS float* s = scr + (8 * c) * 33 + n;
        u32x4 o; o.x = pk2(s[0 * 33], s[1 * 33]); o.y = pk2(s[2 * 33], s[3 * 33]); o.z = pk2(s[4 * 33], s[5 * 33]); o.w = pk2(s[6 * 33], s[7 * 33]);
        *(u32x4*)(dst + (size_t)(dst_row0 + n) * ldd + dst_k0 + k0 + 8 * c) = o; }
    asm volatile("s_waitcnt lgkmcnt(0)" ::: "memory");
}

DI void convert_layer(Frame& F, unsigned char* ws, int l) {
    bf16_t* WB = (bf16_t*)(ws + WS_WB);
    LAS float* scr = (LAS float*)(F.lds + F.wave * 16384);
    const int kind = l % 3, slot = l / 3;
    constexpr int I_FIN = 16 * 176, I_FOUT = 44 * 32, I_MIN = 16 * 96, I_MOUT = 16 * 32;
    const float* fwin = F.in[I_FWIN] + (size_t)l * 2 * 1024 * 5632;
    const float* fwout = F.in[I_FWOUT] + (size_t)l * 2 * 2816 * 1024;
    int nitems = 2 * I_FIN + 2 * I_FOUT + I_MOUT;
    if (kind == 2) nitems += 2 * I_MIN + 4 * 16 * 2 * 2 + 16 * 5 * 2 + 4 * 32 + 96;
    else nitems += I_MIN;
    for (int it = F.gw; it < nitems; it += F.NGW) {
        int r = it;
        if (r < 2 * I_FIN) { const int s = r / I_FIN; r -= s * I_FIN; const int kb = r / 176, nb = r % 176, n0 = nb * 32;
            const int hf = n0 / 2816, rem = n0 % 2816, p = rem / 128, i = rem % 128;
            conv_item(fwin + (size_t)s * 1024 * 5632, 5632, kb * 64, n0, 1024, nullptr, WB + (s ? WB_IN1 : WB_IN0), 1024, p * 256 + hf * 128 + i, 0, scr, F.lane); continue; }
        r -= 2 * I_FIN;
        if (r < 2 * I_FOUT) { const int s = r / I_FOUT; r -= s * I_FOUT; const int kb = r / 32, nb = r % 32;
            conv_item(fwout + (size_t)s * 2816 * 1024, 1024, kb * 64, nb * 32, 2816, nullptr, WB + (s ? WB_OUT1 : WB_OUT0), 2816, nb * 32, 0, scr, F.lane); continue; }
        r -= 2 * I_FOUT;
        if (r < I_MOUT) { const float* w = kind == 0 ? F.in[I_DAWOUT] + (size_t)slot * 1024 * 1024 : kind == 1 ? F.in[I_NAWOUT] : F.in[I_RWWOUT];
            const int kb = r / 32, nb = r % 32;
            conv_item(w, 1024, kb * 64, nb * 32, 1024, nullptr, WB + WB_MIXOUT, 1024, nb * 32, 0, scr, F.lane); continue; }
        r -= I_MOUT;
        if (kind != 2) { const float* w = kind == 0 ? F.in[I_DAWIN] + (size_t)slot * 1024 * 3072 : F.in[I_NAWIN];
            const int kb = r / 96, nb = r % 96;
            conv_item(w, 3072, kb * 64, nb * 32, 1024, nullptr, WB + WB_MIXIN, 1024, nb * 32, 0, scr, F.lane); continue; }
        const float* mu = F.in[I_RWMU];
        if (r < 2 * I_MIN) { const int var = r / I_MIN; r -= var * I_MIN; const int kb = r / 96, nb = r % 96, n0 = nb * 32;
            const int mj = n0 < 1024 ? 0 : (n0 < 2048 ? 2 : 3);
            conv_item(F.in[I_RWWIN], 3072, kb * 64, n0, 1024, var ? mu + mj * 1024 : nullptr, WB + WB_MIXIN, 2048, n0, var * 1024, scr, F.lane); continue; }
        r -= 2 * I_MIN;
        if (r < 4 * 16 * 2 * 2) { const int var = r & 1; r >>= 1; const int nb = r & 1; r >>= 1; const int kb = r & 15; r >>= 4; const int dir = r & 1, isa = r >> 1;
            const float* w = (isa ? F.in[I_RWA1] : F.in[I_RWW1]) + (size_t)dir * 1024 * 64;
            conv_item(w, 64, kb * 64, nb * 32, 1024, var ? mu + (isa ? 4 : 1) * 1024 : nullptr, WB + WB_MIXIN, 2048, (isa ? 3200 : 3072) + dir * 64 + nb * 32, var * 1024, scr, F.lane); continue; }
        r -= 4 * 16 * 2 * 2;
        if (r < 16 * 5 * 2) { const int var = r & 1; r >>= 1; const int nb = r % 5, kb = r / 5;
            conv_item(F.in[I_RWG1], 160, kb * 64, nb * 32, 1024, var ? mu + 5 * 1024 : nullptr, WB + WB_MIXIN, 2048, 3328 + nb * 32, var * 1024, scr, F.lane); continue; }
        r -= 16 * 5 * 2;
        if (r < 4 * 32) { const int kb = r / 32, nb = r % 32;
            conv_item(F.in[I_RWG2], 1024, kb * 64, nb * 32, 160, nullptr, WB + WB_G2T, 256, nb * 32, 0, scr, F.lane); continue; }
        r -= 4 * 32;
        { bf16_t* z = WB + WB_MIXIN + (size_t)(3488 + r) * 2048;
#pragma unroll
          for (int j = 0; j < 4; ++j) *(u32x4*)(z + (j * 64 + F.lane) * 8) = (u32x4){0u, 0u, 0u, 0u}; }
    }
}

DI void phase0(Frame& F, unsigned char* ws) {
    LAS float* sl = (LAS float*)F.lds;
    LAS float* part = (LAS float*)(F.lds + 69632);
    float* MOD = (float*)(ws + WS_MOD);
    for (int i = F.tid; i < 17 * 1024; i += 512) { const float v = i < 16384 ? F.in[I_C][i] : F.in[I_CCTX][i - 16384]; sl[i] = v / (1.f + expf(-v)); }
    __syncthreads();
    for (int item = F.vcu; item < 4 * 72; item += F.G) {
        const int l = item / 72, n0 = (item % 72) * 128;
        const float* W = F.in[I_ADAW] + (size_t)l * 1024 * NMOD + n0 + 2 * F.lane;
        float acc[17][2];
#pragma unroll
        for (int r = 0; r < 17; ++r) { acc[r][0] = 0.f; acc[r][1] = 0.f; }
        const int kbase = F.wave * 128;
        f32x2 wn[16];
#pragma unroll
        for (int e = 0; e < 16; ++e) wn[e] = *(const f32x2*)(W + (size_t)(kbase + e) * NMOD);
        for (int k16 = 0; k16 < 128; k16 += 16) {
            f32x2 w[16];
#pragma unroll
            for (int e = 0; e < 16; ++e) w[e] = wn[e];
            if (k16 + 16 < 128) {
#pragma unroll
                for (int e = 0; e < 16; ++e) wn[e] = *(const f32x2*)(W + (size_t)(kbase + k16 + 16 + e) * NMOD);
            }
#pragma unroll
            for (int q = 0; q < 4; ++q)
#pragma unroll
                for (int r = 0; r < 17; ++r) { const f32x4 s = *(const LAS f32x4*)(sl + r * 1024 + kbase + k16 + 4 * q);
#pragma unroll
                    for (int e = 0; e < 4; ++e) { acc[r][0] += s[e] * w[4 * q + e].x; acc[r][1] += s[e] * w[4 * q + e].y; } }
        }
#pragma unroll
        for (int r = 0; r < 17; ++r) *(LAS f32x2*)(part + (F.wave * 17 + r) * 128 + 2 * F.lane) = (f32x2){acc[r][0], acc[r][1]};
        __syncthreads();
        for (int idx = F.tid; idx < 17 * 128; idx += 512) { const int r = idx >> 7, cI = idx & 127; float s = 0.f;
#pragma unroll
            for (int w = 0; w < 8; ++w) s += part[(w * 17 + r) * 128 + cI];
            MOD[((size_t)l * 17 + r) * NMOD + n0 + cI] = s + F.in[I_ADAB][(size_t)l * NMOD + n0 + cI]; }
        __syncthreads();
    }
    if (F.bx == 0) {
        for (int i = F.tid; i < 3456; i += 512) ((unsigned*)(ws + WS_BAR))[i] = 0u;
        float* cosT = (float*)(ws + WS_ROPE); float* sinT = cosT + 1024;
        for (int i = F.tid; i < 1024; i += 512) { const int pos = i >> 4, p = i & 15; const float fr = powf(10000.f, -(float)p / 16.f); const float ang = (float)pos * fr; cosT[i] = cosf(ang); sinT[i] = sinf(ang); }
        if (F.tid < 2) { const float* lv = F.in[I_DALAM] + F.tid * 256; float d0 = 0.f, d1 = 0.f;
            for (int i = 0; i < 64; ++i) { d0 += lv[i] * lv[64 + i]; d1 += lv[128 + i] * lv[192 + i]; }
            const float li = 0.8f - 0.6f * expf(-0.3f * (float)(F.tid * 3));
            float* lam = (float*)(ws + WS_LAM); lam[2 * F.tid] = expf(d0) - expf(d1) + li; lam[2 * F.tid + 1] = li; }
    }
    __syncthreads();
    convert_layer(F, ws, 0);
}

struct RowPass {
    const float* hsrc_lat; const float* hsrc_ctx; float* hdst_lat; float* hdst_ctx;
    const bf16_t* Y;
    const float* gpost; int gate_idx; float coef; int lpost;
    const float* gpre; int shift_idx; int lpre;
    bf16_t* U; int ldu; int skip_ctx;
};
DI void row_pass(Frame& F, unsigned char* ws, const RowPass& P, int row_lo, int row_hi, int widx, int nw) {
    const float* MOD = (const float*)(ws + WS_MOD);
    const int rpw = (row_hi - row_lo + nw - 1) / nw;
    const int rbeg = row_lo + widx * rpw, rend = min(rbeg + rpw, row_hi);
    if (rbeg >= rend) return;
    const int l4 = 4 * F.lane;
    f32x4 gpo[4], gpr[4], gat[4], shf[4], scl[4];
#pragma unroll
    for (int j = 0; j < 4; ++j) { gpo[j] = *(const f32x4*)(P.gpost + l4 + 256 * j); gpr[j] = P.gpre ? *(const f32x4*)(P.gpre + l4 + 256 * j) : (f32x4){0.f, 0.f, 0.f, 0.f}; }
    int cur_mrow = -1;
    f32x4 hn[4]; u32x2 yn[4];
#define RP_ADDR(row, isctx, hoff) const int _b = (row) / LROW, _t = (row) % LROW; const bool isctx = _t < CTX; \
        const size_t hoff = isctx ? ((size_t)_b * CTX + _t) * DM : ((size_t)_b * SEQ + (_t - CTX)) * DM;
#define RP_LOAD(row) do { RP_ADDR(row, ic_, ho_) if (!(ic_ && P.skip_ctx)) { const float* hs_ = (ic_ ? P.hsrc_ctx : P.hsrc_lat) + ho_ + l4; \
        _Pragma("unroll") for (int j = 0; j < 4; ++j) hn[j] = __builtin_nontemporal_load((const f32x4*)(hs_ + 256 * j)); \
        if (P.Y) { const bf16_t* yr_ = P.Y + (size_t)(row) * DM + l4; _Pragma("unroll") for (int j = 0; j < 4; ++j) yn[j] = __builtin_nontemporal_load((const u32x2*)(yr_ + 256 * j)); } } } while (0)
    RP_LOAD(rbeg);
    for (int row = rbeg; row < rend; ++row) {
        f32x4 h[4]; u32x2 yv[4];
#pragma unroll
        for (int j = 0; j < 4; ++j) { h[j] = hn[j]; yv[j] = yn[j]; }
        if (row + 1 < rend) RP_LOAD(row + 1);
        RP_ADDR(row, isctx, hoff)
        if (isctx && P.skip_ctx) continue;
        float* hd = (isctx ? P.hdst_ctx : P.hdst_lat) + hoff + l4;
        const bool copy_h = ((isctx ? P.hsrc_ctx : P.hsrc_lat) != (isctx ? P.hdst_ctx : P.hdst_lat));
        const int mrow = isctx ? 16 : _b;
        if (mrow != cur_mrow) { cur_mrow = mrow;
            const float* gate = MOD + ((size_t)P.lpost * 17 + mrow) * NMOD + P.gate_idx * DM + l4;
            const float* sh = MOD + ((size_t)P.lpre * 17 + mrow) * NMOD + P.shift_idx * DM + l4;
#pragma unroll
            for (int j = 0; j < 4; ++j) { gat[j] = *(const f32x4*)(gate + 256 * j) * P.coef; shf[j] = *(const f32x4*)(sh + 256 * j); scl[j] = *(const f32x4*)(sh + DM + 256 * j) + 1.f; } }
        if (P.Y) {
            f32x4 y[4]; float ss = 0.f;
#pragma unroll
            for (int j = 0; j < 4; ++j) { y[j] = (f32x4){bflo(yv[j].x), bfhi(yv[j].x), bflo(yv[j].y), bfhi(yv[j].y)};
                ss += (y[j].x * y[j].x + y[j].y * y[j].y) + (y[j].z * y[j].z + y[j].w * y[j].w); }
            const float rstd = 1.f / sqrtf(wave_sum(ss) * (1.f / DM) + NORM_EPS);
#pragma unroll
            for (int j = 0; j < 4; ++j) h[j] = h[j] + gat[j] * ((y[j] * rstd) * gpo[j]);
        }
        if (P.Y || copy_h) {
#pragma unroll
            for (int j = 0; j < 4; ++j) __builtin_nontemporal_store(h[j], (f32x4*)(hd + 256 * j));
        }
        if (P.gpre) {
            float ss = 0.f;
#pragma unroll
            for (int j = 0; j < 4; ++j) ss += (h[j].x * h[j].x + h[j].y * h[j].y) + (h[j].z * h[j].z + h[j].w * h[j].w);
            const float rstd = 1.f / sqrtf(wave_sum(ss) * (1.f / DM) + NORM_EPS);
            bf16_t* ur = P.U + (size_t)row * P.ldu + l4;
#pragma unroll
            for (int j = 0; j < 4; ++j) { const f32x4 u = ((h[j] * rstd) * gpr[j]) * scl[j] + shf[j];
                *(u32x2*)(ur + 256 * j) = (u32x2){pk2(u.x, u.y), pk2(u.z, u.w)}; }
        }
    }
#undef RP_ADDR
#undef RP_LOAD
}

DI void xx_pass(Frame& F, unsigned char* ws) {
    bf16_t* U = (bf16_t*)(ws + WS_U);
    u32x4 nc[2], np[2], nn[2];
#define XX_LOAD(row_) do { const int t_ = (row_) % LROW; const bool fi_ = (t_ == 0) || (t_ == CTX), la_ = (t_ == CTX - 1) || (t_ == LROW - 1); \
        const bf16_t* ur_ = U + (size_t)(row_) * 2048 + 8 * F.lane; \
        _Pragma("unroll") for (int j = 0; j < 2; ++j) { nc[j] = *(const u32x4*)(ur_ + 512 * j); np[j] = (u32x4){0u, 0u, 0u, 0u}; nn[j] = np[j]; \
            if (!fi_) np[j] = *(const u32x4*)(ur_ - 2048 + 512 * j); if (!la_) nn[j] = *(const u32x4*)(ur_ + 2048 + 512 * j); } } while (0)
    if (F.gw < MROWS) XX_LOAD(F.gw);
    for (int row = F.gw; row < MROWS; row += F.NGW) {
        u32x4 c[2], p[2], n[2];
#pragma unroll
        for (int j = 0; j < 2; ++j) { c[j] = nc[j]; p[j] = np[j]; n[j] = nn[j]; }
        if (row + F.NGW < MROWS) XX_LOAD(row + F.NGW);
        bf16_t* ur = U + (size_t)row * 2048 + 8 * F.lane;
#pragma unroll
        for (int j = 0; j < 2; ++j) {
            u32x4 o;
#pragma unroll
            for (int e = 0; e < 4; ++e) { const float lo = 0.5f * (bflo(p[j][e]) + bflo(n[j][e])) - bflo(c[j][e]); const float hi = 0.5f * (bfhi(p[j][e]) + bfhi(n[j][e])) - bfhi(c[j][e]); o[e] = pk2(lo, hi); }
            *(u32x4*)(ur + 1024 + 512 * j) = o;
        }
    }
#undef XX_LOAD
}

DI f32x16 mfma32(bf16x8 a, bf16x8 b, f32x16 c) { return __builtin_amdgcn_mfma_f32_32x32x16_bf16(a, b, c, 0, 0, 0); }
DI bf16x8 pack8(const f32x16& x, int s) { u32x4 p; p.x = pk2(x[8 * s], x[8 * s + 1]); p.y = pk2(x[8 * s + 2], x[8 * s + 3]); p.z = pk2(x[8 * s + 4], x[8 * s + 5]); p.w = pk2(x[8 * s + 6], x[8 * s + 7]); return __builtin_bit_cast(bf16x8, p); }
typedef short v4i16_t __attribute__((ext_vector_type(4)));
DI s16x4 vtr(LAS const unsigned char* p) { return __builtin_bit_cast(s16x4, __builtin_amdgcn_ds_read_tr16_b64_v4i16((LAS v4i16_t*)p)); }
DI float max3f(float a, float b, float c) { return __builtin_fmaxf(__builtin_fmaxf(a, b), c); }
DI float max16(const f32x16& p) { float a = max3f(p[0], p[1], p[2]), b = max3f(p[3], p[4], p[5]);
    a = max3f(a, p[6], p[7]); b = max3f(b, p[8], p[9]); a = max3f(a, p[10], p[11]); b = max3f(b, p[12], p[13]); a = max3f(a, p[14], p[15]); return __builtin_fmaxf(a, b); }

template <int NDB>
DI void softmax_pv(f32x16& p0, f32x16& p1, f32x16 (&o)[NDB], f32x16& negm, float& m_run, float& l_run, const bool first, LAS float* wsf, LAS const unsigned char* Vb, int KP, int r, int hh, int lane) {
    const int i16 = lane & 15, q4 = i16 >> 2, p4 = i16 & 3, g1 = (lane >> 4) & 1;
    LAS const unsigned char* vl = Vb + (4 * hh + q4) * 64 + 32 * g1 + 8 * p4;
    s16x4 flo[2][NDB], fhi[2][NDB];
#pragma unroll
    for (int d = 0; d < NDB; ++d) { flo[0][d] = vtr(vl + d * 4096); fhi[0][d] = vtr(vl + 8 * 64 + d * 4096); }
    __builtin_amdgcn_sched_barrier(0);
    float mx = __builtin_fmaxf(max16(p0), max16(p1)); mx = __builtin_fmaxf(mx, __shfl_xor(mx, 32));
    if (first || __any(mx > 8.f)) {
        const float delta = first ? mx : __builtin_fmaxf(mx, 0.f);
        m_run += delta;
#pragma unroll
        for (int i = 0; i < 16; ++i) { p0[i] -= delta; p1[i] -= delta; negm[i] = -m_run; }
        if (!first) {
            const float alpha = __builtin_amdgcn_exp2f(-delta);
            l_run *= alpha;
            if (hh == 0) wsf[r] = alpha;
#pragma unroll
            for (int g4 = 0; g4 < 4; ++g4) { const f32x4 a4 = *(const LAS f32x4*)(wsf + 8 * g4 + 4 * hh);
#pragma unroll
                for (int d = 0; d < NDB; ++d)
#pragma unroll
                    for (int e = 0; e < 4; ++e) o[d][4 * g4 + e] *= a4[e]; }
        }
    }
    f32x2 ls2 = {0.f, 0.f};
#pragma unroll
    for (int i = 0; i < 16; i += 2) {
        p0[i] = __builtin_amdgcn_exp2f(p0[i]); p0[i + 1] = __builtin_amdgcn_exp2f(p0[i + 1]); p1[i] = __builtin_amdgcn_exp2f(p1[i]); p1[i + 1] = __builtin_amdgcn_exp2f(p1[i + 1]);
        ls2 += (f32x2){p0[i], p0[i + 1]}; ls2 += (f32x2){p1[i], p1[i + 1]};
    }
    l_run += ls2.x + ls2.y;
    const bf16x8 pa[4] = {pack8(p0, 0), pack8(p0, 1), pack8(p1, 0), pack8(p1, 1)};
#pragma unroll
    for (int k = 0; k < 4; ++k) {
        if (k + 1 < 4) {
            LAS const unsigned char* vk = vl + 16 * (k + 1) * 64;
#pragma unroll
            for (int d = 0; d < NDB; ++d) { flo[(k + 1) & 1][d] = vtr(vk + d * 4096); fhi[(k + 1) & 1][d] = vtr(vk + 8 * 64 + d * 4096); }
        }
        __builtin_amdgcn_sched_barrier(0);
#pragma unroll
        for (int d = 0; d < NDB; ++d) { const bf16x8 vb = __builtin_shufflevector(flo[k & 1][d], fhi[k & 1][d], 0, 1, 2, 3, 4, 5, 6, 7); o[d] = mfma32(pa[k], vb, o[d]); }
        __builtin_amdgcn_sched_barrier(0);
    }
}

DI void da_pv_plain(const bf16x8 (&pa)[4], f32x16 (&o)[4], LAS const unsigned char* Vb, int hh, int lane) {
    const int i16 = lane & 15, q4 = i16 >> 2, p4 = i16 & 3, g1 = (lane >> 4) & 1;
    LAS const unsigned char* vl = Vb + (4 * hh + q4) * 64 + 32 * g1 + 8 * p4;
#pragma unroll
    for (int k = 0; k < 4; ++k) {
        s16x4 lo[4], hi[4];
#pragma unroll
        for (int d = 0; d < 4; ++d) { lo[d] = vtr(vl + 16 * k * 64 + d * 4096); hi[d] = vtr(vl + 16 * k * 64 + 8 * 64 + d * 4096); }
#pragma unroll
        for (int d = 0; d < 4; ++d) { const bf16x8 vb = __builtin_shufflevector(lo[d], hi[d], 0, 1, 2, 3, 4, 5, 6, 7); o[d] = mfma32(pa[k], vb, o[d]); }
    }
}
DI void da_step(f32x16& p0, f32x16& p1, f32x16 (&o)[4], float& m_run, float& l_run, bf16x8 (&pa)[4], const bool first, LAS float* wsf, LAS const unsigned char* Vprev, int r, int hh, int lane) {
    float mx = __builtin_fmaxf(max16(p0), max16(p1)); mx = __builtin_fmaxf(mx, __shfl_xor(mx, 32));
    const bool need = first || __any(mx > 8.f);
    float delta = 0.f;
    if (need) { delta = first ? mx : __builtin_fmaxf(mx, 0.f); m_run += delta;
#pragma unroll
        for (int i = 0; i < 16; ++i) { p0[i] -= delta; p1[i] -= delta; } }
    const int i16 = lane & 15, q4 = i16 >> 2, p4 = i16 & 3, g1 = (lane >> 4) & 1;
    LAS const unsigned char* vl = Vprev + (4 * hh + q4) * 64 + 32 * g1 + 8 * p4;
    s16x4 flo[2][4], fhi[2][4];
#pragma unroll
    for (int d = 0; d < 4; ++d) { flo[0][d] = vtr(vl + d * 4096); fhi[0][d] = vtr(vl + 8 * 64 + d * 4096); }
    u32x4 pn[4]; f32x2 ls2 = {0.f, 0.f};
#pragma unroll
    for (int k = 0; k < 4; ++k) {
#pragma unroll
        for (int d = 0; d < 4; ++d) {
            __builtin_amdgcn_sched_barrier(0);
            { const bf16x8 vb = __builtin_shufflevector(flo[k & 1][d], fhi[k & 1][d], 0, 1, 2, 3, 4, 5, 6, 7); o[d] = mfma32(pa[k], vb, o[d]); }
            if (k + 1 < 4) { flo[(k + 1) & 1][d] = vtr(vl + 16 * (k + 1) * 64 + d * 4096); fhi[(k + 1) & 1][d] = vtr(vl + 16 * (k + 1) * 64 + 8 * 64 + d * 4096); }
            const int i = 8 * (k & 1) + 2 * d;
            if (k < 2) { p0[i] = __builtin_amdgcn_exp2f(p0[i]); p0[i + 1] = __builtin_amdgcn_exp2f(p0[i + 1]); ls2 += (f32x2){p0[i], p0[i + 1]}; pn[k][d] = pk2(p0[i], p0[i + 1]); }
            else       { p1[i] = __builtin_amdgcn_exp2f(p1[i]); p1[i + 1] = __builtin_amdgcn_exp2f(p1[i + 1]); ls2 += (f32x2){p1[i], p1[i + 1]}; pn[k][d] = pk2(p1[i], p1[i + 1]); }
        }
    }
    __builtin_amdgcn_sched_barrier(0);
#pragma unroll
    for (int k = 0; k < 4; ++k) pa[k] = __builtin_bit_cast(bf16x8, pn[k]);
    if (need && !first) {
        const float alpha = __builtin_amdgcn_exp2f(-delta);
        l_run *= alpha;
        if (hh == 0) wsf[r] = alpha;
#pragma unroll
        for (int g4 = 0; g4 < 4; ++g4) { const f32x4 a4 = *(const LAS f32x4*)(wsf + 8 * g4 + 4 * hh);
#pragma unroll
            for (int d = 0; d < 4; ++d)
#pragma unroll
                for (int e = 0; e < 4; ++e) o[d][4 * g4 + e] *= a4[e]; }
    }
    l_run += ls2.x + ls2.y;
}

DI void da_unit(LAS unsigned char* lds, const int tid, const bf16_t* QKV, bf16_t* O, int q_row0, int kv_row0, int NT, int h, float lam, float one_m_li, const float* subg) {
    const int lane = tid & 63, wid = __builtin_amdgcn_readfirstlane(tid >> 6), r = lane & 31, hh = lane >> 5;
    const int qg = wid >> 1, j = wid & 1;
    constexpr int KP = 272, STG = 2 * 64 * KP;
    LAS float* wsf = (LAS float*)(lds + 3 * STG) + wid * 64;
    const bf16_t* gbase = QKV + (size_t)(kv_row0 + (tid >> 4)) * 3072 + 1024 + h * 128 + (tid & 15) * 8;
    const int lbase = (tid >> 4) * KP + (tid & 15) * 16;
    const int vbase = 64 * KP + ((tid & 15) >> 2) * 4096 + (tid >> 4) * 64 + (tid & 3) * 16;
    u32x4 st[4];
#define DA_LOAD(t) do { _Pragma("unroll") for (int i = 0; i < 4; ++i) st[i] = *(const u32x4*)(gbase + (size_t)(t) * 64 * 3072 + (size_t)(i & 1) * 32 * 3072 + (i >> 1) * 1024); } while (0)
#define DA_STORE(boff) do { _Pragma("unroll") for (int i = 0; i < 2; ++i) { *(LAS u32x4*)(lds + (boff) + lbase + i * 32 * KP) = st[i]; *(LAS u32x4*)(lds + (boff) + vbase + i * 32 * 64) = st[2 + i]; } } while (0)
    const bf16_t* qp = QKV + (size_t)(q_row0 + 32 * qg + r) * 3072 + h * 128 + j * 64 + 8 * hh;
    bf16x8 qr[4];
#pragma unroll
    for (int d0 = 0; d0 < 4; ++d0) qr[d0] = *(const bf16x8*)(qp + 16 * d0);
    f32x16 o[4];
#pragma unroll
    for (int d = 0; d < 4; ++d)
#pragma unroll
        for (int i = 0; i < 16; ++i) o[d][i] = 0.f;
    float m_run = 0.f, l_run = 0.f;
    bf16x8 pa[4];
#pragma unroll
    for (int k = 0; k < 4; ++k) pa[k] = (bf16x8){0, 0, 0, 0, 0, 0, 0, 0};
    DA_LOAD(0); DA_STORE(0);
    { LAS u32x4* z = (LAS u32x4*)(lds + 2 * STG + 64 * KP) + tid; z[0] = (u32x4){0u, 0u, 0u, 0u}; z[512] = (u32x4){0u, 0u, 0u, 0u}; }
    __syncthreads();
    int b_prv = 2 * STG, b_cur = 0, b_nxt = STG;
    for (int t = 0; t < NT; ++t) {
        if (t + 1 < NT) DA_LOAD(t + 1);
        LAS const unsigned char* Kb = lds + b_cur + j * 128 + r * KP + hh * 16;
        f32x16 p0, p1;
        { const float nm = -m_run;
#pragma unroll
          for (int i = 0; i < 16; ++i) { p0[i] = nm; p1[i] = nm; } }
#pragma unroll
        for (int d0 = 0; d0 < 4; ++d0) { const bf16x8 k0 = *(const LAS bf16x8*)(Kb + d0 * 32), k1 = *(const LAS bf16x8*)(Kb + 32 * KP + d0 * 32);
            p0 = mfma32(k0, qr[d0], p0); p1 = mfma32(k1, qr[d0], p1); }
        da_step(p0, p1, o, m_run, l_run, pa, t == 0, wsf, lds + b_prv + 64 * KP, r, hh, lane);
        if (t + 1 < NT) DA_STORE(b_nxt);
        LDS_BARRIER();
        { const int tmp_ = b_prv; b_prv = b_cur; b_cur = b_nxt; b_nxt = tmp_; }
    }
    da_pv_plain(pa, o, lds + b_prv + 64 * KP, hh, lane);
    LDS_BARRIER();
#undef DA_LOAD
#undef DA_STORE
    const float lt = l_run + __shfl_xor(l_run, 32);
    if (hh == 0) wsf[r] = 1.f / lt;
    float rl[16];
#pragma unroll
    for (int g4 = 0; g4 < 4; ++g4) { const f32x4 a4 = *(const LAS f32x4*)(wsf + 8 * g4 + 4 * hh);
#pragma unroll
        for (int e = 0; e < 4; ++e) rl[4 * g4 + e] = a4[e]; }
    LAS float* R = (LAS float*)lds + qg * 32 * 132;
    if (j == 1) {
#pragma unroll
        for (int d = 0; d < 4; ++d)
#pragma unroll
            for (int i = 0; i < 16; ++i) R[((i & 3) + 8 * (i >> 2) + 4 * hh) * 132 + d * 32 + r] = o[d][i] * rl[i] * lam;
    }
    __syncthreads();
    if (j == 0) {
#pragma unroll
        for (int d = 0; d < 4; ++d)
#pragma unroll
            for (int i = 0; i < 16; ++i) { const int idx = ((i & 3) + 8 * (i >> 2) + 4 * hh) * 132 + d * 32 + r; R[idx] = o[d][i] * rl[i] - R[idx]; }
    }
    __syncthreads();
    {
        const int row = tid >> 2, qtr = tid & 3;
        LAS const float* rp = (LAS const float*)lds + (row >> 5) * 32 * 132 + (row & 31) * 132 + qtr * 32;
        f32x4 v[8]; float ss = 0.f;
#pragma unroll
        for (int c = 0; c < 8; ++c) { v[c] = *(const LAS f32x4*)(rp + 4 * c); ss += (v[c].x * v[c].x + v[c].y * v[c].y) + (v[c].z * v[c].z + v[c].w * v[c].w); }
        ss += __shfl_xor(ss, 1); ss += __shfl_xor(ss, 2);
        const float rs = one_m_li / sqrtf(ss * (1.f / 128.f) + NORM_EPS);
        bf16_t* op = O + (size_t)(q_row0 + row) * DM + h * 128 + qtr * 32;
        const float* gp = subg + qtr * 32;
#pragma unroll
        for (int c = 0; c < 4; ++c) { const f32x4 g0 = *(const f32x4*)(gp + 8 * c), g1 = *(const f32x4*)(gp + 8 * c + 4); const f32x4 a = v[2 * c] * rs * g0, b = v[2 * c + 1] * rs * g1;
            *(u32x4*)(op + 8 * c) = (u32x4){pk2(a.x, a.y), pk2(a.z, a.w), pk2(b.x, b.y), pk2(b.z, b.w)}; }
    }
    __syncthreads();
}

DI void da_phase(Frame& F, unsigned char* ws, int l) {
    const bf16_t* QKV = (const bf16_t*)(ws + WS_ACT); bf16_t* O = (bf16_t*)(ws + WS_U);
    const int slot = l / 3; const bool last = (l == 3);
    const float* lamv = (const float*)(ws + WS_LAM); const float lam = lamv[2 * slot], li = lamv[2 * slot + 1];
    const float* subg = F.in[I_DASUB] + slot * 128;
    const int nunits = 2048 + (last ? 0 : 256);
    for (int u = F.vcu; u < nunits; u += F.G) {
        if (u < 2048) { const int bh = u >> 4, qt = u & 15, b = bh >> 3, h = bh & 7;
            da_unit(F.lds, F.tid, QKV, O, b * LROW + CTX + qt * 128, b * LROW, 36, h, lam, 1.f - li, subg); }
        else { const int v = u - 2048, bh = v >> 1, qt = v & 1, b = bh >> 3, h = bh & 7;
            da_unit(F.lds, F.tid, QKV, O, b * LROW + qt * 128, b * LROW, 4, h, lam, 1.f - li, subg); }
    }
}

DI void na_unit(LAS unsigned char* lds, const int tid, const bf16_t* QKV, bf16_t* O, const float* rpb, int b, int h, int R, int ctxq) {
    const int lane = tid & 63, wid = __builtin_amdgcn_readfirstlane(tid >> 6), r = lane & 31, hh = lane >> 5;
    constexpr int KP = 144, STG = 2 * 64 * KP;
    LAS float* wsf = (LAS float*)(lds + 2 * STG) + wid * 64;
    LAS float* rpbL = (LAS float*)(lds + 2 * STG + 2048) + 48;
    const int rw = 4 * R + (wid >> 1), cq = 32 * (wid & 1) + r;
    const int rs_w = min(max(rw - 4, 0), 24);
    const int rlo = min(max(4 * R - 4, 0), 24), rhi = min(max(4 * R - 1, 0), 24) + 7;
    const int NT = ctxq ? 4 : 4 + (rhi - rlo + 1);
    const int q_row = ctxq ? b * LROW + 32 * wid + r : b * LROW + CTX + R * 256 + 32 * wid + r;
    if (!ctxq) { for (int i = tid; i < 465; i += 512) rpbL[i] = rpb[h * 465 + i] * LOG2E; if (tid < 48) { rpbL[tid - 48] = 0.f; rpbL[465 + tid] = 0.f; } }
    const int srow = tid >> 3, sch = tid & 7;
    const bf16_t* gb = QKV + (size_t)(b * LROW) * 3072 + 1024 + h * 64 + sch * 8;
    const int lbase = srow * KP + sch * 16;
    u32x4 st[2];
#define NA_ROW(t) ((t) < 4 ? 64 * (t) : CTX + (rlo + (t) - 4) * 64)
#define NA_LOAD(t) do { const bf16_t* _g = gb + (size_t)(NA_ROW(t) + srow) * 3072; st[0] = *(const u32x4*)_g; st[1] = *(const u32x4*)(_g + 1024); } while (0)
#define NA_STORE(buf) do { *(LAS u32x4*)(lds + (buf) * STG + lbase) = st[0]; *(LAS u32x4*)(lds + (buf) * STG + 64 * KP + (sch >> 2) * 4096 + srow * 64 + (sch & 3) * 16) = st[1]; } while (0)
    const bf16_t* qp = QKV + (size_t)q_row * 3072 + h * 64 + 8 * hh;
    bf16x8 qr[4];
#pragma unroll
    for (int d0 = 0; d0 < 4; ++d0) qr[d0] = *(const bf16x8*)(qp + 16 * d0);
    f32x16 o[2];
#pragma unroll
    for (int d = 0; d < 2; ++d)
#pragma unroll
        for (int i = 0; i < 16; ++i) o[d][i] = 0.f;
    float m_run = 0.f, l_run = 0.f;
    f32x16 negm;
#pragma unroll
    for (int i = 0; i < 16; ++i) negm[i] = 0.f;
    const int cs = min(max(cq - 8, 0), 48);
    float mk0[16], mk1[16];
#pragma unroll
    for (int i = 0; i < 16; ++i) { const int ck = (i & 3) + 8 * (i >> 2) + 4 * hh;
        mk0[i] = (ck >= cs && ck < cs + 16) ? 0.f : -1e30f; mk1[i] = (ck + 32 >= cs && ck + 32 < cs + 16) ? 0.f : -1e30f; }
    NA_LOAD(0); NA_STORE(0); __syncthreads();
    for (int t = 0; t < NT; ++t) {
        const int cur = t & 1;
        if (t + 1 < NT) NA_LOAD(t + 1);
        const int ri = rlo + t - 4;
        const bool active = (t < 4) || (ri >= rs_w && ri <= rs_w + 7);
        if (active) {
            LAS const unsigned char* Kb = lds + cur * STG + r * KP + hh * 16;
            LAS const unsigned char* Vb = lds + cur * STG + 64 * KP;
            f32x16 p0 = negm, p1 = negm;
#pragma unroll
            for (int d0 = 0; d0 < 4; ++d0) { const bf16x8 k0 = *(const LAS bf16x8*)(Kb + d0 * 32), k1 = *(const LAS bf16x8*)(Kb + 32 * KP + d0 * 32);
                p0 = mfma32(k0, qr[d0], p0); p1 = mfma32(k1, qr[d0], p1); }
            if (t >= 4) {
                LAS const float* bt = rpbL + (ri - rw + 7) * 31 + 15 - cq + 4 * hh;
#pragma unroll
                for (int i = 0; i < 16; ++i) { const int ci = (i & 3) + 8 * (i >> 2);
                    p0[i] = (p0[i] + bt[ci]) + mk0[i]; p1[i] = (p1[i] + bt[ci + 32]) + mk1[i]; }
            }
            softmax_pv<2>(p0, p1, o, negm, m_run, l_run, t == 0, wsf, Vb, KP, r, hh, lane);
        }
        if (t + 1 < NT) NA_STORE(cur ^ 1);
        LDS_BARRIER();
    }
#undef NA_ROW
#undef NA_LOAD
#undef NA_STORE
    const float lt = l_run + __shfl_xor(l_run, 32);
    if (hh == 0) wsf[r] = 1.f / lt;
    const int orow0 = (ctxq ? b * LROW : b * LROW + CTX + R * 256) + 32 * wid;
#pragma unroll
    for (int g4 = 0; g4 < 4; ++g4) { const f32x4 a4 = *(const LAS f32x4*)(wsf + 8 * g4 + 4 * hh);
#pragma unroll
        for (int e = 0; e < 4; ++e) { const int i = 4 * g4 + e; const int q = 8 * g4 + 4 * hh + e;
            bf16_t* op = O + (size_t)(orow0 + q) * DM + h * 64 + r;
            op[0] = (bf16_t)(pk2(o[0][i] * a4[e], 0.f) & 0xffffu); op[32] = (bf16_t)(pk2(o[1][i] * a4[e], 0.f) & 0xffffu); } }
    __syncthreads();
}

DI void na_phase(Frame& F, unsigned char* ws) {
    const bf16_t* QKV = (const bf16_t*)(ws + WS_ACT); bf16_t* O = (bf16_t*)(ws + WS_U);
    for (int u = F.vcu; u < 2048 + 256; u += F.G) {
        if (u < 2048) { const int bh = u >> 3, R = u & 7; na_unit(F.lds, F.tid, QKV, O, F.in[I_NARPB], bh >> 4, bh & 15, R, 0); }
        else { const int bh = u - 2048; na_unit(F.lds, F.tid, QKV, O, F.in[I_NARPB], bh >> 4, bh & 15, 0, 1); }
    }
}

template <int CTRL> DI float dppf(float x) { return __int_as_float(__builtin_amdgcn_update_dpp(0, __float_as_int(x), CTRL, 0xf, 0xf, false)); }
DI float allred8(float x) {
    float a, b, c;
    asm volatile("s_nop 1\n\tv_add_f32_dpp %0, %1, %1 row_half_mirror row_mask:0xf bank_mask:0xf bound_ctrl:1" : "=v"(a) : "v"(x));
    asm volatile("s_nop 1\n\tv_add_f32_dpp %0, %1, %1 quad_perm:[1,0,3,2] row_mask:0xf bank_mask:0xf bound_ctrl:1" : "=v"(b) : "v"(a));
    asm volatile("s_nop 1\n\tv_add_f32_dpp %0, %1, %1 quad_perm:[2,3,0,1] row_mask:0xf bank_mask:0xf bound_ctrl:1" : "=v"(c) : "v"(b));
    return c;
}
DI float allred8_ref(float x) { x += dppf<0x141>(x); x += dppf<0xB1>(x); x += dppf<0x4E>(x); return x; }
DI float allred16(float x) { x += dppf<0x128>(x); x += dppf<0x124>(x); x += dppf<0x122>(x); x += dppf<0x121>(x); return x; }
DI void rwkv_scan(Frame& F, unsigned char* ws) {
    const bf16_t* X = (const bf16_t*)(ws + WS_ACT);
    bf16_t* Y0 = (bf16_t*)(ws + WS_U) + (size_t)MROWS * DM;
    bf16_t* Y1 = (bf16_t*)(ws + WS_Y);
    float* CD = (float*)(ws + WS_CD);
    const int tid = F.tid, lane = F.lane, g = tid >> 8, gt = tid & 255, gwv = (tid >> 6) & 3;
    LAS float* buf = (LAS float*)(F.lds) + g * 5120;
    LAS float* ybuf0 = (LAS float*)(F.lds + 40960) + g * 2048;
    LAS float* red = (LAS float*)(F.lds + 57344) + g * 128;
    for (int s0 = F.vcu * 2; s0 < 512; s0 += F.G * 2) {
        const int s = s0 + g, dir = s >> 8, b = (s >> 4) & 15, h = s & 15;
        const int ch = 16 * gwv + (lane & 15), chn = h * 64 + ch, rq = lane >> 4;
        bf16x8 bw[2], ba[2];
#pragma unroll
        for (int ks = 0; ks < 2; ++ks) { u32x4 pw, pa;
#pragma unroll
            for (int e = 0; e < 4; ++e) { const int k = 32 * ks + 8 * rq + 2 * e;
                pw[e] = pk2(F.in[I_RWW2][(size_t)(dir * 64 + k) * 1024 + chn], F.in[I_RWW2][(size_t)(dir * 64 + k + 1) * 1024 + chn]);
                pa[e] = pk2(F.in[I_RWA2][(size_t)(dir * 64 + k) * 1024 + chn], F.in[I_RWA2][(size_t)(dir * 64 + k + 1) * 1024 + chn]); }
            bw[ks] = __builtin_bit_cast(bf16x8, pw); ba[ks] = __builtin_bit_cast(bf16x8, pa); }
        const float w0c = F.in[I_RWW0][dir * 1024 + chn], a0c = F.in[I_RWA0][dir * 1024 + chn], kkc = F.in[I_RWKK][chn], kac = F.in[I_RWKA][chn], rkc = F.in[I_RWRK][chn];
        const bf16_t* Xb = X + (size_t)(b * LROW) * 3584;
        bf16_t* Yd = (dir ? Y1 : Y0) + (size_t)(b * LROW) * DM + h * 64;
        float* CDd = CD + ((size_t)dir * MROWS + (size_t)b * LROW) * 16 + h;
        float Ss[16];
#pragma unroll
        for (int i = 0; i < 16; ++i) Ss[i] = 0.f;
        bf16x8 Bs[2];
        Bs[0] = (bf16x8){0, 0, 0, 0, 0, 0, 0, 0}; Bs[1] = Bs[0];
        const int vl = lane & 15, kq = lane >> 4;
        bf16x8 ahw[2], aha[2]; bf16_t rr_[4], kr_[4], vr_[4];
#define SC_RLO(c) (dir ? (((c) < 16 ? 255 - 16 * (c) : 2559 - 16 * (c)) - 15) : 16 * (c))
#define SC_LOAD(c) do { const int _rlo = SC_RLO(c); const bf16_t* _p = Xb + (size_t)(_rlo + (lane & 15)) * 3584 + 3072 + dir * 64 + 8 * rq; \
        ahw[0] = *(const bf16x8*)_p; ahw[1] = *(const bf16x8*)(_p + 32); aha[0] = *(const bf16x8*)(_p + 128); aha[1] = *(const bf16x8*)(_p + 160); \
        _Pragma("unroll") for (int j = 0; j < 4; ++j) { const bf16_t* _q = Xb + (size_t)(_rlo + 4 * rq + j) * 3584 + chn; rr_[j] = _q[0]; kr_[j] = _q[1024]; vr_[j] = _q[2048]; } } while (0)
#define SC_OUT(cc) do { const int rr_o = gt >> 4, c4_o = (gt & 15) * 4, js_o = dir ? 15 - rr_o : rr_o; const int rlo_o = SC_RLO(cc); \
        const f32x4 yv_o = *(const LAS f32x4*)(ybuf0 + ((cc) & 1) * 1024 + js_o * 64 + c4_o); \
        *(u32x2*)(Yd + (size_t)(rlo_o + rr_o) * DM + c4_o) = (u32x2){pk2(yv_o.x, yv_o.y), pk2(yv_o.z, yv_o.w)}; } while (0)
        SC_LOAD(0);
        for (int c = 0; c < 144; ++c) {
            const int rlo = SC_RLO(c);
            LAS float* cb = buf;
            LAS float* ybuf = ybuf0 + (c & 1) * 1024;
            f32x4 accw = {0.f, 0.f, 0.f, 0.f}, acca = {0.f, 0.f, 0.f, 0.f};
#pragma unroll
            for (int ks = 0; ks < 2; ++ks) { accw = __builtin_amdgcn_mfma_f32_16x16x32_bf16(ahw[ks], bw[ks], accw, 0, 0, 0); acca = __builtin_amdgcn_mfma_f32_16x16x32_bf16(aha[ks], ba[ks], acca, 0, 0, 0); }
            float dec[4], av[4], kkv[4], kd[4], rv[4], vv[4];
#pragma unroll
            for (int j = 0; j < 4; ++j) {
                const float z = w0c + accw[j]; dec[j] = fast_exp(-0.6065306597126334f * sigmoidf_(z));
                av[j] = sigmoidf_(a0c + acca[j]);
                const float kx = bf2f(kr_[j]); rv[j] = bf2f(rr_[j]); vv[j] = bf2f(vr_[j]);
                kkv[j] = kx * kkc; kd[j] = kx * (1.f + (av[j] - 1.f) * kac);
                const float nsq = allred16(kkv[j] * kkv[j]), cp = allred16(rv[j] * kd[j] * rkc);
                if ((lane & 15) == 0) { red[(4 * rq + j) * 4 + gwv] = nsq; red[64 + (4 * rq + j) * 4 + gwv] = cp; }
            }
            LDS_BARRIER();
            if (c > 0) SC_OUT(c - 1);
            const bf16_t rr_s[4] = {rr_[0], rr_[1], rr_[2], rr_[3]};
#pragma unroll
            for (int j = 0; j < 4; ++j) {
                const int rr = 4 * rq + j, js = dir ? 15 - rr : rr;
                const f32x4 n4 = *(const LAS f32x4*)(red + rr * 4);
                const float inv = __builtin_amdgcn_rsqf(fmaxf((n4.x + n4.y) + (n4.z + n4.w), 1e-24f));
                const float kkn = kkv[j] * inv;
                LAS float* d = cb + js * 320 + ch;
                d[0] = dec[j]; d[64] = kkn * av[j]; d[128] = kd[j]; d[192] = vv[j];
                LAS bf16_t* db = (LAS bf16_t*)(cb + js * 320 + 256) + ch;
                db[0] = (bf16_t)(pk2(-kkn, 0.f) & 0xffffu); db[64] = rr_s[j];
            }
            if (gt < 16) { const f32x4 c4 = *(const LAS f32x4*)(red + 64 + gt * 4); CDd[(size_t)(rlo + gt) * 16] = (c4.x + c4.y) + (c4.z + c4.w); }
            if (c + 1 < 144) SC_LOAD(c + 1);
            LDS_BARRIER();
            bf16x8 oa[2][2], orr[2][2]; float owq[2], obq[2], odq[2], ovt[2];
            const int kself = 32 * (vl >> 3) + 8 * kq + (vl & 7);
#define SC_OPS(P, js_) do { LAS const float* sb_ = cb + (js_) * 320; LAS const bf16_t* ab_ = (LAS const bf16_t*)(sb_ + 256) + 8 * kq; \
                oa[P][0] = *(const LAS bf16x8*)(ab_); oa[P][1] = *(const LAS bf16x8*)(ab_ + 32); orr[P][0] = *(const LAS bf16x8*)(ab_ + 64); orr[P][1] = *(const LAS bf16x8*)(ab_ + 96); \
                owq[P] = sb_[kself]; obq[P] = sb_[64 + kself]; odq[P] = sb_[128 + kself]; ovt[P] = sb_[192 + 16 * gwv + vl]; } while (0)
#define SC_E(J) "v_mul_f32_dpp %" #J ", %16, %" #J " row_newbcast:" #J " row_mask:0xf bank_mask:0xf\n\t"
#define SC_F(J) "v_fmac_f32_dpp %" #J ", %17, %19 row_newbcast:" #J " row_mask:0xf bank_mask:0xf\n\t"
#define SC_G(J) "v_fmac_f32_dpp %" #J ", %18, %20 row_newbcast:" #J " row_mask:0xf bank_mask:0xf\n\t"
            SC_OPS(0, 0);
#pragma unroll
            for (int js = 0; js < 16; ++js) {
                const int P = js & 1;
                if (js + 1 < 16) SC_OPS(P ^ 1, js + 1);
                __builtin_amdgcn_sched_barrier(0);
                const f32x4 zero4 = {0.f, 0.f, 0.f, 0.f};
                const f32x4 acs0 = __builtin_amdgcn_mfma_f32_16x16x32_bf16(oa[P][0], Bs[0], zero4, 0, 0, 0), acs1 = __builtin_amdgcn_mfma_f32_16x16x32_bf16(oa[P][1], Bs[1], zero4, 0, 0, 0);
                const float vt = ovt[P];
                const float sa = acs0[0] + acs1[0];
                const float wq = owq[P], bq = obq[P], dq = odq[P];
                asm volatile("s_nop 1\n\t"
                    SC_E(0) SC_E(1) SC_E(2) SC_E(3) SC_E(4) SC_E(5) SC_E(6) SC_E(7) SC_E(8) SC_E(9) SC_E(10) SC_E(11) SC_E(12) SC_E(13) SC_E(14) SC_E(15)
                    SC_F(0) SC_F(1) SC_F(2) SC_F(3) SC_F(4) SC_F(5) SC_F(6) SC_F(7) SC_F(8) SC_F(9) SC_F(10) SC_F(11) SC_F(12) SC_F(13) SC_F(14) SC_F(15)
                    SC_G(0) SC_G(1) SC_G(2) SC_G(3) SC_G(4) SC_G(5) SC_G(6) SC_G(7) SC_G(8) SC_G(9) SC_G(10) SC_G(11) SC_G(12) SC_G(13) SC_G(14) SC_G(15)
                    "s_nop 0"
                    : "+v"(Ss[0]), "+v"(Ss[1]), "+v"(Ss[2]), "+v"(Ss[3]), "+v"(Ss[4]), "+v"(Ss[5]), "+v"(Ss[6]), "+v"(Ss[7]),
                      "+v"(Ss[8]), "+v"(Ss[9]), "+v"(Ss[10]), "+v"(Ss[11]), "+v"(Ss[12]), "+v"(Ss[13]), "+v"(Ss[14]), "+v"(Ss[15])
                    : "v"(wq), "v"(bq), "v"(dq), "v"(sa), "v"(vt));
#pragma unroll
                for (int s_ = 0; s_ < 2; ++s_) {
                    u32x4 pk; pk.x = pk2(Ss[8 * s_ + 0], Ss[8 * s_ + 1]); pk.y = pk2(Ss[8 * s_ + 2], Ss[8 * s_ + 3]); pk.z = pk2(Ss[8 * s_ + 4], Ss[8 * s_ + 5]); pk.w = pk2(Ss[8 * s_ + 6], Ss[8 * s_ + 7]);
                    Bs[s_] = __builtin_bit_cast(bf16x8, pk);
                }
                f32x4 acy = {0.f, 0.f, 0.f, 0.f};
                acy = __builtin_amdgcn_mfma_f32_16x16x32_bf16(orr[P][0], Bs[0], acy, 0, 0, 0); acy = __builtin_amdgcn_mfma_f32_16x16x32_bf16(orr[P][1], Bs[1], acy, 0, 0, 0);
                if (kq == 0) ybuf[js * 64 + 16 * gwv + vl] = acy[0];
                __builtin_amdgcn_sched_barrier(0);
            }
#undef SC_E
#undef SC_F
#undef SC_G
#undef SC_OPS
        }
        LDS_BARRIER();
        SC_OUT(143);
#undef SC_OUT
#undef SC_RLO
#undef SC_LOAD
        __syncthreads();
    }
}

DI void rwkv_readout(Frame& F, unsigned char* ws) {
    const bf16_t* X = (const bf16_t*)(ws + WS_ACT);
    bf16_t* G = (bf16_t*)(ws + WS_U);
    const bf16_t* Y0 = G + (size_t)MROWS * DM; const bf16_t* Y1 = (const bf16_t*)(ws + WS_Y);
    const float* CD = (const float*)(ws + WS_CD);
    const int c0 = 16 * F.lane, hd = F.lane >> 2;
    float lng[16], lnb[16];
#pragma unroll
    for (int i = 0; i < 16; i += 4) { const f32x4 g_ = *(const f32x4*)(F.in[I_RWLNG] + c0 + i), b_ = *(const f32x4*)(F.in[I_RWLNB] + c0 + i);
        lng[i] = g_.x; lng[i + 1] = g_.y; lng[i + 2] = g_.z; lng[i + 3] = g_.w; lnb[i] = b_.x; lnb[i + 1] = b_.y; lnb[i + 2] = b_.z; lnb[i + 3] = b_.w; }
    u32x4 na[2], nb[2], nv[2], ng_[2]; float ncd0 = 0.f, ncd1 = 0.f;
#define RD_LOAD(row_) do { _Pragma("unroll") for (int j = 0; j < 2; ++j) { na[j] = *(const u32x4*)(Y0 + (size_t)(row_) * DM + c0 + 8 * j); nb[j] = *(const u32x4*)(Y1 + (size_t)(row_) * DM + c0 + 8 * j); \
        nv[j] = *(const u32x4*)(X + (size_t)(row_) * 3584 + 2048 + c0 + 8 * j); ng_[j] = *(const u32x4*)(G + (size_t)(row_) * DM + c0 + 8 * j); } \
        ncd0 = CD[(size_t)(row_) * 16 + hd]; ncd1 = CD[((size_t)MROWS + (row_)) * 16 + hd]; } while (0)
    if (F.gw < MROWS) RD_LOAD(F.gw);
    for (int row = F.gw; row < MROWS; row += F.NGW) {
        float y[16], vv[16], gg[16];
        const float cc = ncd0 + ncd1;
#pragma unroll
        for (int j = 0; j < 2; ++j) {
            const u32x4 a = na[j], bq = nb[j], v4 = nv[j], g4 = ng_[j];
#pragma unroll
            for (int e = 0; e < 4; ++e) { y[8 * j + 2 * e] = bflo(a[e]) + bflo(bq[e]); y[8 * j + 2 * e + 1] = bfhi(a[e]) + bfhi(bq[e]);
                vv[8 * j + 2 * e] = bflo(v4[e]); vv[8 * j + 2 * e + 1] = bfhi(v4[e]); gg[8 * j + 2 * e] = bflo(g4[e]); gg[8 * j + 2 * e + 1] = bfhi(g4[e]); }
        }
        if (row + F.NGW < MROWS) RD_LOAD(row + F.NGW);
        float s = 0.f;
#pragma unroll
        for (int i = 0; i < 16; ++i) s += y[i];
        s += __shfl_xor(s, 1); s += __shfl_xor(s, 2);
        const float mean = s * (1.f / 64.f); float q = 0.f;
#pragma unroll
        for (int i = 0; i < 16; ++i) { y[i] -= mean; q += y[i] * y[i]; }
        q += __shfl_xor(q, 1); q += __shfl_xor(q, 2);
        const float rstd = 1.f / sqrtf(q * (1.f / 64.f) + 64e-5f);
        u32x4 o[2];
#pragma unroll
        for (int j = 0; j < 2; ++j)
#pragma unroll
            for (int e = 0; e < 4; ++e) { const int i = 8 * j + 2 * e;
                const float z0 = ((y[i] * rstd) * lng[i] + lnb[i] + cc * vv[i]) * gg[i];
                const float z1 = ((y[i + 1] * rstd) * lng[i + 1] + lnb[i + 1] + cc * vv[i + 1]) * gg[i + 1];
                o[j][e] = pk2(z0, z1); }
        *(u32x4*)(G + (size_t)row * DM + c0) = o[0]; *(u32x4*)(G + (size_t)row * DM + c0 + 8) = o[1];
    }
#undef RD_LOAD
}


#define XB_TMO      128
#define XB_XCNT(j)  (256  + 64 * (j))
#define XB_XSUB(j)  (1280 + 64 * (j))
#define XB_XGEN(j)  (2304 + 64 * (j))
#define XB_TOP      3328
#define XB_TOPGEN   3392
#define XCD_BAR_WORDS 3456
#define XB_SPIN_CAP (1u << 18)
DI unsigned xb_ld(unsigned* p)              { return __hip_atomic_load(p, __ATOMIC_RELAXED, __HIP_MEMORY_SCOPE_AGENT); }
DI unsigned xb_add(unsigned* p, unsigned v) { return __hip_atomic_fetch_add(p, v, __ATOMIC_RELAXED, __HIP_MEMORY_SCOPE_AGENT); }
DI unsigned xb_xcc_id() { return (unsigned)__builtin_amdgcn_s_getreg((3 << 11) | 20) & 0xFu; }
#define XB_SPIN(cond, bar) do { unsigned _sp = 0; while (cond) { __builtin_amdgcn_s_sleep(1); \
    if ((++_sp & 255u) == 0u) { if (xb_ld(&(bar)[XB_TMO])) break; if (_sp > XB_SPIN_CAP) { atomicAdd(&(bar)[XB_TMO], 1u); break; } } } } while (0)
struct XcdBarrier { unsigned* bar; unsigned x; volatile LAS unsigned* st; };
DI XcdBarrier xcd_barrier_post(unsigned* bar, volatile LAS unsigned* st) {
    XcdBarrier b; b.bar = bar; b.x = xb_xcc_id(); b.st = st;
    if (threadIdx.x == 0) (void)xb_add(&bar[XB_XCNT(b.x)], 1u);
    return b;
}
DI void xcd_barrier_complete(unsigned* bar, unsigned x, unsigned& nloc, unsigned& nx) {
    const unsigned G = gridDim.x * gridDim.y * gridDim.z;
    unsigned sum, cnt, mine, sp = 0u;
    for (;;) {
        sum = 0u; cnt = 0u; mine = 0u;
#pragma unroll
        for (unsigned j = 0; j < 16; ++j) { const unsigned c = xb_ld(&bar[XB_XCNT(j)]); sum += c; cnt += (c > 0u) ? 1u : 0u; mine = (j == x) ? c : mine; }
        if (sum == G) break;
        __builtin_amdgcn_s_sleep(1);
        if ((++sp & 255u) == 0u) { if (xb_ld(&bar[XB_TMO])) break; if (sp > XB_SPIN_CAP) { atomicAdd(&bar[XB_TMO], 1u); break; } }
    }
    nloc = mine > 0u ? mine : 1u; nx = cnt > 0u ? cnt : 1u;
}
DI void xcd_barrier(const XcdBarrier& b) {
    asm volatile("s_waitcnt vmcnt(0)" ::: "memory");
    __syncthreads();
    if (threadIdx.x == 0) {
        unsigned* bar = b.bar;
        __builtin_amdgcn_s_waitcnt(0);
        unsigned nloc = b.st[0], nx = b.st[1];
        if (nloc == 0u) { xcd_barrier_complete(bar, b.x, nloc, nx); b.st[0] = nloc; b.st[1] = nx; }
        const unsigned old = xb_add(&bar[XB_XSUB(b.x)], 1u);
        const unsigned gen = old / nloc;
        if (old + 1u == (gen + 1u) * nloc) {
            __builtin_amdgcn_fence(__ATOMIC_RELEASE, "agent");
            asm volatile("s_waitcnt vmcnt(0)" ::: "memory");
            const unsigned og = xb_add(&bar[XB_TOP], 1u);
            const unsigned tg = og / nx;
            if (og + 1u == (tg + 1u) * nx) xb_add(&bar[XB_TOPGEN], 1u);
            else XB_SPIN(xb_ld(&bar[XB_TOPGEN]) == tg, bar);
            __builtin_amdgcn_fence(__ATOMIC_ACQUIRE, "agent");
            xb_add(&bar[XB_XGEN(b.x)], 1u);
            asm volatile("s_waitcnt vmcnt(0)" ::: "memory");
        } else {
            XB_SPIN(xb_ld(&bar[XB_XGEN(b.x)]) == gen, bar);
            __builtin_amdgcn_fence(__ATOMIC_ACQUIRE, "agent");
            asm volatile("s_waitcnt vmcnt(0)" ::: "memory");
        }
    }
    __syncthreads();
}

enum { OP_RP0 = 0, OP_G1, OP_G2, OP_RP1, OP_XX, OP_RKVH, OP_GG, OP_SCAN, OP_RDOUT, OP_QKV, OP_ATT, OP_OPROJ, OP_RP2, OP_G5, OP_G6, OP_RP3, OP_END };
DI int next_op(int kind, int op) {
    switch (op) {
        case OP_RP0: return OP_G1; case OP_G1: return OP_G2; case OP_G2: return OP_RP1;
        case OP_RP1: return kind == 2 ? OP_XX : OP_QKV;
        case OP_XX: return OP_RKVH; case OP_RKVH: return OP_GG; case OP_GG: return OP_SCAN; case OP_SCAN: return OP_RDOUT; case OP_RDOUT: return OP_OPROJ;
        case OP_QKV: return OP_ATT; case OP_ATT: return OP_OPROJ; case OP_OPROJ: return OP_RP2;
        case OP_RP2: return OP_G5; case OP_G5: return OP_G6; case OP_G6: return OP_RP3; default: return OP_END;
    }
}

__global__ void __launch_bounds__(512, 2) mega(const float* i0, const float* i1, const float* i2, const float* i3, const float* i4, const float* i5, const float* i6, const float* i7, const float* i8, const float* i9, const float* i10, const float* i11, const float* i12, const float* i13, const float* i14, const float* i15, const float* i16, const float* i17, const float* i18, const float* i19, const float* i20, const float* i21, const float* i22, const float* i23, const float* i24, const float* i25, const float* i26, const float* i27, const float* i28, const float* i29, const float* i30, const float* i31, float* out, unsigned char* ws0) {
    const float* in_[32] = {i0, i1, i2, i3, i4, i5, i6, i7, i8, i9, i10, i11, i12, i13, i14, i15, i16, i17, i18, i19, i20, i21, i22, i23, i24, i25, i26, i27, i28, i29, i30, i31};
    extern __shared__ __attribute__((aligned(16))) unsigned char lds_raw[];
    cg::grid_group grid = cg::this_grid();
    Frame F;
#define BUILD_FRAME() do { int tid_ = threadIdx.x; asm volatile("" : "+v"(tid_)); int bx_ = blockIdx.x; asm volatile("" : "+s"(bx_)); \
    F.lds = (LAS unsigned char*)lds_raw; F.tid = tid_; F.lane = tid_ & 63; F.wave = __builtin_amdgcn_readfirstlane(tid_ >> 6); \
    F.G = gridDim.x; F.bx = bx_; F.vcu = (F.G % 8 == 0) ? (bx_ % 8) * (F.G / 8) + bx_ / 8 : bx_; \
    F.gw = F.vcu * 8 + F.wave; F.NGW = F.G * 8; F.in = in_; } while (0)
    BUILD_FRAME();
    unsigned char* ws = ws0;

#ifndef NO_P0
    phase0(F, ws);
#endif
    grid.sync();
    volatile LAS unsigned* bst = (volatile LAS unsigned*)(F.lds + LDS_BYTES - 64);
    if (F.tid < 2) bst[F.tid] = 0u;
    __syncthreads();
    const XcdBarrier xbar = xcd_barrier_post((unsigned*)(ws0 + WS_BAR), bst);

    for (int l = 0; l < 4; ++l) {
        const int kind = l % 3; const bool last = (l == 3);
        const float* ng = F.in[I_NORMG] + l * 6 * DM;
        int op = (l == 0) ? OP_RP0 : OP_G1;
        int sub = 0, rp_lo = 0;
        while (op != OP_END) {
            { size_t zoff = 0; asm volatile("" : "+s"(zoff)); ws = ws0 + zoff; }
            BUILD_FRAME();
            float* HC = (float*)(ws + WS_HC); bf16_t* WB = (bf16_t*)(ws + WS_WB); bf16_t* U = (bf16_t*)(ws + WS_U); bf16_t* ACT = (bf16_t*)(ws + WS_ACT); bf16_t* YB = (bf16_t*)(ws + WS_Y);
            const float* cosT = (const float*)(ws + WS_ROPE); const float* sinT = cosT + 1024;
            int rpop = -1, rlo = 0, rhi = MROWS, rwidx = F.gw, rnw = F.NGW; bool fill = false;
            if (op == OP_G1 || op == OP_G2 || op == OP_G5 || op == OP_G6 || op == OP_QKV || op == OP_RKVH || op == OP_GG || op == OP_OPROJ) {
                pg8::Gemm g; pg8::Epi E; E.cosT = cosT; E.sinT = sinT; int skip = 0;
                if (op == OP_G1 || op == OP_G5) { g.A = U; g.lda = 1024; g.Bt = WB + (op == OP_G1 ? WB_IN0 : WB_IN1); g.ldb = 1024; g.N = 5632; g.K = 1024; E.mode = pg8::EPI_SWIGLU; E.O = ACT; E.ldc = FF; skip = (last && op == OP_G5); }
                else if (op == OP_G2 || op == OP_G6) { g.A = ACT; g.lda = FF; g.Bt = WB + (op == OP_G2 ? WB_OUT0 : WB_OUT1); g.ldb = FF; g.N = 1024; g.K = FF; E.mode = pg8::EPI_PLAIN; E.O = YB; E.ldc = 1024; skip = (last && op == OP_G6); }
                else if (op == OP_QKV) { g.A = U; g.lda = 1024; g.Bt = WB + WB_MIXIN; g.ldb = 1024; g.N = 3072; g.K = 1024; E.mode = kind == 0 ? pg8::EPI_QKV_DA : pg8::EPI_QKV_NA; E.O = ACT; E.ldc = 3072; }
                else if (op == OP_RKVH) { g.A = U; g.lda = 2048; g.Bt = WB + WB_MIXIN; g.ldb = 2048; g.N = 3584; g.K = 2048; E.mode = pg8::EPI_RWKV; E.O = ACT; E.ldc = 3584; }
                else if (op == OP_GG) { g.A = ACT + 3328; g.lda = 3584; g.Bt = WB + WB_G2T; g.ldb = 256; g.N = 1024; g.K = 256; E.mode = pg8::EPI_PLAIN; E.O = U; E.ldc = 1024; }
                else { g.A = U; g.lda = 1024; g.Bt = WB + WB_MIXOUT; g.ldb = 1024; g.N = 1024; g.K = 1024; E.mode = pg8::EPI_PLAIN; E.O = YB; E.ldc = 1024; skip = last; }
                g.nM = skip ? 128 : 144; g.skip = skip;
                pg8::StaticOrder S; S.init(g.nM, g.N, F.G, F.bx, skip);
                fill = (op == OP_G2 || op == OP_G6 || op == OP_OPROJ) && !skip && F.G == 256;
                if (fill) { S.pmode = 1; S.r0 = sub ? 2 : 0; S.nr = sub ? 1 : 2;
                    if (sub == 1 && F.bx >= 64) { rpop = (op == OP_G2) ? OP_RP1 : (op == OP_G6 ? OP_RP3 : OP_RP2); rlo = 0; rhi = 128 * 256; rwidx = (F.bx - 64) * 8 + F.wave; rnw = 192 * 8; } }
#ifndef NO_GEMM
                pg8::gemm_phase(F.lds, F.tid, g, S, E);
#endif
            } else if (op == OP_RP0 || op == OP_RP1 || op == OP_RP2 || op == OP_RP3) { rpop = op; rlo = rp_lo; }
            if (rpop >= 0) {
                RowPass P;
                P.hsrc_lat = out; P.hsrc_ctx = HC; P.hdst_lat = out; P.hdst_ctx = HC; P.U = U; P.ldu = 1024; P.skip_ctx = 0; P.lpost = l; P.lpre = l;
                if (rpop == OP_RP0) { P.hsrc_lat = F.in[I_X]; P.hsrc_ctx = F.in[I_CTX]; P.hdst_lat = (float*)F.in[I_X]; P.hdst_ctx = (float*)F.in[I_CTX];   P.Y = nullptr; P.gpost = ng; P.gate_idx = 0; P.coef = 0.f; P.gpre = ng; P.shift_idx = 0; }
                else if (rpop == OP_RP1) { if (l == 0) { P.hsrc_lat = F.in[I_X]; P.hsrc_ctx = F.in[I_CTX]; } P.Y = YB; P.gpost = ng + DM; P.gate_idx = 2; P.coef = 0.5f; P.gpre = ng + 2 * DM; P.shift_idx = 3; P.ldu = (kind == 2) ? 2048 : 1024; }
                else if (rpop == OP_RP2) { P.Y = YB; P.gpost = ng + 3 * DM; P.gate_idx = 5; P.coef = 1.f; P.gpre = ng + 4 * DM; P.shift_idx = 6; P.skip_ctx = last; }
                else { P.Y = YB; P.gpost = ng + 5 * DM; P.gate_idx = 8; P.coef = 0.5f; P.gpre = last ? nullptr : ng + 6 * DM; P.shift_idx = 0; P.lpre = l + 1; P.skip_ctx = last; }
#ifndef NO_RP
                row_pass(F, ws, P, rlo, rhi, rwidx, rnw);
#endif
#ifndef NO_CONV
                if (op == OP_RP3 && !last) { __syncthreads(); convert_layer(F, ws, l + 1); }
#endif
            }
#ifndef NO_XX
            if (op == OP_XX) { xx_pass(F, ws); }
#endif

#ifndef NO_SCAN
            if (op == OP_SCAN) { rwkv_scan(F, ws); }
#endif

#ifndef NO_RDOUT
            if (op == OP_RDOUT) { rwkv_readout(F, ws); }
#endif

#ifndef NO_ATT
            if (op == OP_ATT) {
#ifndef NO_DA
 if (kind == 0) da_phase(F, ws, l);
#endif
#ifndef NO_NA
 if (kind == 1) na_phase(F, ws);
#endif
 }
#endif
            xcd_barrier(xbar);
            if (fill) { if (sub == 0) { sub = 1; continue; } sub = 0; rp_lo = 128 * 256; }
            else if (rpop >= 0) rp_lo = 0;
            op = next_op(kind, op);
        }
    }
}

extern "C" void kernel_launch(void* const* d_in, const int* in_sizes, int n_in, void* d_out, int out_size,
                              void* d_ws, size_t ws_size, hipStream_t stream) {
    static int grid = 0;
    if (grid == 0) {
        if (n_in != 32 || ws_size < WS_END) { fprintf(stderr, "kernel_launch: need 32 inputs and %zu B of workspace; got %d, %zu\n", (size_t)WS_END, n_in, ws_size); grid = -1; return; }
        int dev = 0, cus = 0, per_cu = 0;
        (void)hipGetDevice(&dev);
        (void)hipDeviceGetAttribute(&cus, hipDeviceAttributeMultiprocessorCount, dev);
        (void)hipFuncSetAttribute((const void*)mega, hipFuncAttributeMaxDynamicSharedMemorySize, LDS_BYTES);
        (void)hipOccupancyMaxActiveBlocksPerMultiprocessor(&per_cu, (const void*)mega, 512, LDS_BYTES);
        if (per_cu < 1) per_cu = 1;
        grid = cus * per_cu;
    }
    if (grid < 0) return;
    const float* inp[32]; for (int i = 0; i < 32; ++i) inp[i] = (const float*)d_in[i];
    float* outp = (float*)d_out; unsigned char* wsp = (unsigned char*)d_ws;
    void* kargs[34]; for (int i = 0; i < 32; ++i) kargs[i] = (void*)&inp[i];
    kargs[32] = (void*)&outp; kargs[33] = (void*)&wsp;
    hipError_t e = hipLaunchCooperativeKernel((const void*)mega, dim3(grid), dim3(512), kargs, LDS_BYTES, stream);
    if (e != hipSuccess) fprintf(stderr, "cooperative launch failed: %s (grid %d)\n", hipGetErrorString(e), grid);
}
```

```cpp
#include <hip/hip_runtime.h>
#include <hip/hip_cooperative_groups.h>
#include <cstdio>
#include <cstdint>
namespace cg = cooperative_groups;
#ifndef REP_MASK
#define REP_MASK 0
#endif

#define LAS __attribute__((address_space(3)))
#define DI __device__ __forceinline__
typedef unsigned short bf16_t;
typedef short bf16x8 __attribute__((ext_vector_type(8)));
typedef short s16x4 __attribute__((ext_vector_type(4)));
typedef float f32x2 __attribute__((ext_vector_type(2)));
typedef float f32x4 __attribute__((ext_vector_type(4)));
typedef float f32x16 __attribute__((ext_vector_type(16)));
typedef unsigned u32x4 __attribute__((ext_vector_type(4)));
typedef unsigned u32x2 __attribute__((ext_vector_type(2)));
typedef __bf16 bf2_t __attribute__((ext_vector_type(2)));

constexpr int DM = 1024, NB = 16, SEQ = 2048, CTX = 256, LROW = 2304, MROWS = NB * LROW, FF = 2816, NMOD = 9216;
constexpr float NORM_EPS = 1e-6f;
constexpr float LOG2E = 1.4426950408889634f;
constexpr float QSCALE = 0.125f * LOG2E;

constexpr size_t MiB = 1u << 20;
constexpr size_t WS_MOD = 0, WS_ROPE = 3 * MiB, WS_LAM = 3 * MiB + 16384, WS_BAR = 3 * MiB + 32768, WS_CD = 4 * MiB, WS_HC = 9 * MiB, WS_WB = 25 * MiB,
                 WS_U = 75 * MiB, WS_ACT = 219 * MiB, WS_Y = 471 * MiB, WS_END = 543 * MiB;
constexpr size_t WB_IN0 = 0, WB_OUT0 = 5767168, WB_IN1 = 8650752, WB_OUT1 = 14417920, WB_MIXIN = 17301504, WB_MIXOUT = 24641536, WB_G2T = 25690112;
constexpr int LDS_BYTES = 147456;

DI unsigned pk2(float lo, float hi) { f32x2 v = {lo, hi}; bf2_t b = __builtin_convertvector(v, bf2_t); return __builtin_bit_cast(unsigned, b); }
DI float bf2f(bf16_t h) { return __uint_as_float(((unsigned)h) << 16); }
DI float bflo(unsigned w) { return __uint_as_float(w << 16); }
DI float bfhi(unsigned w) { return __uint_as_float(w & 0xffff0000u); }
DI float wave_sum(float v) {
#pragma unroll
    for (int o = 1; o < 64; o <<= 1) v += __shfl_xor(v, o);
    return v;
}
#define LDS_BARRIER() asm volatile("s_waitcnt lgkmcnt(0)\n\ts_barrier" ::: "memory")
DI float fast_exp(float x) { return __builtin_amdgcn_exp2f(x * LOG2E); }
DI float sigmoidf_(float x) { return __builtin_amdgcn_rcpf(1.f + fast_exp(-x)); }
DI float siluf_(float x) { return x * sigmoidf_(x); }
DI float tanhf_(float x) { return 1.f - 2.f * __builtin_amdgcn_rcpf(1.f + fast_exp(2.f * x)); }

namespace pg8 {
constexpr int BM = 256, BK = 64, HALF = 128, HTB = HALF * BK * 2, NXCD = 8, WGM = 4;
__host__ __device__ __forceinline__ int lds_byte(int r, int c) { const int st = (r >> 4) * 2 + (c >> 5), rr = r & 15, cc = c & 31, ob = rr * 64 + cc * 2; return st * 1024 + (ob ^ (((ob >> 9) & 1) << 5)); }
__host__ __device__ __forceinline__ void stage_rc(int b, int& R, int& C) { const int st = b / 1024, sb = b % 1024, swz = sb ^ (((sb >> 9) & 1) << 5); R = (st >> 1) * 16 + swz / 64; C = (st & 1) * 32 + (swz % 64) / 2; }
__host__ __device__ __forceinline__ int perm32(int rho) { const int n = rho >> 4, i = rho & 15; return 8 * (i >> 2) + 4 * n + (i & 3); }

struct Unit { int pm, pn; };
struct Gemm { const bf16_t* A; const bf16_t* Bt; int lda, ldb, N, K, nM, skip; };

struct StaticOrder {
    int nM, nN, nwg, G, c, skip;
    int pmode, r0, nr;
    DI void init(int nM_, int N, int G_, int c_, int skip_) { nM = nM_; nN = N / BM; nwg = nM * nN; G = G_; c = c_; skip = skip_; pmode = 0; r0 = 0; nr = 0; }
    DI bool next(int i, Unit& u) const {
        if (pmode) {
            if (i >= nr) return false;
            const int round = r0 + i, xcd = c & 7, j = c >> 3, full = nM >> 6; int panel;
            if (round < full) { panel = round * 64 + xcd * 8 + (j & 7); u.pn = j >> 3; }
            else { if (j >= 8) return false; panel = full * 64 + 2 * xcd + (j & 1); u.pn = j >> 1; if (panel >= nM) return false; }
            u.pm = skip ? (panel + panel / 8 + 1) : panel;
            return true;
        }
        const long L = (long)i * G + c; if (L >= nwg) return false;
        int wgid = (int)L; { const int q = nwg / NXCD, r = nwg % NXCD, xcd = wgid % NXCD, off = wgid / NXCD; wgid = (xcd < r ? xcd * (q + 1) : r * (q + 1) + (xcd - r) * q) + off; }
        const int nig = WGM * nN, gid = wgid / nig, fm = gid * WGM, gsz = (nM - fm) < WGM ? (nM - fm) : WGM;
        int pm = fm + ((wgid % nig) % gsz); u.pn = (wgid % nig) / gsz;
        u.pm = skip ? (pm + pm / 8 + 1) : pm;
        return true;
    }
};

enum { EPI_PLAIN = 0, EPI_SWIGLU = 1, EPI_QKV_DA = 2, EPI_QKV_NA = 3, EPI_RWKV = 4 };
struct Epi {
    static constexpr bool PERM = true;
    int mode; bf16_t* O; int ldc; const float* cosT; const float* sinT;
    DI void operator()(const f32x4 (&acc)[2][2][4][2], const Unit& u, int wr, int wc, int fr, int fq) const {
        const int row0 = u.pm * BM + wr * 64 + fr;
        if (mode == EPI_SWIGLU) {
            const int col0 = u.pn * 128 + wc * 32 + 8 * fq;
#pragma unroll
            for (int ai = 0; ai < 2; ++ai)
#pragma unroll
                for (int m = 0; m < 4; ++m) {
                    bf16_t* rowp = O + (size_t)(row0 + ai * HALF + m * 16) * ldc + col0;
                    const f32x4 a0 = acc[ai][0][m][0], a1 = acc[ai][0][m][1], b0 = acc[ai][1][m][0], b1 = acc[ai][1][m][1];
                    u32x4 w;
                    w.x = pk2(siluf_(a0[0]) * b0[0], siluf_(a0[1]) * b0[1]); w.y = pk2(siluf_(a0[2]) * b0[2], siluf_(a0[3]) * b0[3]);
                    w.z = pk2(siluf_(a1[0]) * b1[0], siluf_(a1[1]) * b1[1]); w.w = pk2(siluf_(a1[2]) * b1[2], siluf_(a1[3]) * b1[3]);
                    *(u32x4*)rowp = w;
                }
        } else {
            const int col0 = u.pn * BM + wc * 32 + 8 * fq;
            const int jt = u.pm % 9;
            float sc = 1.f; bool rope = false; int act0 = 0, act1 = 0;
            if (mode == EPI_QKV_DA) { if (u.pn < 4) sc = QSCALE; if (u.pn < 8 && jt != 0) rope = true; }
            else if (mode == EPI_QKV_NA) { if (u.pn < 4) sc = QSCALE; }
            else if (mode == EPI_RWKV) { if (u.pn == 12) act0 = 1; if (u.pn == 13) { act0 = 2; act1 = 2; } }
#pragma unroll
            for (int ai = 0; ai < 2; ++ai)
#pragma unroll
                for (int m = 0; m < 4; ++m) {
                    bf16_t* rowp = O + (size_t)(row0 + ai * HALF + m * 16) * ldc + col0;
                    f32x4 c0 = {1.f, 1.f, 1.f, 1.f}, c1 = c0, s0 = {0.f, 0.f, 0.f, 0.f}, s1 = s0;
                    if (rope) {
                        const int t = (jt - 1) * 256 + ai * HALF + wr * 64 + m * 16 + fr;
                        const int pos = (wc & 1) ? (t & 63) : (t >> 6);
                        const float* cp = cosT + pos * 16 + 8 * (fq & 1); const float* sp = sinT + pos * 16 + 8 * (fq & 1);
                        c0 = *(const f32x4*)cp; c1 = *(const f32x4*)(cp + 4); s0 = *(const f32x4*)sp; s1 = *(const f32x4*)(sp + 4);
                        if (!(fq & 2)) { s0 = -s0; s1 = -s1; }
                    }
#pragma unroll
                    for (int bj = 0; bj < 2; ++bj) {
                        f32x4 v0 = acc[ai][bj][m][0], v1 = acc[ai][bj][m][1];
                        if (rope) {
                            f32x4 p0, p1;
#pragma unroll
                            for (int e = 0; e < 4; ++e) { p0[e] = __shfl_xor(v0[e], 32); p1[e] = __shfl_xor(v1[e], 32); }
                            v0 = v0 * c0 + p0 * s0; v1 = v1 * c1 + p1 * s1;
                        }
                        v0 = v0 * sc; v1 = v1 * sc;
                        const int act = bj ? act1 : act0;
                        if (act == 1) {
#pragma unroll
                            for (int e = 0; e < 4; ++e) { v0[e] = tanhf_(v0[e]); v1[e] = tanhf_(v1[e]); }
                        } else if (act == 2) {
#pragma unroll
                            for (int e = 0; e < 4; ++e) { v0[e] = sigmoidf_(v0[e]); v1[e] = sigmoidf_(v1[e]); }
                        }
                        u32x4 w; w.x = pk2(v0[0], v0[1]); w.y = pk2(v0[2], v0[3]); w.z = pk2(v1[0], v1[1]); w.w = pk2(v1[2], v1[3]);
                        *(u32x4*)(rowp + bj * HALF) = w;
                    }
                }
        }
    }
};

DI void gemm_phase(LAS unsigned char* lds, const int tid, const Gemm g, const StaticOrder& S, const Epi& E) {
    const int wid = __builtin_amdgcn_readfirstlane(tid >> 6), lane = tid & 63, wr = wid >> 2, wc = wid & 3, fr = lane & 15, fq = lane >> 4;
    const int K = g.K, nt = K / BK;
    unsigned voffA[2], voffB[2];
#pragma unroll
    for (int i = 0; i < 2; ++i) { int R, C; stage_rc(tid * 16 + i * 8192, R, C); const int Rb = (R & ~31) + perm32(R & 31);
        voffA[i] = (unsigned)(R * g.lda + C) * 2u; voffB[i] = (unsigned)(Rb * g.ldb + C) * 2u; }
    const size_t kstep = (size_t)(BK * 2);
    const size_t hstepA = (size_t)HALF * g.lda * 2, hstepB = (size_t)HALF * g.ldb * 2;
    const size_t tstepA = 2 * hstepA, tstepB = 2 * hstepB;
    const unsigned ldsw = (unsigned)wid * 1024u;
    const int aoff = lds_byte(wr * 64 + fr, fq * 8), boff = lds_byte(wc * 32 + fr, fq * 8);
#define PG8_SA(b, h) (((b) * 2 + (h)) * HTB)
#define PG8_SB(b, h) ((4 + (b) * 2 + (h)) * HTB)
#define PG8_STAGE(bufoff, gbase, voff) do { _Pragma("unroll") for (int _i = 0; _i < 2; ++_i) \
        __builtin_amdgcn_global_load_lds((const unsigned*)((const char*)(gbase) + (voff)[_i]), (LAS unsigned*)(lds + (bufoff) + ldsw + _i * 8192), 16, 0, 0); } while (0)
#define PG8_LDA(dst, b, h) do { _Pragma("unroll") for (int m = 0; m < 4; ++m) _Pragma("unroll") for (int k = 0; k < 2; ++k) dst[m][k] = *(const LAS bf16x8*)(lds + PG8_SA(b, h) + aoff + m * 2048 + k * 1024); } while (0)
#define PG8_LDB(dst, b, h) do { _Pragma("unroll") for (int n = 0; n < 2; ++n) _Pragma("unroll") for (int k = 0; k < 2; ++k) dst[n][k] = *(const LAS bf16x8*)(lds + PG8_SB(b, h) + boff + n * 2048 + k * 1024); } while (0)
#define PG8_MMA(ai, bj, At, Bt) do { __builtin_amdgcn_s_setprio(1); _Pragma("unroll") for (int m = 0; m < 4; ++m) _Pragma("unroll") for (int n = 0; n < 2; ++n) _Pragma("unroll") for (int k = 0; k < 2; ++k) \
        acc[ai][bj][m][n] = __builtin_amdgcn_mfma_f32_16x16x32_bf16(Bt[n][k], At[m][k], acc[ai][bj][m][n], 0, 0, 0); __builtin_amdgcn_s_setprio(0); } while (0)
#define PG8_WAIT_V(n) asm volatile("s_waitcnt vmcnt(" #n ")" ::: "memory")
#define PG8_WAIT_L(n) asm volatile("s_waitcnt lgkmcnt(" #n ")" ::: "memory")
#define PG8_BAR __builtin_amdgcn_s_barrier()
#define PG8_SCHED __builtin_amdgcn_sched_barrier(0)
    Unit cur, nxt; int ui = 0;
    if (!S.next(0, cur)) return;
    f32x4 acc[2][2][4][2];
#pragma unroll
    for (int a = 0; a < 2; ++a)
#pragma unroll
        for (int b = 0; b < 2; ++b)
#pragma unroll
            for (int m = 0; m < 4; ++m)
#pragma unroll
                for (int n = 0; n < 2; ++n) acc[a][b][m][n] = (f32x4){0.f, 0.f, 0.f, 0.f};
    bf16x8 At[4][2], B0[2][2], B1[2][2];
    const char* cA = (const char*)g.A + (size_t)cur.pm * tstepA; const char* cB = (const char*)g.Bt + (size_t)cur.pn * tstepB;
    PG8_STAGE(PG8_SB(0, 0), cB, voffB); PG8_STAGE(PG8_SB(0, 1), cB + hstepB, voffB); PG8_STAGE(PG8_SA(0, 0), cA, voffA); PG8_STAGE(PG8_SA(0, 1), cA + hstepA, voffA);
    if (wr == 1) PG8_BAR;
    PG8_WAIT_V(2); PG8_BAR;
    PG8_STAGE(PG8_SB(1, 0), cB + kstep, voffB); PG8_STAGE(PG8_SA(1, 0), cA + kstep, voffA); PG8_STAGE(PG8_SB(1, 1), cB + hstepB + kstep, voffB);
    PG8_WAIT_V(6); PG8_BAR;
    for (;;) {
        const bool has_next = S.next(ui + 1, nxt);
        const char* nA = has_next ? (const char*)g.A + (size_t)nxt.pm * tstepA : cA; const char* nB = has_next ? (const char*)g.Bt + (size_t)nxt.pn * tstepB : cB;
        for (int t = 0; t < nt; t += 2) {
            const bool last = (t == nt - 2);
            const char* a1 = cA + (size_t)(t + 1) * kstep;
            const char* a2 = last ? nA : cA + (size_t)(t + 2) * kstep; const char* b2 = last ? nB : cB + (size_t)(t + 2) * kstep;
            const char* a3 = a2 + kstep; const char* b3 = b2 + kstep;
            PG8_LDB(B0, 0, 0); PG8_LDB(B1, 0, 1); PG8_SCHED; PG8_LDA(At, 0, 0); PG8_STAGE(PG8_SA(1, 1), a1 + hstepA, voffA);
            PG8_WAIT_V(8); PG8_WAIT_L(0); PG8_BAR; PG8_MMA(0, 0, At, B0); PG8_MMA(0, 1, At, B1); PG8_BAR; PG8_SCHED;
            PG8_LDA(At, 0, 1); PG8_STAGE(PG8_SB(0, 0), b2, voffB); PG8_STAGE(PG8_SB(0, 1), b2 + hstepB, voffB); PG8_STAGE(PG8_SA(0, 0), a2, voffA);
            PG8_WAIT_V(8); PG8_WAIT_L(0); PG8_BAR; PG8_MMA(1, 0, At, B0); PG8_MMA(1, 1, At, B1); PG8_BAR; PG8_SCHED;
            PG8_LDB(B0, 1, 0); PG8_LDB(B1, 1, 1); PG8_SCHED; PG8_LDA(At, 1, 0); PG8_STAGE(PG8_SA(0, 1), a2 + hstepA, voffA);
            PG8_WAIT_V(8); PG8_WAIT_L(0); PG8_BAR; PG8_MMA(0, 0, At, B0); PG8_MMA(0, 1, At, B1); PG8_BAR; PG8_SCHED;
            PG8_LDA(At, 1, 1); PG8_STAGE(PG8_SB(1, 0), b3, voffB); PG8_STAGE(PG8_SB(1, 1), b3 + hstepB, voffB); PG8_STAGE(PG8_SA(1, 0), a3, voffA);
            PG8_WAIT_V(8); PG8_WAIT_L(0); PG8_BAR; PG8_MMA(1, 0, At, B0); PG8_MMA(1, 1, At, B1); PG8_BAR; PG8_SCHED;
        }
        if (wr == 0) PG8_BAR;
        E(acc, cur, wr, wc, fr, fq);
        if (!has_next) break;
#pragma unroll
        for (int a = 0; a < 2; ++a)
#pragma unroll
            for (int b = 0; b < 2; ++b)
#pragma unroll
                for (int m = 0; m < 4; ++m)
#pragma unroll
                    for (int n = 0; n < 2; ++n) acc[a][b][m][n] = (f32x4){0.f, 0.f, 0.f, 0.f};
        cur = nxt; cA = nA; cB = nB; ++ui;
        if (wr == 1) PG8_BAR;
    }
    PG8_WAIT_V(0);
    PG8_BAR;
#undef PG8_SA
#undef PG8_SB
#undef PG8_STAGE
#undef PG8_LDA
#undef PG8_LDB
#undef PG8_MMA
#undef PG8_WAIT_V
#undef PG8_WAIT_L
#undef PG8_BAR
#undef PG8_SCHED
}
}

struct Args { const float* in[32]; float* out; unsigned char* ws; };

struct Frame {
    LAS unsigned char* lds;
    int tid, lane, wave, vcu, G, gw, NGW, bx;
    const float* const* in;
};
enum { I_X = 0, I_C, I_CTX, I_CCTX, I_ADAW, I_ADAB, I_NORMG, I_FWIN, I_FWOUT, I_DAWIN, I_DAWOUT, I_DALAM, I_DASUB, I_NAWIN, I_NAWOUT, I_NARPB,
       I_RWMU, I_RWWIN, I_RWWOUT, I_RWW0, I_RWW1, I_RWW2, I_RWA0, I_RWA1, I_RWA2, I_RWG1, I_RWG2, I_RWKK, I_RWKA, I_RWRK, I_RWLNG, I_RWLNB };

DI void conv_item(const float* W, int ldw, int k0, int n0, int kmax, const float* mu, bf16_t* dst, int ldd, int dst_row0, int dst_k0, LAS float* scr, int lane) {
    float cv[32];
#pragma unroll
    for (int i = 0; i < 32; ++i) { const int k = k0 + 2 * i + (lane >> 5); cv[i] = (k < kmax) ? W[(size_t)k * ldw + n0 + (lane & 31)] : 0.f; }
    if (mu) {
#pragma unroll
        for (int i = 0; i < 32; ++i) { const int k = k0 + 2 * i + (lane >> 5); cv[i] *= (k < kmax) ? mu[k] : 0.f; }
    }
#pragma unroll
    for (int i = 0; i < 32; ++i) scr[(2 * i + (lane >> 5)) * 33 + (lane & 31)] = cv[i];
    asm volatile("s_waitcnt lgkmcnt(0)" ::: "memory");
    const int c = lane & 7;
#pragma unroll
    for (int j = 0; j < 4; ++j) { const int n = (lane >> 3) + 8 * j; const LAS float* s = scr + (8 * c) * 33 + n;
        u32x4 o; o.x = pk2(s[0 * 33], s[1 * 33]); o.y = pk2(s[2 * 33], s[3 * 33]); o.z = pk2(s[4 * 33], s[5 * 33]); o.w = pk2(s[6 * 33], s[7 * 33]);
        *(u32x4*)(dst + (size_t)(dst_row0 + n) * ldd + dst_k0 + k0 + 8 * c) = o; }
    asm volatile("s_waitcnt lgkmcnt(0)" ::: "memory");
}

DI void convert_layer(Frame& F, unsigned char* ws, int l) {
    bf16_t* WB = (bf16_t*)(ws + WS_WB);
    LAS float* scr = (LAS float*)(F.lds + F.wave * 16384);
    const int kind = l % 3, slot = l / 3;
    constexpr int I_FIN = 16 * 176, I_FOUT = 44 * 32, I_MIN = 16 * 96, I_MOUT = 16 * 32;
    const float* fwin = F.in[I_FWIN] + (size_t)l * 2 * 1024 * 5632;
    const float* fwout = F.in[I_FWOUT] + (size_t)l * 2 * 2816 * 1024;
    int nitems = 2 * I_FIN + 2 * I_FOUT + I_MOUT;
    if (kind == 2) nitems += 2 * I_MIN + 4 * 16 * 2 * 2 + 16 * 5 * 2 + 4 * 32 + 96;
    else nitems += I_MIN;
    for (int it = F.gw; it < nitems; it += F.NGW) {
        int r = it;
        if (r < 2 * I_FIN) { const int s = r / I_FIN; r -= s * I_FIN; const int kb = r / 176, nb = r % 176, n0 = nb * 32;
            const int hf = n0 / 2816, rem = n0 % 2816, p = rem / 128, i = rem % 128;
            conv_item(fwin + (size_t)s * 1024 * 5632, 5632, kb * 64, n0, 1024, nullptr, WB + (s ? WB_IN1 : WB_IN0), 1024, p * 256 + hf * 128 + i, 0, scr, F.lane); continue; }
        r -= 2 * I_FIN;
        if (r < 2 * I_FOUT) { const int s = r / I_FOUT; r -= s * I_FOUT; const int kb = r / 32, nb = r % 32;
            conv_item(fwout + (size_t)s * 2816 * 1024, 1024, kb * 64, nb * 32, 2816, nullptr, WB + (s ? WB_OUT1 : WB_OUT0), 2816, nb * 32, 0, scr, F.lane); continue; }
        r -= 2 * I_FOUT;
        if (r < I_MOUT) { const float* w = kind == 0 ? F.in[I_DAWOUT] + (size_t)slot * 1024 * 1024 : kind == 1 ? F.in[I_NAWOUT] : F.in[I_RWWOUT];
            const int kb = r / 32, nb = r % 32;
            conv_item(w, 1024, kb * 64, nb * 32, 1024, nullptr, WB + WB_MIXOUT, 1024, nb * 32, 0, scr, F.lane); continue; }
        r -= I_MOUT;
        if (kind != 2) { const float* w = kind == 0 ? F.in[I_DAWIN] + (size_t)slot * 1024 * 3072 : F.in[I_NAWIN];
            const int kb = r / 96, nb = r % 96;
            conv_item(w, 3072, kb * 64, nb * 32, 1024, nullptr, WB + WB_MIXIN, 1024, nb * 32, 0, scr, F.lane); continue; }
        const float* mu = F.in[I_RWMU];
        if (r < 2 * I_MIN) { const int var = r / I_MIN; r -= var * I_MIN; const int kb = r / 96, nb = r % 96, n0 = nb * 32;
            const int mj = n0 < 1024 ? 0 : (n0 < 2048 ? 2 : 3);
            conv_item(F.in[I_RWWIN], 3072, kb * 64, n0, 1024, var ? mu + mj * 1024 : nullptr, WB + WB_MIXIN, 2048, n0, var * 1024, scr, F.lane); continue; }
        r -= 2 * I_MIN;
        if (r < 4 * 16 * 2 * 2) { const int var = r & 1; r >>= 1; const int nb = r & 1; r >>= 1; const int kb = r & 15; r >>= 4; const int dir = r & 1, isa = r >> 1;
            const float* w = (isa ? F.in[I_RWA1] : F.in[I_RWW1]) + (size_t)dir * 1024 * 64;
            conv_item(w, 64, kb * 64, nb * 32, 1024, var ? mu + (isa ? 4 : 1) * 1024 : nullptr, WB + WB_MIXIN, 2048, (isa ? 3200 : 3072) + dir * 64 + nb * 32, var * 1024, scr, F.lane); continue; }
        r -= 4 * 16 * 2 * 2;
        if (r < 16 * 5 * 2) { const int var = r & 1; r >>= 1; const int nb = r % 5, kb = r / 5;
            conv_item(F.in[I_RWG1], 160, kb * 64, nb * 32, 1024, var ? mu + 5 * 1024 : nullptr, WB + WB_MIXIN, 2048, 3328 + nb * 32, var * 1024, scr, F.lane); continue; }
        r -= 16 * 5 * 2;
        if (r < 4 * 32) { const int kb = r / 32, nb = r % 32;
            conv_item(F.in[I_RWG2], 1024, kb * 64, nb * 32, 160, nullptr, WB + WB_G2T, 256, nb * 32, 0, scr, F.lane); continue; }
        r -= 4 * 32;
        { bf16_t* z = WB + WB_MIXIN + (size_t)(3488 + r) * 2048;
#pragma unroll
          for (int j = 0; j < 4; ++j) *(u32x4*)(z + (j * 64 + F.lane) * 8) = (u32x4){0u, 0u, 0u, 0u}; }
    }
}

DI void phase0(Frame& F, unsigned char* ws) {
    LAS float* sl = (LAS float*)F.lds;
    LAS float* part = (LAS float*)(F.lds + 69632);
    float* MOD = (float*)(ws + WS_MOD);
    for (int i = F.tid; i < 17 * 1024; i += 512) { const float v = i < 16384 ? F.in[I_C][i] : F.in[I_CCTX][i - 16384]; sl[i] = v / (1.f + expf(-v)); }
    __syncthreads();
    for (int item = F.vcu; item < 4 * 72; item += F.G) {
        const int l = item / 72, n0 = (item % 72) * 128;
        const float* W = F.in[I_ADAW] + (size_t)l * 1024 * NMOD + n0 + 2 * F.lane;
        float acc[17][2];
#pragma unroll
        for (int r = 0; r < 17; ++r) { acc[r][0] = 0.f; acc[r][1] = 0.f; }
        const int kbase = F.wave * 128;
        f32x2 wn[16];
#pragma unroll
        for (int e = 0; e < 16; ++e) wn[e] = *(const f32x2*)(W + (size_t)(kbase + e) * NMOD);
        for (int k16 = 0; k16 < 128; k16 += 16) {
            f32x2 w[16];
#pragma unroll
            for (int e = 0; e < 16; ++e) w[e] = wn[e];
            if (k16 + 16 < 128) {
#pragma unroll
                for (int e = 0; e < 16; ++e) wn[e] = *(const f32x2*)(W + (size_t)(kbase + k16 + 16 + e) * NMOD);
            }
#pragma unroll
            for (int q = 0; q < 4; ++q)
#pragma unroll
                for (int r = 0; r < 17; ++r) { const f32x4 s = *(const LAS f32x4*)(sl + r * 1024 + kbase + k16 + 4 * q);
#pragma unroll
                    for (int e = 0; e < 4; ++e) { acc[r][0] += s[e] * w[4 * q + e].x; acc[r][1] += s[e] * w[4 * q + e].y; } }
        }
#pragma unroll
        for (int r = 0; r < 17; ++r) *(LAS f32x2*)(part + (F.wave * 17 + r) * 128 + 2 * F.lane) = (f32x2){acc[r][0], acc[r][1]};
        __syncthreads();
        for (int idx = F.tid; idx < 17 * 128; idx += 512) { const int r = idx >> 7, cI = idx & 127; float s = 0.f;
#pragma unroll
            for (int w = 0; w < 8; ++w) s += part[(w * 17 + r) * 128 + cI];
            MOD[((size_t)l * 17 + r) * NMOD + n0 + cI] = s + F.in[I_ADAB][(size_t)l * NMOD + n0 + cI]; }
        __syncthreads();
    }
    if (F.bx == 0) {
        for (int i = F.tid; i < 3456; i += 512) ((unsigned*)(ws + WS_BAR))[i] = 0u;
        float* cosT = (float*)(ws + WS_ROPE); float* sinT = cosT + 1024;
        for (int i = F.tid; i < 1024; i += 512) { const int pos = i >> 4, p = i & 15; const float fr = powf(10000.f, -(float)p / 16.f); const float ang = (float)pos * fr; cosT[i] = cosf(ang); sinT[i] = sinf(ang); }
        if (F.tid < 2) { const float* lv = F.in[I_DALAM] + F.tid * 256; float d0 = 0.f, d1 = 0.f;
            for (int i = 0; i < 64; ++i) { d0 += lv[i] * lv[64 + i]; d1 += lv[128 + i] * lv[192 + i]; }
            const float li = 0.8f - 0.6f * expf(-0.3f * (float)(F.tid * 3));
            float* lam = (float*)(ws + WS_LAM); lam[2 * F.tid] = expf(d0) - expf(d1) + li; lam[2 * F.tid + 1] = li; }
    }
    __syncthreads();
    convert_layer(F, ws, 0);
}

struct RowPass {
    const float* hsrc_lat; const float* hsrc_ctx; float* hdst_lat; float* hdst_ctx;
    const bf16_t* Y;
    const float* gpost; int gate_idx; float coef; int lpost;
    const float* gpre; int shift_idx; int lpre;
    bf16_t* U; int ldu; int skip_ctx;
};
DI void row_pass(Frame& F, unsigned char* ws, const RowPass& P, int row_lo, int row_hi, int widx, int nw) {
    const float* MOD = (const float*)(ws + WS_MOD);
    const int rpw = (row_hi - row_lo + nw - 1) / nw;
    const int rbeg = row_lo + widx * rpw, rend = min(rbeg + rpw, row_hi);
    if (rbeg >= rend) return;
    const int l4 = 4 * F.lane;
    f32x4 gpo[4], gpr[4], gat[4], shf[4], scl[4];
#pragma unroll
    for (int j = 0; j < 4; ++j) { gpo[j] = *(const f32x4*)(P.gpost + l4 + 256 * j); gpr[j] = P.gpre ? *(const f32x4*)(P.gpre + l4 + 256 * j) : (f32x4){0.f, 0.f, 0.f, 0.f}; }
    int cur_mrow = -1;
    f32x4 hn[4]; u32x2 yn[4];
#define RP_ADDR(row, isctx, hoff) const int _b = (row) / LROW, _t = (row) % LROW; const bool isctx = _t < CTX; \
        const size_t hoff = isctx ? ((size_t)_b * CTX + _t) * DM : ((size_t)_b * SEQ + (_t - CTX)) * DM;
#define RP_LOAD(row) do { RP_ADDR(row, ic_, ho_) if (!(ic_ && P.skip_ctx)) { const float* hs_ = (ic_ ? P.hsrc_ctx : P.hsrc_lat) + ho_ + l4; \
        _Pragma("unroll") for (int j = 0; j < 4; ++j) hn[j] = *(const f32x4*)(hs_ + 256 * j); \
        if (P.Y) { const bf16_t* yr_ = P.Y + (size_t)(row) * DM + l4; _Pragma("unroll") for (int j = 0; j < 4; ++j) yn[j] = *(const u32x2*)(yr_ + 256 * j); } } } while (0)
    RP_LOAD(rbeg);
    for (int row = rbeg; row < rend; ++row) {
        f32x4 h[4]; u32x2 yv[4];
#pragma unroll
        for (int j = 0; j < 4; ++j) { h[j] = hn[j]; yv[j] = yn[j]; }
        if (row + 1 < rend) RP_LOAD(row + 1);
        RP_ADDR(row, isctx, hoff)
        if (isctx && P.skip_ctx) continue;
        float* hd = (isctx ? P.hdst_ctx : P.hdst_lat) + hoff + l4;
        const bool copy_h = ((isctx ? P.hsrc_ctx : P.hsrc_lat) != (isctx ? P.hdst_ctx : P.hdst_lat));
        const int mrow = isctx ? 16 : _b;
        if (mrow != cur_mrow) { cur_mrow = mrow;
            const float* gate = MOD + ((size_t)P.lpost * 17 + mrow) * NMOD + P.gate_idx * DM + l4;
            const float* sh = MOD + ((size_t)P.lpre * 17 + mrow) * NMOD + P.shift_idx * DM + l4;
#pragma unroll
            for (int j = 0; j < 4; ++j) { gat[j] = *(const f32x4*)(gate + 256 * j) * P.coef; shf[j] = *(const f32x4*)(sh + 256 * j); scl[j] = *(const f32x4*)(sh + DM + 256 * j) + 1.f; } }
        if (P.Y) {
            f32x4 y[4]; float ss = 0.f;
#pragma unroll
            for (int j = 0; j < 4; ++j) { y[j] = (f32x4){bflo(yv[j].x), bfhi(yv[j].x), bflo(yv[j].y), bfhi(yv[j].y)};
                ss += (y[j].x * y[j].x + y[j].y * y[j].y) + (y[j].z * y[j].z + y[j].w * y[j].w); }
            const float rstd = 1.f / sqrtf(wave_sum(ss) * (1.f / DM) + NORM_EPS);
#pragma unroll
            for (int j = 0; j < 4; ++j) h[j] = h[j] + gat[j] * ((y[j] * rstd) * gpo[j]);
        }
        if (P.Y || copy_h) {
#pragma unroll
            for (int j = 0; j < 4; ++j) *(f32x4*)(hd + 256 * j) = h[j];
        }
        if (P.gpre) {
            float ss = 0.f;
#pragma unroll
            for (int j = 0; j < 4; ++j) ss += (h[j].x * h[j].x + h[j].y * h[j].y) + (h[j].z * h[j].z + h[j].w * h[j].w);
            const float rstd = 1.f / sqrtf(wave_sum(ss) * (1.f / DM) + NORM_EPS);
            bf16_t* ur = P.U + (size_t)row * P.ldu + l4;
#pragma unroll
            for (int j = 0; j < 4; ++j) { const f32x4 u = ((h[j] * rstd) * gpr[j]) * scl[j] + shf[j];
                *(u32x2*)(ur + 256 * j) = (u32x2){pk2(u.x, u.y), pk2(u.z, u.w)}; }
        }
    }
#undef RP_ADDR
#undef RP_LOAD
}

DI void xx_pass(Frame& F, unsigned char* ws) {
    bf16_t* U = (bf16_t*)(ws + WS_U);
    u32x4 nc[2], np[2], nn[2];
#define XX_LOAD(row_) do { const int t_ = (row_) % LROW; const bool fi_ = (t_ == 0) || (t_ == CTX), la_ = (t_ == CTX - 1) || (t_ == LROW - 1); \
        const bf16_t* ur_ = U + (size_t)(row_) * 2048 + 8 * F.lane; \
        _Pragma("unroll") for (int j = 0; j < 2; ++j) { nc[j] = *(const u32x4*)(ur_ + 512 * j); np[j] = (u32x4){0u, 0u, 0u, 0u}; nn[j] = np[j]; \
            if (!fi_) np[j] = *(const u32x4*)(ur_ - 2048 + 512 * j); if (!la_) nn[j] = *(const u32x4*)(ur_ + 2048 + 512 * j); } } while (0)
    if (F.gw < MROWS) XX_LOAD(F.gw);
    for (int row = F.gw; row < MROWS; row += F.NGW) {
        u32x4 c[2], p[2], n[2];
#pragma unroll
        for (int j = 0; j < 2; ++j) { c[j] = nc[j]; p[j] = np[j]; n[j] = nn[j]; }
        if (row + F.NGW < MROWS) XX_LOAD(row + F.NGW);
        bf16_t* ur = U + (size_t)row * 2048 + 8 * F.lane;
#pragma unroll
        for (int j = 0; j < 2; ++j) {
            u32x4 o;
#pragma unroll
            for (int e = 0; e < 4; ++e) { const float lo = 0.5f * (bflo(p[j][e]) + bflo(n[j][e])) - bflo(c[j][e]); const float hi = 0.5f * (bfhi(p[j][e]) + bfhi(n[j][e])) - bfhi(c[j][e]); o[e] = pk2(lo, hi); }
            *(u32x4*)(ur + 1024 + 512 * j) = o;
        }
    }
#undef XX_LOAD
}

DI f32x16 mfma32(bf16x8 a, bf16x8 b, f32x16 c) { return __builtin_amdgcn_mfma_f32_32x32x16_bf16(a, b, c, 0, 0, 0); }
DI bf16x8 pack8(const f32x16& x, int s) { u32x4 p; p.x = pk2(x[8 * s], x[8 * s + 1]); p.y = pk2(x[8 * s + 2], x[8 * s + 3]); p.z = pk2(x[8 * s + 4], x[8 * s + 5]); p.w = pk2(x[8 * s + 6], x[8 * s + 7]); return __builtin_bit_cast(bf16x8, p); }
typedef short v4i16_t __attribute__((ext_vector_type(4)));
DI s16x4 vtr(LAS const unsigned char* p) { return __builtin_bit_cast(s16x4, __builtin_amdgcn_ds_read_tr16_b64_v4i16((LAS v4i16_t*)p)); }
DI float max3f(float a, float b, float c) { return __builtin_fmaxf(__builtin_fmaxf(a, b), c); }
DI float max16(const f32x16& p) { float a = max3f(p[0], p[1], p[2]), b = max3f(p[3], p[4], p[5]);
    a = max3f(a, p[6], p[7]); b = max3f(b, p[8], p[9]); a = max3f(a, p[10], p[11]); b = max3f(b, p[12], p[13]); a = max3f(a, p[14], p[15]); return __builtin_fmaxf(a, b); }

template <int NDB>
DI void softmax_pv(f32x16& p0, f32x16& p1, f32x16 (&o)[NDB], f32x16& negm, float& m_run, float& l_run, const bool first, LAS float* wsf, LAS const unsigned char* Vb, int KP, int r, int hh, int lane) {
    const int i16 = lane & 15, q4 = i16 >> 2, p4 = i16 & 3, g1 = (lane >> 4) & 1;
    LAS const unsigned char* vl = Vb + (4 * hh + q4) * 64 + 32 * g1 + 8 * p4;
    s16x4 flo[2][NDB], fhi[2][NDB];
#pragma unroll
    for (int d = 0; d < NDB; ++d) { flo[0][d] = vtr(vl + d * 4096); fhi[0][d] = vtr(vl + 8 * 64 + d * 4096); }
    __builtin_amdgcn_sched_barrier(0);
    const float mxh = __builtin_fmaxf(max16(p0), max16(p1));
    if (first || __any(mxh > 8.f)) {
        const float mx = __builtin_fmaxf(mxh, __shfl_xor(mxh, 32));
        const float delta = first ? mx : __builtin_fmaxf(mx, 0.f);
        m_run += delta;
#pragma unroll
        for (int i = 0; i < 16; ++i) { p0[i] -= delta; p1[i] -= delta; negm[i] = -m_run; }
        if (!first) {
            const float alpha = __builtin_amdgcn_exp2f(-delta);
            l_run *= alpha;
            if (hh == 0) wsf[r] = alpha;
#pragma unroll
            for (int g4 = 0; g4 < 4; ++g4) { const f32x4 a4 = *(const LAS f32x4*)(wsf + 8 * g4 + 4 * hh);
#pragma unroll
                for (int d = 0; d < NDB; ++d)
#pragma unroll
                    for (int e = 0; e < 4; ++e) o[d][4 * g4 + e] *= a4[e]; }
        }
    }
    f32x2 ls2 = {0.f, 0.f};
#pragma unroll
    for (int i = 0; i < 16; i += 2) {
        p0[i] = __builtin_amdgcn_exp2f(p0[i]); p0[i + 1] = __builtin_amdgcn_exp2f(p0[i + 1]); p1[i] = __builtin_amdgcn_exp2f(p1[i]); p1[i + 1] = __builtin_amdgcn_exp2f(p1[i + 1]);
        ls2 += (f32x2){p0[i], p0[i + 1]}; ls2 += (f32x2){p1[i], p1[i + 1]};
    }
    l_run += ls2.x + ls2.y;
    const bf16x8 pa[4] = {pack8(p0, 0), pack8(p0, 1), pack8(p1, 0), pack8(p1, 1)};
#pragma unroll
    for (int k = 0; k < 4; ++k) {
        if (k + 1 < 4) {
            LAS const unsigned char* vk = vl + 16 * (k + 1) * 64;
#pragma unroll
            for (int d = 0; d < NDB; ++d) { flo[(k + 1) & 1][d] = vtr(vk + d * 4096); fhi[(k + 1) & 1][d] = vtr(vk + 8 * 64 + d * 4096); }
        }
        __builtin_amdgcn_sched_barrier(0);
#pragma unroll
        for (int d = 0; d < NDB; ++d) { const bf16x8 vb = __builtin_shufflevector(flo[k & 1][d], fhi[k & 1][d], 0, 1, 2, 3, 4, 5, 6, 7); o[d] = mfma32(pa[k], vb, o[d]); }
        __builtin_amdgcn_sched_barrier(0);
    }
}

DI void da_pv_plain(const bf16x8 (&pa)[4], f32x16 (&o)[4], LAS const unsigned char* Vb, int hh, int lane) {
    const int i16 = lane & 15, q4 = i16 >> 2, p4 = i16 & 3, g1 = (lane >> 4) & 1;
    LAS const unsigned char* vl = Vb + (4 * hh + q4) * 64 + 32 * g1 + 8 * p4;
#pragma unroll
    for (int k = 0; k < 4; ++k) {
        s16x4 lo[4], hi[4];
#pragma unroll
        for (int d = 0; d < 4; ++d) { lo[d] = vtr(vl + 16 * k * 64 + d * 4096); hi[d] = vtr(vl + 16 * k * 64 + 8 * 64 + d * 4096); }
#pragma unroll
        for (int d = 0; d < 4; ++d) { const bf16x8 vb = __builtin_shufflevector(lo[d], hi[d], 0, 1, 2, 3, 4, 5, 6, 7); o[d] = mfma32(pa[k], vb, o[d]); }
    }
}
DI void da_step(f32x16& p0, f32x16& p1, f32x16 (&o)[4], float& m_run, float& l_run, bf16x8 (&pa)[4], const bool first, LAS float* wsf, LAS const unsigned char* Vprev, int r, int hh, int lane) {
    const float mxh = __builtin_fmaxf(max16(p0), max16(p1));
    const bool need = first || __any(mxh > 8.f);
    float delta = 0.f;
    if (need) { const float mx = __builtin_fmaxf(mxh, __shfl_xor(mxh, 32)); delta = first ? mx : __builtin_fmaxf(mx, 0.f); m_run += delta;
#pragma unroll
        for (int i = 0; i < 16; ++i) { p0[i] -= delta; p1[i] -= delta; } }
    const int i16 = lane & 15, q4 = i16 >> 2, p4 = i16 & 3, g1 = (lane >> 4) & 1;
    LAS const unsigned char* vl = Vprev + (4 * hh + q4) * 64 + 32 * g1 + 8 * p4;
    s16x4 flo[2][4], fhi[2][4];
#pragma unroll
    for (int d = 0; d < 4; ++d) { flo[0][d] = vtr(vl + d * 4096); fhi[0][d] = vtr(vl + 8 * 64 + d * 4096); }
    u32x4 pn[4]; f32x2 ls2 = {0.f, 0.f};
#pragma unroll
    for (int k = 0; k < 4; ++k) {
#pragma unroll
        for (int d = 0; d < 4; ++d) {
            __builtin_amdgcn_sched_barrier(0);
            { const bf16x8 vb = __builtin_shufflevector(flo[k & 1][d], fhi[k & 1][d], 0, 1, 2, 3, 4, 5, 6, 7); o[d] = mfma32(pa[k], vb, o[d]); }
            if (k + 1 < 4) { flo[(k + 1) & 1][d] = vtr(vl + 16 * (k + 1) * 64 + d * 4096); fhi[(k + 1) & 1][d] = vtr(vl + 16 * (k + 1) * 64 + 8 * 64 + d * 4096); }
            const int i = 8 * (k & 1) + 2 * d;
            if (k < 2) { p0[i] = __builtin_amdgcn_exp2f(p0[i]); p0[i + 1] = __builtin_amdgcn_exp2f(p0[i + 1]); ls2 += (f32x2){p0[i], p0[i + 1]}; pn[k][d] = pk2(p0[i], p0[i + 1]); }
            else       { p1[i] = __builtin_amdgcn_exp2f(p1[i]); p1[i + 1] = __builtin_amdgcn_exp2f(p1[i + 1]); ls2 += (f32x2){p1[i], p1[i + 1]}; pn[k][d] = pk2(p1[i], p1[i + 1]); }
        }
    }
    __builtin_amdgcn_sched_barrier(0);
#pragma unroll
    for (int k = 0; k < 4; ++k) pa[k] = __builtin_bit_cast(bf16x8, pn[k]);
    if (need && !first) {
        const float alpha = __builtin_amdgcn_exp2f(-delta);
        l_run *= alpha;
        if (hh == 0) wsf[r] = alpha;
#pragma unroll
        for (int g4 = 0; g4 < 4; ++g4) { const f32x4 a4 = *(const LAS f32x4*)(wsf + 8 * g4 + 4 * hh);
#pragma unroll
            for (int d = 0; d < 4; ++d)
#pragma unroll
                for (int e = 0; e < 4; ++e) o[d][4 * g4 + e] *= a4[e]; }
    }
    l_run += ls2.x + ls2.y;
}

DI void da_unit(LAS unsigned char* lds, const int tid, const bf16_t* QKV, bf16_t* O, int q_row0, int kv_row0, int NT, int h, float lam, float one_m_li, const float* subg) {
    const int lane = tid & 63, wid = __builtin_amdgcn_readfirstlane(tid >> 6), r = lane & 31, hh = lane >> 5;
    const int qg = wid >> 1, j = wid & 1;
    constexpr int KP = 272, STG = 2 * 64 * KP;
    LAS float* wsf = (LAS float*)(lds + 3 * STG) + wid * 64;
    const bf16_t* gbase = QKV + (size_t)(kv_row0 + (tid >> 4)) * 3072 + 1024 + h * 128 + (tid & 15) * 8;
    const int lbase = (tid >> 4) * KP + (tid & 15) * 16;
    const int vbase = 64 * KP + ((tid & 15) >> 2) * 4096 + (tid >> 4) * 64 + (tid & 3) * 16;
    u32x4 st[4];
#define DA_LOAD(t) do { _Pragma("unroll") for (int i = 0; i < 4; ++i) st[i] = *(const u32x4*)(gbase + (size_t)(t) * 64 * 3072 + (size_t)(i & 1) * 32 * 3072 + (i >> 1) * 1024); } while (0)
#define DA_STORE(boff) do { _Pragma("unroll") for (int i = 0; i < 2; ++i) { *(LAS u32x4*)(lds + (boff) + lbase + i * 32 * KP) = st[i]; *(LAS u32x4*)(lds + (boff) + vbase + i * 32 * 64) = st[2 + i]; } } while (0)
    const bf16_t* qp = QKV + (size_t)(q_row0 + 32 * qg + r) * 3072 + h * 128 + j * 64 + 8 * hh;
    bf16x8 qr[4];
#pragma unroll
    for (int d0 = 0; d0 < 4; ++d0) qr[d0] = *(const bf16x8*)(qp + 16 * d0);
    f32x16 o[4];
#pragma unroll
    for (int d = 0; d < 4; ++d)
#pragma unroll
        for (int i = 0; i < 16; ++i) o[d][i] = 0.f;
    float m_run = 0.f, l_run = 0.f;
    bf16x8 pa[4];
#pragma unroll
    for (int k = 0; k < 4; ++k) pa[k] = (bf16x8){0, 0, 0, 0, 0, 0, 0, 0};
    DA_LOAD(0); DA_STORE(0);
    { LAS u32x4* z = (LAS u32x4*)(lds + 2 * STG + 64 * KP) + tid; z[0] = (u32x4){0u, 0u, 0u, 0u}; z[512] = (u32x4){0u, 0u, 0u, 0u}; }
    __syncthreads();
    int b_prv = 2 * STG, b_cur = 0, b_nxt = STG;
    for (int t = 0; t < NT; ++t) {
        if (t + 1 < NT) DA_LOAD(t + 1);
        LAS const unsigned char* Kb = lds + b_cur + j * 128 + r * KP + hh * 16;
        f32x16 p0, p1;
        { const float nm = -m_run;
#pragma unroll
          for (int i = 0; i < 16; ++i) { p0[i] = nm; p1[i] = nm; } }
#pragma unroll
        for (int d0 = 0; d0 < 4; ++d0) { const bf16x8 k0 = *(const LAS bf16x8*)(Kb + d0 * 32), k1 = *(const LAS bf16x8*)(Kb + 32 * KP + d0 * 32);
            p0 = mfma32(k0, qr[d0], p0); p1 = mfma32(k1, qr[d0], p1); }
        da_step(p0, p1, o, m_run, l_run, pa, t == 0, wsf, lds + b_prv + 64 * KP, r, hh, lane);
        if (t + 1 < NT) DA_STORE(b_nxt);
        LDS_BARRIER();
        { const int tmp_ = b_prv; b_prv = b_cur; b_cur = b_nxt; b_nxt = tmp_; }
    }
    da_pv_plain(pa, o, lds + b_prv + 64 * KP, hh, lane);
    LDS_BARRIER();
#undef DA_LOAD
#undef DA_STORE
    const float lt = l_run + __shfl_xor(l_run, 32);
    if (hh == 0) wsf[r] = 1.f / lt;
    float rl[16];
#pragma unroll
    for (int g4 = 0; g4 < 4; ++g4) { const f32x4 a4 = *(const LAS f32x4*)(wsf + 8 * g4 + 4 * hh);
#pragma unroll
        for (int e = 0; e < 4; ++e) rl[4 * g4 + e] = a4[e]; }
    LAS float* R = (LAS float*)lds + qg * 32 * 132;
    if (j == 1) {
#pragma unroll
        for (int d = 0; d < 4; ++d)
#pragma unroll
            for (int i = 0; i < 16; ++i) R[((i & 3) + 8 * (i >> 2) + 4 * hh) * 132 + d * 32 + r] = o[d][i] * rl[i] * lam;
    }
    __syncthreads();
    if (j == 0) {
#pragma unroll
        for (int d = 0; d < 4; ++d)
#pragma unroll
            for (int i = 0; i < 16; ++i) { const int idx = ((i & 3) + 8 * (i >> 2) + 4 * hh) * 132 + d * 32 + r; R[idx] = o[d][i] * rl[i] - R[idx]; }
    }
    __syncthreads();
    {
        const int row = tid >> 2, qtr = tid & 3;
        LAS const float* rp = (LAS const float*)lds + (row >> 5) * 32 * 132 + (row & 31) * 132 + qtr * 32;
        f32x4 v[8]; float ss = 0.f;
#pragma unroll
        for (int c = 0; c < 8; ++c) { v[c] = *(const LAS f32x4*)(rp + 4 * c); ss += (v[c].x * v[c].x + v[c].y * v[c].y) + (v[c].z * v[c].z + v[c].w * v[c].w); }
        ss += __shfl_xor(ss, 1); ss += __shfl_xor(ss, 2);
        const float rs = one_m_li / sqrtf(ss * (1.f / 128.f) + NORM_EPS);
        bf16_t* op = O + (size_t)(q_row0 + row) * DM + h * 128 + qtr * 32;
        const float* gp = subg + qtr * 32;
#pragma unroll
        for (int c = 0; c < 4; ++c) { const f32x4 g0 = *(const f32x4*)(gp + 8 * c), g1 = *(const f32x4*)(gp + 8 * c + 4); const f32x4 a = v[2 * c] * rs * g0, b = v[2 * c + 1] * rs * g1;
            *(u32x4*)(op + 8 * c) = (u32x4){pk2(a.x, a.y), pk2(a.z, a.w), pk2(b.x, b.y), pk2(b.z, b.w)}; }
    }
    __syncthreads();
}

DI void da_phase(Frame& F, unsigned char* ws, int l) {
    const bf16_t* QKV = (const bf16_t*)(ws + WS_ACT); bf16_t* O = (bf16_t*)(ws + WS_U);
    const int slot = l / 3; const bool last = (l == 3);
    const float* lamv = (const float*)(ws + WS_LAM); const float lam = lamv[2 * slot], li = lamv[2 * slot + 1];
    const float* subg = F.in[I_DASUB] + slot * 128;
    const int nunits = 2048 + (last ? 0 : 256);
    for (int u = F.vcu; u < nunits; u += F.G) {
        if (u < 2048) { const int bh = u >> 4, qt = u & 15, b = bh >> 3, h = bh & 7;
            da_unit(F.lds, F.tid, QKV, O, b * LROW + CTX + qt * 128, b * LROW, 36, h, lam, 1.f - li, subg); }
        else { const int v = u - 2048, bh = v >> 1, qt = v & 1, b = bh >> 3, h = bh & 7;
            da_unit(F.lds, F.tid, QKV, O, b * LROW + qt * 128, b * LROW, 4, h, lam, 1.f - li, subg); }
    }
}

DI void na_unit(LAS unsigned char* lds, const int tid, const bf16_t* QKV, bf16_t* O, const float* rpb, int b, int h, int R, int ctxq) {
    const int lane = tid & 63, wid = __builtin_amdgcn_readfirstlane(tid >> 6), r = lane & 31, hh = lane >> 5;
    constexpr int KP = 144, STG = 2 * 64 * KP;
    LAS float* wsf = (LAS float*)(lds + 2 * STG) + wid * 64;
    LAS float* rpbL = (LAS float*)(lds + 2 * STG + 2048) + 48;
    const int rw = 4 * R + (wid >> 1), cq = 32 * (wid & 1) + r;
    const int rs_w = min(max(rw - 4, 0), 24);
    const int rlo = min(max(4 * R - 4, 0), 24), rhi = min(max(4 * R - 1, 0), 24) + 7;
    const int NT = ctxq ? 4 : 4 + (rhi - rlo + 1);
    const int q_row = ctxq ? b * LROW + 32 * wid + r : b * LROW + CTX + R * 256 + 32 * wid + r;
    if (!ctxq) { for (int i = tid; i < 465; i += 512) rpbL[i] = rpb[h * 465 + i] * LOG2E; if (tid < 48) { rpbL[tid - 48] = 0.f; rpbL[465 + tid] = 0.f; } }
    const int srow = tid >> 3, sch = tid & 7;
    const bf16_t* gb = QKV + (size_t)(b * LROW) * 3072 + 1024 + h * 64 + sch * 8;
    const int lbase = srow * KP + sch * 16;
    u32x4 st[2];
#define NA_ROW(t) ((t) < 4 ? 64 * (t) : CTX + (rlo + (t) - 4) * 64)
#define NA_LOAD(t) do { const bf16_t* _g = gb + (size_t)(NA_ROW(t) + srow) * 3072; st[0] = *(const u32x4*)_g; st[1] = *(const u32x4*)(_g + 1024); } while (0)
#define NA_STORE(buf) do { *(LAS u32x4*)(lds + (buf) * STG + lbase) = st[0]; *(LAS u32x4*)(lds + (buf) * STG + 64 * KP + (sch >> 2) * 4096 + srow * 64 + (sch & 3) * 16) = st[1]; } while (0)
    const bf16_t* qp = QKV + (size_t)q_row * 3072 + h * 64 + 8 * hh;
    bf16x8 qr[4];
#pragma unroll
    for (int d0 = 0; d0 < 4; ++d0) qr[d0] = *(const bf16x8*)(qp + 16 * d0);
    f32x16 o[2];
#pragma unroll
    for (int d = 0; d < 2; ++d)
#pragma unroll
        for (int i = 0; i < 16; ++i) o[d][i] = 0.f;
    float m_run = 0.f, l_run = 0.f;
    f32x16 negm;
#pragma unroll
    for (int i = 0; i < 16; ++i) negm[i] = 0.f;
    const int cs = min(max(cq - 8, 0), 48);
    float mk0[16], mk1[16];
#pragma unroll
    for (int i = 0; i < 16; ++i) { const int ck = (i & 3) + 8 * (i >> 2) + 4 * hh;
        mk0[i] = (ck >= cs && ck < cs + 16) ? 0.f : -1e30f; mk1[i] = (ck + 32 >= cs && ck + 32 < cs + 16) ? 0.f : -1e30f; }
    NA_LOAD(0); NA_STORE(0); __syncthreads();
    for (int t = 0; t < NT; ++t) {
        const int cur = t & 1;
        if (t + 1 < NT) NA_LOAD(t + 1);
        const int ri = rlo + t - 4;
        const bool active = (t < 4) || (ri >= rs_w && ri <= rs_w + 7);
        if (active) {
            LAS const unsigned char* Kb = lds + cur * STG + r * KP + hh * 16;
            LAS const unsigned char* Vb = lds + cur * STG + 64 * KP;
            f32x16 p0 = negm, p1 = negm;
#pragma unroll
            for (int d0 = 0; d0 < 4; ++d0) { const bf16x8 k0 = *(const LAS bf16x8*)(Kb + d0 * 32), k1 = *(const LAS bf16x8*)(Kb + 32 * KP + d0 * 32);
                p0 = mfma32(k0, qr[d0], p0); p1 = mfma32(k1, qr[d0], p1); }
            if (t >= 4) {
                LAS const float* bt = rpbL + (ri - rw + 7) * 31 + 15 - cq + 4 * hh;
#pragma unroll
                for (int i = 0; i < 16; ++i) { const int ci = (i & 3) + 8 * (i >> 2);
                    p0[i] = (p0[i] + bt[ci]) + mk0[i]; p1[i] = (p1[i] + bt[ci + 32]) + mk1[i]; }
            }
            softmax_pv<2>(p0, p1, o, negm, m_run, l_run, t == 0, wsf, Vb, KP, r, hh, lane);
        }
        if (t + 1 < NT) NA_STORE(cur ^ 1);
        LDS_BARRIER();
    }
#undef NA_ROW
#undef NA_LOAD
#undef NA_STORE
    const float lt = l_run + __shfl_xor(l_run, 32);
    if (hh == 0) wsf[r] = 1.f / lt;
    const int orow0 = (ctxq ? b * LROW : b * LROW + CTX + R * 256) + 32 * wid;
#pragma unroll
    for (int g4 = 0; g4 < 4; ++g4) { const f32x4 a4 = *(const LAS f32x4*)(wsf + 8 * g4 + 4 * hh);
#pragma unroll
        for (int e = 0; e < 4; ++e) { const int i = 4 * g4 + e; const int q = 8 * g4 + 4 * hh + e;
            bf16_t* op = O + (size_t)(orow0 + q) * DM + h * 64 + r;
            op[0] = (bf16_t)(pk2(o[0][i] * a4[e], 0.f) & 0xffffu); op[32] = (bf16_t)(pk2(o[1][i] * a4[e], 0.f) & 0xffffu); } }
    __syncthreads();
}

DI void na_phase(Frame& F, unsigned char* ws) {
    const bf16_t* QKV = (const bf16_t*)(ws + WS_ACT); bf16_t* O = (bf16_t*)(ws + WS_U);
    for (int u = F.vcu; u < 2048 + 256; u += F.G) {
        if (u < 2048) { const int bh = u >> 3, R = u & 7; na_unit(F.lds, F.tid, QKV, O, F.in[I_NARPB], bh >> 4, bh & 15, R, 0); }
        else { const int bh = u - 2048; na_unit(F.lds, F.tid, QKV, O, F.in[I_NARPB], bh >> 4, bh & 15, 0, 1); }
    }
}

template <int CTRL> DI float dppf(float x) { return __int_as_float(__builtin_amdgcn_update_dpp(0, __float_as_int(x), CTRL, 0xf, 0xf, false)); }
DI float allred8(float x) {
    float a, b, c;
    asm volatile("s_nop 1\n\tv_add_f32_dpp %0, %1, %1 row_half_mirror row_mask:0xf bank_mask:0xf bound_ctrl:1" : "=v"(a) : "v"(x));
    asm volatile("s_nop 1\n\tv_add_f32_dpp %0, %1, %1 quad_perm:[1,0,3,2] row_mask:0xf bank_mask:0xf bound_ctrl:1" : "=v"(b) : "v"(a));
    asm volatile("s_nop 1\n\tv_add_f32_dpp %0, %1, %1 quad_perm:[2,3,0,1] row_mask:0xf bank_mask:0xf bound_ctrl:1" : "=v"(c) : "v"(b));
    return c;
}
DI float allred8_ref(float x) { x += dppf<0x141>(x); x += dppf<0xB1>(x); x += dppf<0x4E>(x); return x; }
DI float allred16(float x) { x += dppf<0x128>(x); x += dppf<0x124>(x); x += dppf<0x122>(x); x += dppf<0x121>(x); return x; }
DI void rwkv_scan(Frame& F, unsigned char* ws) {
    const bf16_t* X = (const bf16_t*)(ws + WS_ACT);
    bf16_t* Y0 = (bf16_t*)(ws + WS_U) + (size_t)MROWS * DM;
    bf16_t* Y1 = (bf16_t*)(ws + WS_Y);
    float* CD = (float*)(ws + WS_CD);
    const int tid = F.tid, lane = F.lane, g = tid >> 8, gt = tid & 255, gwv = (tid >> 6) & 3;
    LAS float* buf = (LAS float*)(F.lds) + g * 5120;
    LAS float* ybuf0 = (LAS float*)(F.lds + 40960) + g * 2048;
    LAS float* red = (LAS float*)(F.lds + 57344) + g * 128;
    for (int s0 = F.vcu * 2; s0 < 512; s0 += F.G * 2) {
        const int s = s0 + g, dir = s >> 8, b = (s >> 4) & 15, h = s & 15;
        const int ch = 16 * gwv + (lane & 15), chn = h * 64 + ch, rq = lane >> 4;
        bf16x8 bw[2], ba[2];
#pragma unroll
        for (int ks = 0; ks < 2; ++ks) { u32x4 pw, pa;
#pragma unroll
            for (int e = 0; e < 4; ++e) { const int k = 32 * ks + 8 * rq + 2 * e;
                pw[e] = pk2(F.in[I_RWW2][(size_t)(dir * 64 + k) * 1024 + chn], F.in[I_RWW2][(size_t)(dir * 64 + k + 1) * 1024 + chn]);
                pa[e] = pk2(F.in[I_RWA2][(size_t)(dir * 64 + k) * 1024 + chn], F.in[I_RWA2][(size_t)(dir * 64 + k + 1) * 1024 + chn]); }
            bw[ks] = __builtin_bit_cast(bf16x8, pw); ba[ks] = __builtin_bit_cast(bf16x8, pa); }
        const float w0c = F.in[I_RWW0][dir * 1024 + chn], a0c = F.in[I_RWA0][dir * 1024 + chn], kkc = F.in[I_RWKK][chn], kac = F.in[I_RWKA][chn], rkc = F.in[I_RWRK][chn];
        const bf16_t* Xb = X + (size_t)(b * LROW) * 3584;
        bf16_t* Yd = (dir ? Y1 : Y0) + (size_t)(b * LROW) * DM + h * 64;
        float* CDd = CD + ((size_t)dir * MROWS + (size_t)b * LROW) * 16 + h;
        float Ss[16];
#pragma unroll
        for (int i = 0; i < 16; ++i) Ss[i] = 0.f;
        bf16x8 Bs[2];
        Bs[0] = (bf16x8){0, 0, 0, 0, 0, 0, 0, 0}; Bs[1] = Bs[0];
        const int vl = lane & 15, kq = lane >> 4;
        bf16x8 ahw[2], aha[2]; bf16_t rr_[4], kr_[4], vr_[4];
#define SC_RLO(c) (dir ? (((c) < 16 ? 255 - 16 * (c) : 2559 - 16 * (c)) - 15) : 16 * (c))
#define SC_LOAD(c) do { const int _rlo = SC_RLO(c); const bf16_t* _p = Xb + (size_t)(_rlo + (lane & 15)) * 3584 + 3072 + dir * 64 + 8 * rq; \
        ahw[0] = *(const bf16x8*)_p; ahw[1] = *(const bf16x8*)(_p + 32); aha[0] = *(const bf16x8*)(_p + 128); aha[1] = *(const bf16x8*)(_p + 160); \
        _Pragma("unroll") for (int j = 0; j < 4; ++j) { const bf16_t* _q = Xb + (size_t)(_rlo + 4 * rq + j) * 3584 + chn; rr_[j] = _q[0]; kr_[j] = _q[1024]; vr_[j] = _q[2048]; } } while (0)
#define SC_OUT(cc) do { const int rr_o = gt >> 4, c4_o = (gt & 15) * 4, js_o = dir ? 15 - rr_o : rr_o; const int rlo_o = SC_RLO(cc); \
        const f32x4 yv_o = *(const LAS f32x4*)(ybuf0 + ((cc) & 1) * 1024 + js_o * 64 + c4_o); \
        *(u32x2*)(Yd + (size_t)(rlo_o + rr_o) * DM + c4_o) = (u32x2){pk2(yv_o.x, yv_o.y), pk2(yv_o.z, yv_o.w)}; } while (0)
        SC_LOAD(0);
        for (int c = 0; c < 144; ++c) {
            const int rlo = SC_RLO(c);
            LAS float* cb = buf;
            LAS float* ybuf = ybuf0 + (c & 1) * 1024;
            f32x4 accw = {0.f, 0.f, 0.f, 0.f}, acca = {0.f, 0.f, 0.f, 0.f};
#pragma unroll
            for (int ks = 0; ks < 2; ++ks) { accw = __builtin_amdgcn_mfma_f32_16x16x32_bf16(ahw[ks], bw[ks], accw, 0, 0, 0); acca = __builtin_amdgcn_mfma_f32_16x16x32_bf16(aha[ks], ba[ks], acca, 0, 0, 0); }
            float dec[4], av[4], kkv[4], kd[4], rv[4], vv[4];
#pragma unroll
            for (int j = 0; j < 4; ++j) {
                const float z = w0c + accw[j]; dec[j] = fast_exp(-0.6065306597126334f * sigmoidf_(z));
                av[j] = sigmoidf_(a0c + acca[j]);
                const float kx = bf2f(kr_[j]); rv[j] = bf2f(rr_[j]); vv[j] = bf2f(vr_[j]);
                kkv[j] = kx * kkc; kd[j] = kx * (1.f + (av[j] - 1.f) * kac);
                const float nsq = allred16(kkv[j] * kkv[j]), cp = allred16(rv[j] * kd[j] * rkc);
                if ((lane & 15) == 0) { red[(4 * rq + j) * 4 + gwv] = nsq; red[64 + (4 * rq + j) * 4 + gwv] = cp; }
            }
            LDS_BARRIER();
            if (c > 0) SC_OUT(c - 1);
            const bf16_t rr_s[4] = {rr_[0], rr_[1], rr_[2], rr_[3]};
#pragma unroll
            for (int j = 0; j < 4; ++j) {
                const int rr = 4 * rq + j, js = dir ? 15 - rr : rr;
                const f32x4 n4 = *(const LAS f32x4*)(red + rr * 4);
                const float inv = __builtin_amdgcn_rsqf(fmaxf((n4.x + n4.y) + (n4.z + n4.w), 1e-24f));
                const float kkn = kkv[j] * inv;
                LAS float* d = cb + js * 320 + ch;
                d[0] = dec[j]; d[64] = kkn * av[j]; d[128] = kd[j]; d[192] = vv[j];
                LAS bf16_t* db = (LAS bf16_t*)(cb + js * 320 + 256) + ch;
                db[0] = (bf16_t)(pk2(-kkn, 0.f) & 0xffffu); db[64] = rr_s[j];
            }
            if (gt < 16) { const f32x4 c4 = *(const LAS f32x4*)(red + 64 + gt * 4); CDd[(size_t)(rlo + gt) * 16] = (c4.x + c4.y) + (c4.z + c4.w); }
            if (c + 1 < 144) SC_LOAD(c + 1);
            LDS_BARRIER();
            bf16x8 oa[2][2], orr[2][2]; float owq[2], obq[2], odq[2], ovt[2];
            const int kself = 32 * (vl >> 3) + 8 * kq + (vl & 7);
#define SC_OPS(P, js_) do { LAS const float* sb_ = cb + (js_) * 320; LAS const bf16_t* ab_ = (LAS const bf16_t*)(sb_ + 256) + 8 * kq; \
                oa[P][0] = *(const LAS bf16x8*)(ab_); oa[P][1] = *(const LAS bf16x8*)(ab_ + 32); orr[P][0] = *(const LAS bf16x8*)(ab_ + 64); orr[P][1] = *(const LAS bf16x8*)(ab_ + 96); \
                owq[P] = sb_[kself]; obq[P] = sb_[64 + kself]; odq[P] = sb_[128 + kself]; ovt[P] = sb_[192 + 16 * gwv + vl]; } while (0)
#define SC_E(J) "v_mul_f32_dpp %" #J ", %16, %" #J " row_newbcast:" #J " row_mask:0xf bank_mask:0xf\n\t"
#define SC_F(J) "v_fmac_f32_dpp %" #J ", %17, %19 row_newbcast:" #J " row_mask:0xf bank_mask:0xf\n\t"
#define SC_G(J) "v_fmac_f32_dpp %" #J ", %18, %20 row_newbcast:" #J " row_mask:0xf bank_mask:0xf\n\t"
            SC_OPS(0, 0);
#pragma unroll
            for (int js = 0; js < 16; ++js) {
                const int P = js & 1;
                if (js + 1 < 16) SC_OPS(P ^ 1, js + 1);
                __builtin_amdgcn_sched_barrier(0);
                const f32x4 zero4 = {0.f, 0.f, 0.f, 0.f};
                const f32x4 acs0 = __builtin_amdgcn_mfma_f32_16x16x32_bf16(oa[P][0], Bs[0], zero4, 0, 0, 0), acs1 = __builtin_amdgcn_mfma_f32_16x16x32_bf16(oa[P][1], Bs[1], zero4, 0, 0, 0);
                const float vt = ovt[P];
                const float sa = acs0[0] + acs1[0];
                const float wq = owq[P], bq = obq[P], dq = odq[P];
                asm volatile("s_nop 1\n\t"
                    SC_E(0) SC_E(1) SC_E(2) SC_E(3) SC_E(4) SC_E(5) SC_E(6) SC_E(7) SC_E(8) SC_E(9) SC_E(10) SC_E(11) SC_E(12) SC_E(13) SC_E(14) SC_E(15)
                    SC_F(0) SC_F(1) SC_F(2) SC_F(3) SC_F(4) SC_F(5) SC_F(6) SC_F(7) SC_F(8) SC_F(9) SC_F(10) SC_F(11) SC_F(12) SC_F(13) SC_F(14) SC_F(15)
                    SC_G(0) SC_G(1) SC_G(2) SC_G(3) SC_G(4) SC_G(5) SC_G(6) SC_G(7) SC_G(8) SC_G(9) SC_G(10) SC_G(11) SC_G(12) SC_G(13) SC_G(14) SC_G(15)
                    "s_nop 0"
                    : "+v"(Ss[0]), "+v"(Ss[1]), "+v"(Ss[2]), "+v"(Ss[3]), "+v"(Ss[4]), "+v"(Ss[5]), "+v"(Ss[6]), "+v"(Ss[7]),
                      "+v"(Ss[8]), "+v"(Ss[9]), "+v"(Ss[10]), "+v"(Ss[11]), "+v"(Ss[12]), "+v"(Ss[13]), "+v"(Ss[14]), "+v"(Ss[15])
                    : "v"(wq), "v"(bq), "v"(dq), "v"(sa), "v"(vt));
#pragma unroll
                for (int s_ = 0; s_ < 2; ++s_) {
                    u32x4 pk; pk.x = pk2(Ss[8 * s_ + 0], Ss[8 * s_ + 1]); pk.y = pk2(Ss[8 * s_ + 2], Ss[8 * s_ + 3]); pk.z = pk2(Ss[8 * s_ + 4], Ss[8 * s_ + 5]); pk.w = pk2(Ss[8 * s_ + 6], Ss[8 * s_ + 7]);
                    Bs[s_] = __builtin_bit_cast(bf16x8, pk);
                }
                f32x4 acy = {0.f, 0.f, 0.f, 0.f};
                acy = __builtin_amdgcn_mfma_f32_16x16x32_bf16(orr[P][0], Bs[0], acy, 0, 0, 0); acy = __builtin_amdgcn_mfma_f32_16x16x32_bf16(orr[P][1], Bs[1], acy, 0, 0, 0);
                if (kq == 0) ybuf[js * 64 + 16 * gwv + vl] = acy[0];
                __builtin_amdgcn_sched_barrier(0);
            }
#undef SC_E
#undef SC_F
#undef SC_G
#undef SC_OPS
        }
        LDS_BARRIER();
        SC_OUT(143);
#undef SC_OUT
#undef SC_RLO
#undef SC_LOAD
        __syncthreads();
    }
}

DI void rwkv_readout(Frame& F, unsigned char* ws) {
    const bf16_t* X = (const bf16_t*)(ws + WS_ACT);
    bf16_t* G = (bf16_t*)(ws + WS_U);
    const bf16_t* Y0 = G + (size_t)MROWS * DM; const bf16_t* Y1 = (const bf16_t*)(ws + WS_Y);
    const float* CD = (const float*)(ws + WS_CD);
    const int c0 = 16 * F.lane, hd = F.lane >> 2;
    float lng[16], lnb[16];
#pragma unroll
    for (int i = 0; i < 16; i += 4) { const f32x4 g_ = *(const f32x4*)(F.in[I_RWLNG] + c0 + i), b_ = *(const f32x4*)(F.in[I_RWLNB] + c0 + i);
        lng[i] = g_.x; lng[i + 1] = g_.y; lng[i + 2] = g_.z; lng[i + 3] = g_.w; lnb[i] = b_.x; lnb[i + 1] = b_.y; lnb[i + 2] = b_.z; lnb[i + 3] = b_.w; }
    u32x4 na[2], nb[2], nv[2], ng_[2]; float ncd0 = 0.f, ncd1 = 0.f;
#define RD_LOAD(row_) do { _Pragma("unroll") for (int j = 0; j < 2; ++j) { na[j] = *(const u32x4*)(Y0 + (size_t)(row_) * DM + c0 + 8 * j); nb[j] = *(const u32x4*)(Y1 + (size_t)(row_) * DM + c0 + 8 * j); \
        nv[j] = *(const u32x4*)(X + (size_t)(row_) * 3584 + 2048 + c0 + 8 * j); ng_[j] = *(const u32x4*)(G + (size_t)(row_) * DM + c0 + 8 * j); } \
        ncd0 = CD[(size_t)(row_) * 16 + hd]; ncd1 = CD[((size_t)MROWS + (row_)) * 16 + hd]; } while (0)
    if (F.gw < MROWS) RD_LOAD(F.gw);
    for (int row = F.gw; row < MROWS; row += F.NGW) {
        float y[16], vv[16], gg[16];
        const float cc = ncd0 + ncd1;
#pragma unroll
        for (int j = 0; j < 2; ++j) {
            const u32x4 a = na[j], bq = nb[j], v4 = nv[j], g4 = ng_[j];
#pragma unroll
            for (int e = 0; e < 4; ++e) { y[8 * j + 2 * e] = bflo(a[e]) + bflo(bq[e]); y[8 * j + 2 * e + 1] = bfhi(a[e]) + bfhi(bq[e]);
                vv[8 * j + 2 * e] = bflo(v4[e]); vv[8 * j + 2 * e + 1] = bfhi(v4[e]); gg[8 * j + 2 * e] = bflo(g4[e]); gg[8 * j + 2 * e + 1] = bfhi(g4[e]); }
        }
        if (row + F.NGW < MROWS) RD_LOAD(row + F.NGW);
        float s = 0.f;
#pragma unroll
        for (int i = 0; i < 16; ++i) s += y[i];
        s += __shfl_xor(s, 1); s += __shfl_xor(s, 2);
        const float mean = s * (1.f / 64.f); float q = 0.f;
#pragma unroll
        for (int i = 0; i < 16; ++i) { y[i] -= mean; q += y[i] * y[i]; }
        q += __shfl_xor(q, 1); q += __shfl_xor(q, 2);
        const float rstd = 1.f / sqrtf(q * (1.f / 64.f) + 64e-5f);
        u32x4 o[2];
#pragma unroll
        for (int j = 0; j < 2; ++j)
#pragma unroll
            for (int e = 0; e < 4; ++e) { const int i = 8 * j + 2 * e;
                const float z0 = ((y[i] * rstd) * lng[i] + lnb[i] + cc * vv[i]) * gg[i];
                const float z1 = ((y[i + 1] * rstd) * lng[i + 1] + lnb[i + 1] + cc * vv[i + 1]) * gg[i + 1];
                o[j][e] = pk2(z0, z1); }
        *(u32x4*)(G + (size_t)row * DM + c0) = o[0]; *(u32x4*)(G + (size_t)row * DM + c0 + 8) = o[1];
    }
#undef RD_LOAD
}


#define XB_TMO      128
#define XB_XCNT(j)  (256  + 64 * (j))
#define XB_XSUB(j)  (1280 + 64 * (j))
#define XB_XGEN(j)  (2304 + 64 * (j))
#define XB_TOP      3328
#define XB_TOPGEN   3392
#define XCD_BAR_WORDS 3456
#define XB_SPIN_CAP (1u << 18)
DI unsigned xb_ld(unsigned* p)              { return __hip_atomic_load(p, __ATOMIC_RELAXED, __HIP_MEMORY_SCOPE_AGENT); }
DI unsigned xb_add(unsigned* p, unsigned v) { return __hip_atomic_fetch_add(p, v, __ATOMIC_RELAXED, __HIP_MEMORY_SCOPE_AGENT); }
DI unsigned xb_xcc_id() { return (unsigned)__builtin_amdgcn_s_getreg((3 << 11) | 20) & 0xFu; }
#define XB_SPIN(cond, bar) do { unsigned _sp = 0; while (cond) { __builtin_amdgcn_s_sleep(1); \
    if ((++_sp & 255u) == 0u) { if (xb_ld(&(bar)[XB_TMO])) break; if (_sp > XB_SPIN_CAP) { atomicAdd(&(bar)[XB_TMO], 1u); break; } } } } while (0)
struct XcdBarrier { unsigned* bar; unsigned x; volatile LAS unsigned* st; };
DI XcdBarrier xcd_barrier_post(unsigned* bar, volatile LAS unsigned* st) {
    XcdBarrier b; b.bar = bar; b.x = xb_xcc_id(); b.st = st;
    if (threadIdx.x == 0) (void)xb_add(&bar[XB_XCNT(b.x)], 1u);
    return b;
}
DI void xcd_barrier_complete(unsigned* bar, unsigned x, unsigned& nloc, unsigned& nx) {
    const unsigned G = gridDim.x * gridDim.y * gridDim.z;
    unsigned sum, cnt, mine, sp = 0u;
    for (;;) {
        sum = 0u; cnt = 0u; mine = 0u;
#pragma unroll
        for (unsigned j = 0; j < 16; ++j) { const unsigned c = xb_ld(&bar[XB_XCNT(j)]); sum += c; cnt += (c > 0u) ? 1u : 0u; mine = (j == x) ? c : mine; }
        if (sum == G) break;
        __builtin_amdgcn_s_sleep(1);
        if ((++sp & 255u) == 0u) { if (xb_ld(&bar[XB_TMO])) break; if (sp > XB_SPIN_CAP) { atomicAdd(&bar[XB_TMO], 1u); break; } }
    }
    nloc = mine > 0u ? mine : 1u; nx = cnt > 0u ? cnt : 1u;
}
DI void xcd_barrier(const XcdBarrier& b) {
    asm volatile("s_waitcnt vmcnt(0)" ::: "memory");
    __syncthreads();
    if (threadIdx.x == 0) {
        unsigned* bar = b.bar;
        __builtin_amdgcn_s_waitcnt(0);
        unsigned nloc = b.st[0], nx = b.st[1];
        if (nloc == 0u) { xcd_barrier_complete(bar, b.x, nloc, nx); b.st[0] = nloc; b.st[1] = nx; }
        const unsigned old = xb_add(&bar[XB_XSUB(b.x)], 1u);
        const unsigned gen = old / nloc;
        if (old + 1u == (gen + 1u) * nloc) {
            __builtin_amdgcn_fence(__ATOMIC_RELEASE, "agent");
            asm volatile("s_waitcnt vmcnt(0)" ::: "memory");
            const unsigned og = xb_add(&bar[XB_TOP], 1u);
            const unsigned tg = og / nx;
            if (og + 1u == (tg + 1u) * nx) xb_add(&bar[XB_TOPGEN], 1u);
            else XB_SPIN(xb_ld(&bar[XB_TOPGEN]) == tg, bar);
            __builtin_amdgcn_fence(__ATOMIC_ACQUIRE, "agent");
            xb_add(&bar[XB_XGEN(b.x)], 1u);
            asm volatile("s_waitcnt vmcnt(0)" ::: "memory");
        } else {
            XB_SPIN(xb_ld(&bar[XB_XGEN(b.x)]) == gen, bar);
            __builtin_amdgcn_fence(__ATOMIC_ACQUIRE, "agent");
            asm volatile("s_waitcnt vmcnt(0)" ::: "memory");
        }
    }
    __syncthreads();
}

enum { OP_RP0 = 0, OP_G1, OP_G2, OP_RP1, OP_XX, OP_RKVH, OP_GG, OP_SCAN, OP_RDOUT, OP_QKV, OP_ATT, OP_OPROJ, OP_RP2, OP_G5, OP_G6, OP_RP3, OP_END };
DI int next_op(int kind, int op) {
    switch (op) {
        case OP_RP0: return OP_G1; case OP_G1: return OP_G2; case OP_G2: return OP_RP1;
        case OP_RP1: return kind == 2 ? OP_XX : OP_QKV;
        case OP_XX: return OP_RKVH; case OP_RKVH: return OP_GG; case OP_GG: return OP_SCAN; case OP_SCAN: return OP_RDOUT; case OP_RDOUT: return OP_OPROJ;
        case OP_QKV: return OP_ATT; case OP_ATT: return OP_OPROJ; case OP_OPROJ: return OP_RP2;
        case OP_RP2: return OP_G5; case OP_G5: return OP_G6; case OP_G6: return OP_RP3; default: return OP_END;
    }
}

__global__ void __launch_bounds__(512, 2) mega(const float* i0, const float* i1, const float* i2, const float* i3, const float* i4, const float* i5, const float* i6, const float* i7, const float* i8, const float* i9, const float* i10, const float* i11, const float* i12, const float* i13, const float* i14, const float* i15, const float* i16, const float* i17, const float* i18, const float* i19, const float* i20, const float* i21, const float* i22, const float* i23, const float* i24, const float* i25, const float* i26, const float* i27, const float* i28, const float* i29, const float* i30, const float* i31, float* out, unsigned char* ws0) {
    const float* in_[32] = {i0, i1, i2, i3, i4, i5, i6, i7, i8, i9, i10, i11, i12, i13, i14, i15, i16, i17, i18, i19, i20, i21, i22, i23, i24, i25, i26, i27, i28, i29, i30, i31};
    extern __shared__ __attribute__((aligned(16))) unsigned char lds_raw[];
    cg::grid_group grid = cg::this_grid();
    Frame F;
#define BUILD_FRAME() do { int tid_ = threadIdx.x; asm volatile("" : "+v"(tid_)); int bx_ = blockIdx.x; asm volatile("" : "+s"(bx_)); \
    F.lds = (LAS unsigned char*)lds_raw; F.tid = tid_; F.lane = tid_ & 63; F.wave = __builtin_amdgcn_readfirstlane(tid_ >> 6); \
    F.G = gridDim.x; F.bx = bx_; F.vcu = (F.G % 8 == 0) ? (bx_ % 8) * (F.G / 8) + bx_ / 8 : bx_; \
    F.gw = F.vcu * 8 + F.wave; F.NGW = F.G * 8; F.in = in_; } while (0)
    BUILD_FRAME();
    unsigned char* ws = ws0;

#ifndef NO_P0
    phase0(F, ws);
#endif
    grid.sync();
    volatile LAS unsigned* bst = (volatile LAS unsigned*)(F.lds + LDS_BYTES - 64);
    if (F.tid < 2) bst[F.tid] = 0u;
    __syncthreads();
    const XcdBarrier xbar = xcd_barrier_post((unsigned*)(ws0 + WS_BAR), bst);

    for (int l = 0; l < 4; ++l) {
        const int kind = l % 3; const bool last = (l == 3);
        const float* ng = F.in[I_NORMG] + l * 6 * DM;
        int op = (l == 0) ? OP_RP0 : OP_G1;
        int sub = 0, rp_lo = 0;
        while (op != OP_END) {
            { size_t zoff = 0; asm volatile("" : "+s"(zoff)); ws = ws0 + zoff; }
            BUILD_FRAME();
            float* HC = (float*)(ws + WS_HC); bf16_t* WB = (bf16_t*)(ws + WS_WB); bf16_t* U = (bf16_t*)(ws + WS_U); bf16_t* ACT = (bf16_t*)(ws + WS_ACT); bf16_t* YB = (bf16_t*)(ws + WS_Y);
            const float* cosT = (const float*)(ws + WS_ROPE); const float* sinT = cosT + 1024;
            int rpop = -1, rlo = 0, rhi = MROWS, rwidx = F.gw, rnw = F.NGW; bool fill = false;
            if (op == OP_G1 || op == OP_G2 || op == OP_G5 || op == OP_G6 || op == OP_QKV || op == OP_RKVH || op == OP_GG || op == OP_OPROJ) {
                pg8::Gemm g; pg8::Epi E; E.cosT = cosT; E.sinT = sinT; int skip = 0;
                if (op == OP_G1 || op == OP_G5) { g.A = U; g.lda = 1024; g.Bt = WB + (op == OP_G1 ? WB_IN0 : WB_IN1); g.ldb = 1024; g.N = 5632; g.K = 1024; E.mode = pg8::EPI_SWIGLU; E.O = ACT; E.ldc = FF; skip = (last && op == OP_G5); }
                else if (op == OP_G2 || op == OP_G6) { g.A = ACT; g.lda = FF; g.Bt = WB + (op == OP_G2 ? WB_OUT0 : WB_OUT1); g.ldb = FF; g.N = 1024; g.K = FF; E.mode = pg8::EPI_PLAIN; E.O = YB; E.ldc = 1024; skip = (last && op == OP_G6); }
                else if (op == OP_QKV) { g.A = U; g.lda = 1024; g.Bt = WB + WB_MIXIN; g.ldb = 1024; g.N = 3072; g.K = 1024; E.mode = kind == 0 ? pg8::EPI_QKV_DA : pg8::EPI_QKV_NA; E.O = ACT; E.ldc = 3072; }
                else if (op == OP_RKVH) { g.A = U; g.lda = 2048; g.Bt = WB + WB_MIXIN; g.ldb = 2048; g.N = 3584; g.K = 2048; E.mode = pg8::EPI_RWKV; E.O = ACT; E.ldc = 3584; }
                else if (op == OP_GG) { g.A = ACT + 3328; g.lda = 3584; g.Bt = WB + WB_G2T; g.ldb = 256; g.N = 1024; g.K = 256; E.mode = pg8::EPI_PLAIN; E.O = U; E.ldc = 1024; }
                else { g.A = U; g.lda = 1024; g.Bt = WB + WB_MIXOUT; g.ldb = 1024; g.N = 1024; g.K = 1024; E.mode = pg8::EPI_PLAIN; E.O = YB; E.ldc = 1024; skip = last; }
                g.nM = skip ? 128 : 144; g.skip = skip;
                pg8::StaticOrder S; S.init(g.nM, g.N, F.G, F.bx, skip);
                fill = (op == OP_G2 || op == OP_G6 || op == OP_OPROJ) && !skip && F.G == 256;
                if (fill) { S.pmode = 1; S.r0 = sub ? 2 : 0; S.nr = sub ? 1 : 2;
                    if (sub == 1 && F.bx >= 64) { rpop = (op == OP_G2) ? OP_RP1 : (op == OP_G6 ? OP_RP3 : OP_RP2); rlo = 0; rhi = 128 * 256; rwidx = (F.bx - 64) * 8 + F.wave; rnw = 192 * 8; } }
#ifndef NO_GEMM
                pg8::gemm_phase(F.lds, F.tid, g, S, E);
#endif
            } else if (op == OP_RP0 || op == OP_RP1 || op == OP_RP2 || op == OP_RP3) { rpop = op; rlo = rp_lo; }
            if (rpop >= 0) {
                RowPass P;
                P.hsrc_lat = out; P.hsrc_ctx = HC; P.hdst_lat = out; P.hdst_ctx = HC; P.U = U; P.ldu = 1024; P.skip_ctx = 0; P.lpost = l; P.lpre = l;
                if (rpop == OP_RP0) { P.hsrc_lat = F.in[I_X]; P.hsrc_ctx = F.in[I_CTX]; P.hdst_lat = (float*)F.in[I_X]; P.hdst_ctx = (float*)F.in[I_CTX];   P.Y = nullptr; P.gpost = ng; P.gate_idx = 0; P.coef = 0.f; P.gpre = ng; P.shift_idx = 0; }
                else if (rpop == OP_RP1) { if (l == 0) { P.hsrc_lat = F.in[I_X]; P.hsrc_ctx = F.in[I_CTX]; } P.Y = YB; P.gpost = ng + DM; P.gate_idx = 2; P.coef = 0.5f; P.gpre = ng + 2 * DM; P.shift_idx = 3; P.ldu = (kind == 2) ? 2048 : 1024; }
                else if (rpop == OP_RP2) { P.Y = YB; P.gpost = ng + 3 * DM; P.gate_idx = 5; P.coef = 1.f; P.gpre = ng + 4 * DM; P.shift_idx = 6; P.skip_ctx = last; }
                else { P.Y = YB; P.gpost = ng + 5 * DM; P.gate_idx = 8; P.coef = 0.5f; P.gpre = last ? nullptr : ng + 6 * DM; P.shift_idx = 0; P.lpre = l + 1; P.skip_ctx = last; }
#ifndef NO_RP
                row_pass(F, ws, P, rlo, rhi, rwidx, rnw);
#endif
#ifndef NO_CONV
                if (op == OP_RP3 && !last) { __syncthreads(); convert_layer(F, ws, l + 1); }
#endif
            }
#ifndef NO_XX
            if (op == OP_XX) { xx_pass(F, ws); }
#endif

#ifndef NO_SCAN
            if (op == OP_SCAN) { rwkv_scan(F, ws); }
#endif

#ifndef NO_RDOUT
            if (op == OP_RDOUT) { rwkv_readout(F, ws); }
#endif

#ifndef NO_ATT
            if (op == OP_ATT) {
#ifndef NO_DA
 if (kind == 0) da_phase(F, ws, l);
#endif
#ifndef NO_NA
 if (kind == 1) na_phase(F, ws);
#endif
 }
#endif
            xcd_barrier(xbar);
            if (fill) { if (sub == 0) { sub = 1; continue; } sub = 0; rp_lo = 128 * 256; }
            else if (rpop >= 0) rp_lo = 0;
            op = next_op(kind, op);
        }
    }
}

extern "C" void kernel_launch(void* const* d_in, const int* in_sizes, int n_in, void* d_out, int out_size,
                              void* d_ws, size_t ws_size, hipStream_t stream) {
    static int grid = 0;
    if (grid == 0) {
        if (n_in != 32 || ws_size < WS_END) { fprintf(stderr, "kernel_launch: need 32 inputs and %zu B of workspace; got %d, %zu\n", (size_t)WS_END, n_in, ws_size); grid = -1; return; }
        int dev = 0, cus = 0, per_cu = 0;
        (void)hipGetDevice(&dev);
        (void)hipDeviceGetAttribute(&cus, hipDeviceAttributeMultiprocessorCount, dev);
        (void)hipFuncSetAttribute((const void*)mega, hipFuncAttributeMaxDynamicSharedMemorySize, LDS_BYTES);
        (void)hipOccupancyMaxActiveBlocksPerMultiprocessor(&per_cu, (const void*)mega, 512, LDS_BYTES);
        if (per_cu < 1) per_cu = 1;
        grid = cus * per_cu;
    }
    if (grid < 0) return;
    const float* inp[32]; for (int i = 0; i < 32; ++i) inp[i] = (const float*)d_in[i];
    float* outp = (float*)d_out; unsigned char* wsp = (unsigned char*)d_ws;
    void* kargs[34]; for (int i = 0; i < 32; ++i) kargs[i] = (void*)&inp[i];
    kargs[32] = (void*)&outp; kargs[33] = (void*)&wsp;
    hipError_t e = hipLaunchCooperativeKernel((const void*)mega, dim3(grid), dim3(512), kargs, LDS_BYTES, stream);
    if (e != hipSuccess) fprintf(stderr, "cooperative launch failed: %s (grid %d)\n", hipGetErrorString(e), grid);
}
```
